# Optimizing an MI355X kernel written in HIP

```python
import math
import jax
import jax.numpy as jnp
from jax import lax
import numpy as np

D_MODEL = 1024
BATCH = 2
SEQ = 8192
DEPTH = 1

GRID_W = 64
CTX_LEN = 256
EPS = 1e-6

MIX_WIDTH = D_MODEL
SSD_INNER = MIX_WIDTH // 2
SSD_HEAD_DIM = 64
SSD_HEADS = SSD_INNER // SSD_HEAD_DIM
SSD_GROUPS = 2
SSD_HEADS_PER_GROUP = SSD_HEADS // SSD_GROUPS
SSD_STATE = 128
CONV_WIDTH = 5
CONV_DIM = SSD_INNER + 2 * SSD_GROUPS * SSD_STATE
CHUNK = 128
DT_MIN = 0.001
DT_MAX = 0.1
ATTN_WIDTH = MIX_WIDTH - SSD_INNER
HEAD_DIM = 64
ATTN_Q_HEADS = ATTN_WIDTH // HEAD_DIM
ATTN_KV_HEADS = 2
Q_PER_KV = ATTN_Q_HEADS // ATTN_KV_HEADS
KV_WIDTH = ATTN_KV_HEADS * HEAD_DIM
WINDOW = 128
BLOCK = 128
ROPE_BASE = 10000.0
IN_COLS = SSD_INNER + CONV_DIM + 2 * SSD_HEADS + ATTN_WIDTH + 2 * KV_WIDTH
N_GROUPS = 4
EXPERTS_PER_GROUP = 8
N_EXPERTS = N_GROUPS * EXPERTS_PER_GROUP
TOP_K = 2
EXPERT_DIM = D_MODEL // 2
MOE_BLOCK = 128

kernel_name = 'hymba_ssd_swa_hmoe_prefix_dit'


def rms_norm(x, gain):
    xf = x.astype(jnp.float32)
    y = xf * lax.rsqrt(jnp.mean(xf * xf, axis=-1, keepdims=True) + EPS)
    return (y * gain).astype(x.dtype)


def _flip(t):
    return jnp.flip(t, axis=1)


def split_projection(p):
    sizes = [SSD_INNER, CONV_DIM, 2 * SSD_HEADS, ATTN_WIDTH, KV_WIDTH, KV_WIDTH]
    return jnp.split(p, np.cumsum(sizes)[:-1].tolist(), axis=-1)


def centred_dwconv(u, w, b):
    out = lax.conv_general_dilated(
        u, w[:, None, :].astype(u.dtype), window_strides=(1,),
        padding=((CONV_WIDTH // 2, CONV_WIDTH // 2),),
        dimension_numbers=('NWC', 'WIO', 'NWC'), feature_group_count=u.shape[-1])
    return out + b.astype(u.dtype)


def ssd_inputs(xbc, dt_raw, conv_w, conv_b, dt_bias):
    b, L = xbc.shape[:2]
    u = jax.nn.silu(centred_dwconv(xbc, conv_w, conv_b))
    xs, bm, cm = jnp.split(u, [SSD_INNER, SSD_INNER + SSD_GROUPS * SSD_STATE], axis=-1)
    xs = xs.reshape(b, L, SSD_HEADS, SSD_HEAD_DIM)
    bm = bm.reshape(b, L, SSD_GROUPS, SSD_STATE)
    cm = cm.reshape(b, L, SSD_GROUPS, SSD_STATE)
    dt = jax.nn.softplus(dt_raw.astype(jnp.float32).reshape(b, L, 2, SSD_HEADS) + dt_bias)
    return xs, bm, cm, dt


def ssd_scan(xs, dt, a, bm, cm, h0, need_y=True):
    f32 = jnp.float32
    b, L = xs.shape[:2]
    nc = L // CHUNK
    G, R, P, N = SSD_GROUPS, SSD_HEADS_PER_GROUP, SSD_HEAD_DIM, SSD_STATE
    xg = xs.astype(f32).reshape(b, nc, CHUNK, G, R, P)
    dtc = dt.astype(f32).reshape(b, nc, CHUNK, G, R)
    bc = bm.astype(f32).reshape(b, nc, CHUNK, G, N)
    a_cs = jnp.cumsum(dtc * a.reshape(G, R), axis=2)
    a_last = a_cs[:, :, -1]
    dtx = dtc[..., None] * xg
    states = jnp.einsum('bcjgn,bcjgr,bcjgrp->bcgrpn', bc, jnp.exp(a_last[:, :, None] - a_cs), dtx)

    def step(h, inp):
        s, al = inp
        return jnp.exp(al)[..., None, None] * h + s, h

    h_final, h_prev = lax.scan(step, h0.astype(f32),
                               (jnp.moveaxis(states, 1, 0), jnp.moveaxis(a_last, 1, 0)))
    if not need_y:
        return None, h_final
    cc = cm.astype(f32).reshape(b, nc, CHUNK, G, N)
    tri = jnp.tril(jnp.ones((CHUNK, CHUNK), dtype=bool))
    seg = a_cs[:, :, :, None] - a_cs[:, :, None, :]
    decay = jnp.exp(jnp.where(tri[:, :, None, None], seg, -jnp.inf))
    cb = jnp.einsum('bcign,bcjgn->bcijg', cc, bc)
    y_diag = jnp.einsum('bcijgr,bcjgrp->bcigrp', cb[..., None] * decay, dtx)
    y_off = jnp.einsum('bcign,cbgrpn->bcigrp', cc, h_prev) * jnp.exp(a_cs)[..., None]
    return (y_diag + y_off).reshape(b, L, SSD_HEADS, P), h_final


def ssd_output(y, xs, z, d_skip, gain):
    b, L = xs.shape[:2]
    y = y + d_skip.astype(jnp.float32)[:, None] * xs.astype(jnp.float32)
    y = y.reshape(b, L, SSD_INNER) * jax.nn.silu(z.astype(jnp.float32))
    return rms_norm(y, gain).astype(z.dtype)


def axial_rope_tables(rows):
    row = jnp.repeat(jnp.arange(rows), GRID_W)
    col = jnp.tile(jnp.arange(GRID_W), rows)
    n_freq = HEAD_DIM // 4
    inv_freq = ROPE_BASE ** (-jnp.arange(n_freq, dtype=jnp.float32) / n_freq)
    ang = jnp.concatenate([row[:, None] * inv_freq, col[:, None] * inv_freq], axis=-1)
    ang = jnp.concatenate([ang, ang], axis=-1)
    return jnp.cos(ang), jnp.sin(ang)


def apply_rope(t, cos, sin):
    half = HEAD_DIM // 2
    rot = jnp.concatenate([-t[..., half:], t[..., :half]], axis=-1)
    return (t * cos[:, None] + rot * sin[:, None]).astype(t.dtype)


def softmax_with_sink(logits, sink):
    full = jnp.concatenate([logits, jnp.broadcast_to(sink, logits.shape[:-1] + (1,))], axis=-1)
    return jax.nn.softmax(full, axis=-1)[..., :-1]


def windowed_attention(q, k, v, k_ctx, v_ctx, sinks):
    f32 = jnp.float32
    b, L = q.shape[:2]
    nb = L // BLOCK
    scale = HEAD_DIM ** -0.5
    qb = q.reshape(b, nb, BLOCK, ATTN_KV_HEADS, Q_PER_KV, HEAD_DIM)

    def band(t):
        tp = jnp.pad(t, ((0, 0), (BLOCK, BLOCK), (0, 0), (0, 0)))
        tp = tp.reshape(b, nb + 2, BLOCK, ATTN_KV_HEADS, HEAD_DIM)
        return jnp.concatenate([tp[:, :-2], tp[:, 1:-1], tp[:, 2:]], axis=2)

    kw, vw = band(k), band(v)
    s_loc = jnp.einsum('bnqhgd,bnkhd->bnhgqk', qb, kw, preferred_element_type=f32) * scale
    blk = jnp.arange(nb)[:, None, None] * BLOCK
    q_pos = blk + jnp.arange(BLOCK)[None, :, None]
    k_pos = blk + jnp.arange(3 * BLOCK)[None, None, :] - BLOCK
    valid = (jnp.abs(k_pos - q_pos) <= WINDOW) & (k_pos >= 0) & (k_pos < L)
    s_loc = jnp.where(valid[None, :, None, None], s_loc, -jnp.inf)
    s_ctx = jnp.einsum('bnqhgd,bkhd->bnhgqk', qb, k_ctx, preferred_element_type=f32) * scale
    sink = sinks.astype(f32).reshape(ATTN_KV_HEADS, Q_PER_KV)[:, :, None, None]
    p = softmax_with_sink(jnp.concatenate([s_loc, s_ctx], axis=-1), sink)
    p_loc = p[..., :3 * BLOCK].astype(v.dtype)
    p_ctx = p[..., 3 * BLOCK:].astype(v.dtype)
    o = (jnp.einsum('bnhgqk,bnkhd->bnqhgd', p_loc, vw)
         + jnp.einsum('bnhgqk,bkhd->bnqhgd', p_ctx, v_ctx))
    return o.reshape(b, L, ATTN_WIDTH)


def context_attention(q_c, k_c, v_c, sinks):
    b, Lc = q_c.shape[:2]
    qg = q_c.reshape(b, Lc, ATTN_KV_HEADS, Q_PER_KV, HEAD_DIM)
    s = jnp.einsum('bqhgd,bkhd->bhgqk', qg, k_c, preferred_element_type=jnp.float32) * HEAD_DIM ** -0.5
    sink = sinks.astype(jnp.float32).reshape(ATTN_KV_HEADS, Q_PER_KV)[:, :, None, None]
    p = softmax_with_sink(s, sink).astype(v_c.dtype)
    return jnp.einsum('bhgqk,bkhd->bqhgd', p, v_c).reshape(b, Lc, ATTN_WIDTH)


def hier_moe(h, w_group, b_group, w_expert, b_expert, w_gate, w_up, w_down):
    f32 = jnp.float32
    n_tok, d = h.shape
    g_prob = jax.nn.softmax((h @ w_group).astype(f32) + b_group, axis=-1)
    g_w, g_idx = lax.top_k(g_prob, 1)
    e_logits = ((h @ w_expert).astype(f32) + b_expert).reshape(n_tok, N_GROUPS, EXPERTS_PER_GROUP)
    e_sel = e_logits[jnp.arange(n_tok), g_idx[:, 0]]
    e_w, e_idx = lax.top_k(jax.nn.softmax(e_sel, axis=-1), TOP_K)
    weights = g_w * e_w / jnp.sum(e_w, axis=-1, keepdims=True)
    expert = g_idx * EXPERTS_PER_GROUP + e_idx
    n_assign = n_tok * TOP_K
    flat_e = expert.reshape(n_assign).astype(jnp.int32)
    flat_tok = jnp.repeat(jnp.arange(n_tok, dtype=jnp.int32), TOP_K)
    flat_w = weights.reshape(n_assign)
    order = jnp.argsort(flat_e)
    sorted_e = flat_e[order]
    counts = jnp.zeros((N_EXPERTS,), jnp.int32).at[flat_e].add(1)
    start = jnp.cumsum(counts) - counts
    padded = (counts + MOE_BLOCK - 1) // MOE_BLOCK * MOE_BLOCK
    ends = jnp.cumsum(padded)
    pstart = ends - padded
    dest = pstart[sorted_e] + jnp.arange(n_assign, dtype=jnp.int32) - start[sorted_e]
    n_blocks = -(-n_assign // MOE_BLOCK) + N_EXPERTS
    n_slots = n_blocks * MOE_BLOCK
    tok_buf = jnp.full((n_slots,), n_tok, jnp.int32).at[dest].set(flat_tok[order])
    w_buf = jnp.zeros((n_slots,), f32).at[dest].set(flat_w[order])
    h_pad = jnp.concatenate([h, jnp.zeros((1, d), h.dtype)], axis=0)
    x_buf = h_pad[tok_buf].reshape(n_blocks, MOE_BLOCK, d)
    blk_e = jnp.searchsorted(ends, jnp.arange(n_blocks, dtype=jnp.int32) * MOE_BLOCK, side='right')
    blk_e = jnp.minimum(blk_e, N_EXPERTS - 1)

    def expert_block(args):
        xb, e = args
        return (jax.nn.silu(xb @ w_gate[e]) * (xb @ w_up[e])) @ w_down[e]

    y_buf = lax.map(expert_block, (x_buf, blk_e)).reshape(n_slots, d)
    out = jax.ops.segment_sum(y_buf.astype(f32) * w_buf[:, None], tok_buf, num_segments=n_tok + 1)
    return out[:n_tok].astype(h.dtype)


def setup_inputs(seed: int = 0) -> dict:
    key = jax.random.key(seed)
    ks = jax.random.split(key, 26)
    f32 = jnp.float32

    def nrm(k, shape, scale):
        return jax.random.normal(k, shape, f32) * scale

    u = jax.random.uniform(ks[10], (DEPTH, 2, SSD_HEADS), f32)
    dt0 = jnp.exp(u * (math.log(DT_MAX) - math.log(DT_MIN)) + math.log(DT_MIN))
    return {
        'x': nrm(ks[0], (BATCH, SEQ, D_MODEL), 1.0),
        'c': nrm(ks[1], (BATCH, D_MODEL), 1.0),
        'ctx': nrm(ks[2], (BATCH, CTX_LEN, D_MODEL), 1.0),
        'c_ctx': nrm(ks[3], (D_MODEL,), 1.0),
        'w_ada': nrm(ks[4], (DEPTH, D_MODEL, 6 * D_MODEL), 0.5 * D_MODEL ** -0.5),
        'b_ada': nrm(ks[5], (DEPTH, 6 * D_MODEL), 0.02),
        'norm1': 1.0 + nrm(ks[6], (DEPTH, D_MODEL), 0.02),
        'w_in': nrm(ks[7], (DEPTH, D_MODEL, IN_COLS), D_MODEL ** -0.5),
        'conv_w': nrm(ks[8], (DEPTH, CONV_WIDTH, CONV_DIM), CONV_WIDTH ** -0.5),
        'conv_b': nrm(ks[9], (DEPTH, CONV_DIM), 0.02),
        'dt_bias': dt0 + jnp.log(-jnp.expm1(-dt0)),
        'a_log': jnp.log(jax.random.uniform(ks[11], (DEPTH, 2, SSD_HEADS), f32, 1.0, 16.0)),
        'd_skip': 1.0 + nrm(ks[12], (DEPTH, SSD_HEADS), 0.1),
        'ssd_norm': 1.0 + nrm(ks[13], (DEPTH, SSD_INNER), 0.02),
        'attn_sinks': nrm(ks[14], (DEPTH, ATTN_Q_HEADS), 1.0),
        'w_out': nrm(ks[15], (DEPTH, MIX_WIDTH, D_MODEL), MIX_WIDTH ** -0.5),
        'norm2': 1.0 + nrm(ks[16], (DEPTH, D_MODEL), 0.02),
        'w_group': nrm(ks[17], (DEPTH, D_MODEL, N_GROUPS), D_MODEL ** -0.5),
        'b_group': nrm(ks[18], (DEPTH, N_GROUPS), 0.01),
        'w_expert': nrm(ks[19], (DEPTH, D_MODEL, N_EXPERTS), D_MODEL ** -0.5),
        'b_expert': nrm(ks[20], (DEPTH, N_EXPERTS), 0.01),
        'w_gate': nrm(ks[21], (DEPTH, N_EXPERTS, D_MODEL, EXPERT_DIM), D_MODEL ** -0.5),
        'w_up': nrm(ks[22], (DEPTH, N_EXPERTS, D_MODEL, EXPERT_DIM), D_MODEL ** -0.5),
        'w_down': nrm(ks[23], (DEPTH, N_EXPERTS, EXPERT_DIM, D_MODEL), EXPERT_DIM ** -0.5),
        'norm_final': 1.0 + nrm(ks[24], (D_MODEL,), 0.02),
    }


def reference(x, c, ctx, c_ctx, w_ada, b_ada, norm1, w_in, conv_w, conv_b, dt_bias, a_log,
              d_skip, ssd_norm, attn_sinks, w_out, norm2, w_group, b_group, w_expert, b_expert,
              w_gate, w_up, w_down, norm_final):
    b, n_tok, d = x.shape
    n_ctx = ctx.shape[1]
    rows = n_tok // GRID_W
    cos, sin = axial_rope_tables(rows)
    h0 = jnp.zeros((b, SSD_GROUPS, SSD_HEADS_PER_GROUP, SSD_HEAD_DIM, SSD_STATE), jnp.float32)
    for layer in range(DEPTH):
        last = layer == DEPTH - 1
        mod_x = jax.nn.silu(c) @ w_ada[layer] + b_ada[layer]
        mod_c = jax.nn.silu(c_ctx) @ w_ada[layer] + b_ada[layer]
        sh1, sc1, g1, sh2, sc2, g2 = jnp.split(mod_x[:, None, :], 6, axis=-1)
        csh1, csc1, cg1, csh2, csc2, cg2 = jnp.split(mod_c, 6, axis=-1)
        hx = rms_norm(x, norm1[layer]) * (1 + sc1) + sh1
        hc = rms_norm(ctx, norm1[layer]) * (1 + csc1) + csh1
        zx, xbc_x, dt_x, qx, kx, vx = split_projection(hx @ w_in[layer])
        zc, xbc_c, dt_c, qc, kc, vc = split_projection(hc @ w_in[layer])
        xs_x, bm_x, cm_x, dtv_x = ssd_inputs(xbc_x, dt_x, conv_w[layer], conv_b[layer], dt_bias[layer])
        xs_c, bm_c, cm_c, dtv_c = ssd_inputs(xbc_c, dt_c, conv_w[layer], conv_b[layer], dt_bias[layer])
        A = -jnp.exp(a_log[layer].astype(jnp.float32))
        y_cf, h_cf = ssd_scan(xs_c, dtv_c[:, :, 0], A[0], bm_c, cm_c, h0, need_y=not last)
        y_cb, h_cb = ssd_scan(_flip(xs_c), _flip(dtv_c[:, :, 1]), A[1], _flip(bm_c), _flip(cm_c), h0,
                              need_y=not last)
        y_xf, _ = ssd_scan(xs_x, dtv_x[:, :, 0], A[0], bm_x, cm_x, h_cf)
        y_xb, _ = ssd_scan(_flip(xs_x), _flip(dtv_x[:, :, 1]), A[1], _flip(bm_x), _flip(cm_x), h_cb)
        ssd_x = ssd_output(y_xf + _flip(y_xb), xs_x, zx, d_skip[layer], ssd_norm[layer])
        qx = apply_rope(qx.reshape(b, n_tok, ATTN_Q_HEADS, HEAD_DIM), cos, sin)
        kx = apply_rope(kx.reshape(b, n_tok, ATTN_KV_HEADS, HEAD_DIM), cos, sin)
        vx = vx.reshape(b, n_tok, ATTN_KV_HEADS, HEAD_DIM)
        kc = kc.reshape(b, n_ctx, ATTN_KV_HEADS, HEAD_DIM)
        vc = vc.reshape(b, n_ctx, ATTN_KV_HEADS, HEAD_DIM)
        attn_x = windowed_attention(qx, kx, vx, kc, vc, attn_sinks[layer])
        x = x + g1 * (jnp.concatenate([ssd_x, attn_x], axis=-1) @ w_out[layer])
        h2 = rms_norm(x, norm2[layer]) * (1 + sc2) + sh2
        moe_x = hier_moe(h2.reshape(b * n_tok, d), w_group[layer], b_group[layer], w_expert[layer],
                         b_expert[layer], w_gate[layer], w_up[layer], w_down[layer])
        x = x + g2 * moe_x.reshape(b, n_tok, d)
        if not last:
            ssd_c = ssd_output(y_cf + _flip(y_cb), xs_c, zc, d_skip[layer], ssd_norm[layer])
            attn_c = context_attention(qc.reshape(b, n_ctx, ATTN_Q_HEADS, HEAD_DIM), kc, vc, attn_sinks[layer])
            ctx = ctx + cg1 * (jnp.concatenate([ssd_c, attn_c], axis=-1) @ w_out[layer])
            h2c = rms_norm(ctx, norm2[layer]) * (1 + csc2) + csh2
            moe_c = hier_moe(h2c.reshape(b * n_ctx, d), w_group[layer], b_group[layer], w_expert[layer],
                             b_expert[layer], w_gate[layer], w_up[layer], w_down[layer])
            ctx = ctx + cg2 * moe_c.reshape(b, n_ctx, d)
    return rms_norm(x, norm_final)
```

```cpp
#include <hip/hip_runtime.h>
#include <cstdio>
#include <cstdint>

constexpr int DM = 1024, SEQ = 8192, NB = 2, CTXL = 256;
constexpr int ML = NB * SEQ;
constexpr int MC = NB * CTXL;
constexpr int MT = ML + MC;
constexpr int INC = 2320;
constexpr int C_Z = 0, C_XBC = 512, C_DT = 1536, C_Q = 1552, C_K = 2064, C_V = 2192;
constexpr int NCH = 132;
constexpr int NE = 32, EDIM = 512;
constexpr float EPS = 1e-6f;

constexpr size_t MiB = 1u << 20;
constexpr size_t WS_CTL = 0, CTL_ZERO_BYTES = 64 * 1024;
constexpr size_t WS_MODP = 1 * MiB;
constexpr size_t WS_MOD = WS_MODP + 16 * 3 * 6144 * 4;
constexpr size_t WS_ROPE = 3 * MiB;
constexpr size_t WS_DT = 5 * MiB;
constexpr size_t WS_ACS = 6 * MiB + 512 * 1024;
constexpr size_t WS_AL = 8 * MiB;
constexpr size_t WS_EW = 8 * MiB + 64 * 1024;
constexpr size_t WS_LIST = 9 * MiB;
constexpr size_t WS_A = 12 * MiB;
constexpr size_t WS_B = WS_A + 66 * MiB;
constexpr size_t WS_C = WS_B + 150 * MiB;
constexpr size_t WS_END = WS_C + 66 * MiB;
constexpr int CW_CNT = 64;
constexpr int CW_BAR = 1024;

constexpr int LDS_BYTES = 147456;
constexpr int NTHREADS = 512;

#define LAS __attribute__((address_space(3)))

#define XB_TMO      128
#define XB_XCNT(j)  (256  + 64 * (j))
#define XB_XSUB(j)  (1280 + 64 * (j))
#define XB_XGEN(j)  (2304 + 64 * (j))
#define XB_TOP      3328
#define XB_TOPGEN   3392
#define XCD_BAR_WORDS 3456
#define XB_SPIN_CAP (1u << 18)
__device__ __forceinline__ unsigned xb_ld(unsigned* p)              { return __hip_atomic_load(p, __ATOMIC_RELAXED, __HIP_MEMORY_SCOPE_AGENT); }
__device__ __forceinline__ unsigned xb_add(unsigned* p, unsigned v) { return __hip_atomic_fetch_add(p, v, __ATOMIC_RELAXED, __HIP_MEMORY_SCOPE_AGENT); }
__device__ __forceinline__ unsigned xb_xcc_id() { return (unsigned)__builtin_amdgcn_s_getreg((3 << 11) | 20) & 0xFu; }
#define XB_SPIN(cond, bar) do { unsigned _sp = 0; while (cond) { __builtin_amdgcn_s_sleep(1); \
    if ((++_sp & 255u) == 0u) { if (xb_ld(&(bar)[XB_TMO])) break; if (_sp > XB_SPIN_CAP) { atomicAdd(&(bar)[XB_TMO], 1u); break; } } } } while (0)
struct XcdBarrier { unsigned* bar; unsigned x; volatile LAS unsigned* st; };
__device__ __forceinline__ XcdBarrier xcd_barrier_post(unsigned* bar, volatile LAS unsigned* st) {
    XcdBarrier b; b.bar = bar; b.x = xb_xcc_id(); b.st = st;
    if (threadIdx.x == 0) (void)xb_add(&bar[XB_XCNT(b.x)], 1u);
    return b;
}
__device__ __forceinline__ void xcd_barrier_complete(unsigned* bar, unsigned x, unsigned& nloc, unsigned& nx) {
    const unsigned G = gridDim.x * gridDim.y * gridDim.z;
    unsigned sum, cnt, mine, sp = 0u;
    for (;;) {
        sum = 0u; cnt = 0u; mine = 0u;
#pragma unroll
        for (unsigned j = 0; j < 16; ++j) { const unsigned c = xb_ld(&bar[XB_XCNT(j)]); sum += c; cnt += (c > 0u) ? 1u : 0u; mine = (j == x) ? c : mine; }
        if (sum == G) break;
        __builtin_amdgcn_s_sleep(1);
        if ((++sp & 255u) == 0u) { if (xb_ld(&bar[XB_TMO])) break; if (sp > XB_SPIN_CAP) { atomicAdd(&bar[XB_TMO], 1u); break; } }
    }
    nloc = mine > 0u ? mine : 1u; nx = cnt > 0u ? cnt : 1u;
}
__device__ __forceinline__ void xcd_barrier(const XcdBarrier& b) {
    asm volatile("s_waitcnt vmcnt(0)" ::: "memory");
    __syncthreads();
    if (threadIdx.x == 0) {
        unsigned* bar = b.bar;
        __builtin_amdgcn_s_waitcnt(0);
        unsigned nloc = b.st[0], nx = b.st[1];
        if (nloc == 0u) { xcd_barrier_complete(bar, b.x, nloc, nx); b.st[0] = nloc; b.st[1] = nx; }
        const unsigned old = xb_add(&bar[XB_XSUB(b.x)], 1u);
        const unsigned gen = old / nloc;
        if (old + 1u == (gen + 1u) * nloc) {
            __builtin_amdgcn_fence(__ATOMIC_RELEASE, "agent");
            asm volatile("s_waitcnt vmcnt(0)" ::: "memory");
            const unsigned og = xb_add(&bar[XB_TOP], 1u);
            const unsigned tg = og / nx;
            if (og + 1u == (tg + 1u) * nx) xb_add(&bar[XB_TOPGEN], 1u);
            else XB_SPIN(xb_ld(&bar[XB_TOPGEN]) == tg, bar);
            __builtin_amdgcn_fence(__ATOMIC_ACQUIRE, "agent");
            xb_add(&bar[XB_XGEN(b.x)], 1u);
            asm volatile("s_waitcnt vmcnt(0)" ::: "memory");
        } else {
            XB_SPIN(xb_ld(&bar[XB_XGEN(b.x)]) == gen, bar);
            __builtin_amdgcn_fence(__ATOMIC_ACQUIRE, "agent");
            asm volatile("s_waitcnt vmcnt(0)" ::: "memory");
        }
    }
    __syncthreads();
}

typedef float f32x4 __attribute__((ext_vector_type(4)));
__device__ __forceinline__ float silu_f(float x) { return x / (1.f + __expf(-x)); }
__device__ __forceinline__ float silu_acc(float x) { return x / (1.f + expf(-x)); }
__device__ __forceinline__ float softplus_f(float x) { return fmaxf(x, 0.f) + log1pf(expf(-fabsf(x))); }
__device__ __forceinline__ float wave_sum(float v) {
#pragma unroll
    for (int o = 1; o < 64; o <<= 1) v += __shfl_xor(v, o);
    return v;
}
__device__ __forceinline__ float wave_max(float v) {
#pragma unroll
    for (int o = 1; o < 64; o <<= 1) v = fmaxf(v, __shfl_xor(v, o));
    return v;
}

struct Ptrs {
    const float *x, *c, *ctx, *c_ctx, *w_ada, *b_ada, *norm1, *w_in, *conv_w, *conv_b, *dt_bias, *a_log, *d_skip, *ssd_norm, *sinks,
                *w_out, *norm2, *w_group, *b_group, *w_expert, *b_expert, *w_gate, *w_up, *w_down, *norm_final;
    float* out; unsigned char* ws;
};

template <class RowPtr>
__device__ __forceinline__ void sgemm_tile(float (&acc)[4][8], LAS float* lds, const RowPtr& rowptr, const float* W, int ldw, int K, int n0, int N) {
    const int tid = threadIdx.x, ty = tid >> 4, tx = tid & 15;
    LAS float* As = lds;
    LAS float* Ws = lds + 16 * 132;
#pragma unroll
    for (int i = 0; i < 4; ++i)
#pragma unroll
        for (int j = 0; j < 8; ++j) acc[i][j] = 0.f;
    const int ar = tid >> 2, ak = (tid & 3) * 4;
    const float* arow = rowptr(ar);
    const int wk = tid >> 5, wn = (tid & 31) * 4;
    const bool wok = (n0 + wn) < N;
    for (int k0 = 0; k0 < K; k0 += 16) {
        f32x4 av = {0.f, 0.f, 0.f, 0.f}, wv = {0.f, 0.f, 0.f, 0.f};
        if (arow) av = *(const f32x4*)(arow + k0 + ak);
        if (wok) wv = *(const f32x4*)(W + (size_t)(k0 + wk) * ldw + n0 + wn);
        __syncthreads();
        As[(ak + 0) * 132 + ar] = av.x; As[(ak + 1) * 132 + ar] = av.y; As[(ak + 2) * 132 + ar] = av.z; As[(ak + 3) * 132 + ar] = av.w;
        *(LAS f32x4*)&Ws[wk * 128 + wn] = wv;
        __syncthreads();
#pragma unroll
        for (int k = 0; k < 16; ++k) {
            const f32x4 a = *(const LAS f32x4*)&As[k * 132 + ty * 4];
            const f32x4 w0 = *(const LAS f32x4*)&Ws[k * 128 + tx * 8], w1 = *(const LAS f32x4*)&Ws[k * 128 + tx * 8 + 4];
#pragma unroll
            for (int i = 0; i < 4; ++i) {
                acc[i][0] += a[i] * w0.x; acc[i][1] += a[i] * w0.y; acc[i][2] += a[i] * w0.z; acc[i][3] += a[i] * w0.w;
                acc[i][4] += a[i] * w1.x; acc[i][5] += a[i] * w1.y; acc[i][6] += a[i] * w1.z; acc[i][7] += a[i] * w1.w;
            }
        }
    }
    __syncthreads();
}

__device__ __forceinline__ int chunk_row0(int q) { return q < 128 ? q * 128 : ML + (q - 128) * 128; }

struct Args { Ptrs p; int ph_lo, ph_hi; };

__global__ void __launch_bounds__(NTHREADS, 2) fwd_kernel(Args args) {
    extern __shared__ __attribute__((aligned(16))) unsigned char lds_raw[];
    LAS unsigned char* lds = (LAS unsigned char*)lds_raw;
    const Ptrs& P = args.p;
    const int tid = threadIdx.x, lane = tid & 63, wave = tid >> 6;
    const int G = gridDim.x, bid = blockIdx.x;
    const int gtid = bid * NTHREADS + tid, NT = G * NTHREADS;
    const int gw = bid * 8 + wave, NGW = G * 8;
    unsigned char* ws = P.ws;
    unsigned* ctl = (unsigned*)(ws + WS_CTL);
    float* MODP = (float*)(ws + WS_MODP);
    float* MOD = (float*)(ws + WS_MOD);
    float* ROPEC = (float*)(ws + WS_ROPE);
    float* ROPES = ROPEC + 8192 * 32;
    float* DT = (float*)(ws + WS_DT);
    float* ACS = (float*)(ws + WS_ACS);
    float* AL = (float*)(ws + WS_AL);
    float* EW = (float*)(ws + WS_EW);
    int* LIST = (int*)(ws + WS_LIST);
    float* HX = (float*)(ws + WS_A);
    float* U = (float*)(ws + WS_A);
    float* X1 = (float*)(ws + WS_A);
    float* PR = (float*)(ws + WS_B);
    float* Y = (float*)(ws + WS_B);
    float* S = (float*)(ws + WS_C);
    float* H2 = (float*)(ws + WS_C);
    float* MIX = P.out;
    float* ACT = P.out;
    unsigned* CNT = ctl + CW_CNT;

    volatile LAS unsigned* MISC = (volatile LAS unsigned*)(lds + LDS_BYTES - 64);
    if (tid < 16) MISC[tid] = 0u;
    __syncthreads();
    XcdBarrier bar = xcd_barrier_post(ctl + CW_BAR, MISC);
    const int lo = args.ph_lo, hi = args.ph_hi;
#define IN(k) (lo <= (k) && (k) < hi)
#define SEAM(k) do { if (IN(k) && IN((k) + 1)) xcd_barrier(bar); } while (0)

    if (IN(0)) {
        for (int idx = gtid; idx < 16 * 6144; idx += NT) {
            const int ks = idx / 6144, n = idx % 6144;
            float a0 = 0.f, a1 = 0.f, a2 = 0.f;
            for (int k = ks * 64; k < ks * 64 + 64; ++k) {
                const float w = P.w_ada[(size_t)k * 6144 + n];
                a0 += silu_acc(P.c[k]) * w; a1 += silu_acc(P.c[1024 + k]) * w; a2 += silu_acc(P.c_ctx[k]) * w;
            }
            MODP[(ks * 3 + 0) * 6144 + n] = a0; MODP[(ks * 3 + 1) * 6144 + n] = a1; MODP[(ks * 3 + 2) * 6144 + n] = a2;
        }
        for (int idx = gtid; idx < 8192 * 32; idx += NT) {
            const int pos = idx >> 5, f = idx & 31;
            const float inv = powf(10000.0f, -(float)(f & 15) / 16.0f);
            const float ang = (float)((f < 16) ? (pos >> 6) : (pos & 63)) * inv;
            ROPEC[idx] = cosf(ang); ROPES[idx] = sinf(ang);
        }
    }
    SEAM(0);
    if (IN(1)) {
        for (int idx = gtid; idx < 3 * 6144; idx += NT) {
            const int r = idx / 6144, n = idx % 6144;
            float a = P.b_ada[n];
            for (int ks = 0; ks < 16; ++ks) a += MODP[(ks * 3 + r) * 6144 + n];
            MOD[idx] = a;
        }
    }
    SEAM(1);
    if (IN(2)) {
        for (int r = gw; r < MT; r += NGW) {
            const float* src = r < ML ? P.x + (size_t)r * DM : P.ctx + (size_t)(r - ML) * DM;
            const float* mod = MOD + (r < ML ? (r / SEQ) : 2) * 6144;
            f32x4 v[4]; float s = 0.f;
#pragma unroll
            for (int j = 0; j < 4; ++j) { v[j] = *(const f32x4*)(src + j * 256 + lane * 4); s += v[j].x * v[j].x + v[j].y * v[j].y + v[j].z * v[j].z + v[j].w * v[j].w; }
            const float rstd = rsqrtf(wave_sum(s) * (1.f / DM) + EPS);
#pragma unroll
            for (int j = 0; j < 4; ++j) {
                const int c0 = j * 256 + lane * 4;
                const f32x4 g = *(const f32x4*)(P.norm1 + c0), sh = *(const f32x4*)(mod + c0), sc = *(const f32x4*)(mod + 1024 + c0);
                f32x4 o;
                o.x = v[j].x * rstd * g.x * (1.f + sc.x) + sh.x; o.y = v[j].y * rstd * g.y * (1.f + sc.y) + sh.y;
                o.z = v[j].z * rstd * g.z * (1.f + sc.z) + sh.z; o.w = v[j].w * rstd * g.w * (1.f + sc.w) + sh.w;
                *(f32x4*)(HX + (size_t)r * DM + c0) = o;
            }
        }
    }
    SEAM(2);
    if (IN(3)) {
        const int ntn = (INC + 127) / 128, ntiles = (MT / 128) * ntn;
        for (int t = bid; t < ntiles; t += G) {
            const int tm = t / ntn, tn = t % ntn;
            float acc[4][8];
            const float* A0 = HX + (size_t)tm * 128 * DM;
            sgemm_tile(acc, (LAS float*)lds, [&](int i) { return A0 + (size_t)i * DM; }, P.w_in, INC, DM, tn * 128, INC);
            const int ty = tid >> 4, tx = tid & 15;
#pragma unroll
            for (int i = 0; i < 4; ++i) {
                const int m = tm * 128 + ty * 4 + i;
#pragma unroll
                for (int j = 0; j < 8; ++j) { const int n = tn * 128 + tx * 8 + j; if (n < INC) PR[(size_t)m * INC + n] = acc[i][j]; }
            }
        }
    }
    SEAM(3);
    if (IN(4)) {
        for (size_t idx = gtid; idx < (size_t)MT * 1024; idx += NT) {
            const int r = (int)(idx >> 10), c = (int)(idx & 1023);
            int s0, sl;
            if (r < ML) { s0 = (r / SEQ) * SEQ; sl = SEQ; } else { s0 = ML + ((r - ML) / CTXL) * CTXL; sl = CTXL; }
            float a = P.conv_b[c];
#pragma unroll
            for (int w = 0; w < 5; ++w) { const int rr = r + w - 2; if (rr >= s0 && rr < s0 + sl) a += P.conv_w[w * 1024 + c] * PR[(size_t)rr * INC + C_XBC + c]; }
            U[idx] = silu_acc(a);
        }
        for (int sidx = gtid; sidx < NCH * 16; sidx += NT) {
            const int q = sidx >> 4, dh = sidx & 15, dir = dh >> 3;
            const int r0 = chunk_row0(q);
            const float A = -expf(P.a_log[dh]), bias = P.dt_bias[dh];
            float cs = 0.f;
            if (dir == 0) {
                for (int i = 0; i < 128; ++i) { const float dt = softplus_f(PR[(size_t)(r0 + i) * INC + C_DT + dh] + bias); DT[(r0 + i) * 16 + dh] = dt; cs += dt * A; ACS[(q * 16 + dh) * 128 + i] = cs; }
            } else {
                for (int i = 127; i >= 0; --i) { const float dt = softplus_f(PR[(size_t)(r0 + i) * INC + C_DT + dh] + bias); DT[(r0 + i) * 16 + dh] = dt; cs += dt * A; ACS[(q * 16 + dh) * 128 + i] = cs; }
            }
            AL[q * 16 + dh] = cs;
        }
    }
    SEAM(4);
    if (IN(5)) {
        for (size_t idx = gtid; idx < (size_t)NCH * 16 * 8192; idx += NT) {
            const int n = (int)(idx & 127), p = (int)((idx >> 7) & 63), dh = (int)((idx >> 13) & 15), q = (int)(idx >> 17);
            const int head = dh & 7, g = head >> 2, r0 = chunk_row0(q);
            const float al = AL[q * 16 + dh];
            const float* acs = ACS + (q * 16 + dh) * 128;
            float a = 0.f;
            for (int j = 0; j < 128; ++j) {
                const float* u = U + (size_t)(r0 + j) * 1024;
                a += u[512 + g * 128 + n] * (expf(al - acs[j]) * DT[(r0 + j) * 16 + dh] * u[head * 64 + p]);
            }
            S[idx] = a;
        }
    }
    SEAM(5);
    if (IN(6)) {
        for (int idx = gtid; idx < NB * 16 * 8192; idx += NT) {
            const int pn = idx & 8191, dh = (idx >> 13) & 15, b = idx >> 17, dir = dh >> 3;
            float h = 0.f;
            const int qa = dir == 0 ? 128 + 2 * b : 129 + 2 * b, qb = dir == 0 ? 129 + 2 * b : 128 + 2 * b;
            h = S[((size_t)qa * 16 + dh) * 8192 + pn];
            h = expf(AL[qb * 16 + dh]) * h + S[((size_t)qb * 16 + dh) * 8192 + pn];
            for (int cc = 0; cc < 64; ++cc) {
                const int q = 64 * b + (dir == 0 ? cc : 63 - cc);
                const size_t o = ((size_t)q * 16 + dh) * 8192 + pn;
                const float tmp = S[o]; S[o] = h; h = expf(AL[q * 16 + dh]) * h + tmp;
            }
        }
    }
    SEAM(6);
    if (IN(7)) {
        LAS float* cb = (LAS float*)lds;
        LAS float* red = cb + 256;
        for (int r = bid; r < ML; r += G) {
            const int q = r >> 7, i = r & 127, r0 = q * 128;
            __syncthreads();
            if (tid < 256) {
                const int g = tid >> 7, j = tid & 127;
                const float* ci = U + (size_t)r * 1024 + 768 + g * 128;
                const float* bj = U + (size_t)(r0 + j) * 1024 + 512 + g * 128;
                float a = 0.f;
                for (int n = 0; n < 128; ++n) a += ci[n] * bj[n];
                cb[tid] = a;
            }
            __syncthreads();
            const int head = tid >> 6, p = tid & 63, g = head >> 2;
            float y = 0.f;
            for (int dir = 0; dir < 2; ++dir) {
                const int dh = dir * 8 + head;
                const float* acs = ACS + (q * 16 + dh) * 128;
                const float ai = acs[i];
                const int j0 = dir == 0 ? 0 : i, j1 = dir == 0 ? i : 127;
                float a = 0.f;
                for (int j = j0; j <= j1; ++j) a += cb[g * 128 + j] * expf(ai - acs[j]) * DT[(r0 + j) * 16 + dh] * U[(size_t)(r0 + j) * 1024 + head * 64 + p];
                const float* hp = S + ((size_t)q * 16 + dh) * 8192 + p * 128;
                const float* ci = U + (size_t)r * 1024 + 768 + g * 128;
                float off = 0.f;
                for (int n = 0; n < 128; ++n) off += ci[n] * hp[n];
                y += a + expf(ai) * off;
            }
            y += P.d_skip[head] * U[(size_t)r * 1024 + tid];
            y *= silu_acc(PR[(size_t)r * INC + C_Z + tid]);
            const float ss = wave_sum(y * y);
            if (lane == 0) red[wave] = ss;
            __syncthreads();
            float tot = 0.f;
#pragma unroll
            for (int w = 0; w < 8; ++w) tot += red[w];
            MIX[(size_t)r * 1024 + tid] = y * rsqrtf(tot * (1.f / 512.f) + EPS) * P.ssd_norm[tid];
        }
        __syncthreads();
        LAS float* qs = (LAS float*)lds + wave * 640;
        LAS float* sc = qs + 64;
        for (int it = gw; it < ML * 8; it += NGW) {
            const int r = it >> 3, hq = it & 7, kvh = hq >> 2, b = r / SEQ, pos = r % SEQ;
            {
                const float* qp = PR + (size_t)r * INC + C_Q + hq * 64;
                const float qv = qp[lane], qo = qp[lane ^ 32];
                const float cs = ROPEC[pos * 32 + (lane & 31)], sn = ROPES[pos * 32 + (lane & 31)];
                qs[lane] = (qv * cs + (lane < 32 ? -qo : qo) * sn) * 0.125f;
            }
            __builtin_amdgcn_wave_barrier();
            const int klo = pos - 128 < 0 ? 0 : pos - 128, khi = pos + 128 > SEQ - 1 ? SEQ - 1 : pos + 128;
            const int nloc = khi - klo + 1, nk = nloc + CTXL;
            float mx = P.sinks[hq];
            for (int kk = lane; kk < nk; kk += 64) {
                float s = 0.f;
                if (kk < nloc) {
                    const int kp = klo + kk;
                    const float* kr = PR + (size_t)(b * SEQ + kp) * INC + C_K + kvh * 64;
                    for (int d = 0; d < 32; ++d) {
                        const float cs = ROPEC[kp * 32 + d], sn = ROPES[kp * 32 + d];
                        const float k0 = kr[d], k1 = kr[d + 32];
                        s += qs[d] * (k0 * cs - k1 * sn) + qs[d + 32] * (k1 * cs + k0 * sn);
                    }
                } else {
                    const float* kr = PR + (size_t)(ML + b * CTXL + (kk - nloc)) * INC + C_K + kvh * 64;
                    for (int d = 0; d < 64; ++d) s += qs[d] * kr[d];
                }
                sc[kk] = s; mx = fmaxf(mx, s);
            }
            __builtin_amdgcn_wave_barrier();
            mx = wave_max(mx);
            float sum = 0.f;
            for (int kk = lane; kk < nk; kk += 64) { const float e = expf(sc[kk] - mx); sc[kk] = e; sum += e; }
            sum = wave_sum(sum) + expf(P.sinks[hq] - mx);
            const float inv = 1.f / sum;
            __builtin_amdgcn_wave_barrier();
            float o = 0.f;
            for (int kk = 0; kk < nk; ++kk) {
                const int row = kk < nloc ? b * SEQ + klo + kk : ML + b * CTXL + (kk - nloc);
                o += sc[kk] * PR[(size_t)row * INC + C_V + kvh * 64 + lane];
            }
            MIX[(size_t)r * 1024 + 512 + hq * 64 + lane] = o * inv;
            __builtin_amdgcn_wave_barrier();
        }
    }
    SEAM(7);
    if (IN(8)) {
        const int ntiles = (ML / 128) * 8;
        for (int t = bid; t < ntiles; t += G) {
            const int tm = t >> 3, tn = t & 7;
            float acc[4][8];
            const float* A0 = MIX + (size_t)tm * 128 * DM;
            sgemm_tile(acc, (LAS float*)lds, [&](int i) { return A0 + (size_t)i * DM; }, P.w_out, DM, DM, tn * 128, DM);
            const int ty = tid >> 4, tx = tid & 15;
#pragma unroll
            for (int i = 0; i < 4; ++i) {
                const int m = tm * 128 + ty * 4 + i;
                const float* g1 = MOD + (m / SEQ) * 6144 + 2048;
#pragma unroll
                for (int j = 0; j < 8; ++j) { const int n = tn * 128 + tx * 8 + j; X1[(size_t)m * DM + n] = P.x[(size_t)m * DM + n] + g1[n] * acc[i][j]; }
            }
        }
    }
    SEAM(8);
    if (IN(9)) {
        for (int r = gw; r < ML; r += NGW) {
            const float* mod = MOD + (r / SEQ) * 6144;
            f32x4 v[4]; float s = 0.f;
#pragma unroll
            for (int j = 0; j < 4; ++j) { v[j] = *(const f32x4*)(X1 + (size_t)r * DM + j * 256 + lane * 4); s += v[j].x * v[j].x + v[j].y * v[j].y + v[j].z * v[j].z + v[j].w * v[j].w; }
            const float rstd = rsqrtf(wave_sum(s) * (1.f / DM) + EPS);
            LAS float* hrow = (LAS float*)lds + wave * 1024;
#pragma unroll
            for (int j = 0; j < 4; ++j) {
                const int c0 = j * 256 + lane * 4;
                const f32x4 g = *(const f32x4*)(P.norm2 + c0), sh = *(const f32x4*)(mod + 3072 + c0), scv = *(const f32x4*)(mod + 4096 + c0);
                f32x4 o;
                o.x = v[j].x * rstd * g.x * (1.f + scv.x) + sh.x; o.y = v[j].y * rstd * g.y * (1.f + scv.y) + sh.y;
                o.z = v[j].z * rstd * g.z * (1.f + scv.z) + sh.z; o.w = v[j].w * rstd * g.w * (1.f + scv.w) + sh.w;
                *(f32x4*)(H2 + (size_t)r * DM + c0) = o;
                *(LAS f32x4*)(hrow + c0) = o;
            }
            __builtin_amdgcn_wave_barrier();
            float accl = 0.f;
            if (lane < 36) {
                const float* wp = lane < 4 ? P.w_group + lane : P.w_expert + (lane - 4);
                const int st = lane < 4 ? 4 : 32;
#pragma unroll 8
                for (int k = 0; k < DM; ++k) accl += hrow[k] * wp[(size_t)k * st];
            }
            __builtin_amdgcn_wave_barrier();
            float lg[36];
#pragma unroll
            for (int e = 0; e < 36; ++e) lg[e] = __shfl(accl, e);
            if (lane == 0) {
                float gl[4]; float gm = -INFINITY; int gi = 0;
#pragma unroll
                for (int e = 0; e < 4; ++e) { gl[e] = lg[e] + P.b_group[e]; if (gl[e] > gm) { gm = gl[e]; gi = e; } }
                float gs = 0.f;
#pragma unroll
                for (int e = 0; e < 4; ++e) gs += expf(gl[e] - gm);
                const float gwt = 1.f / gs;
                float el[8]; float em = -INFINITY; int e1 = 0;
#pragma unroll
                for (int e = 0; e < 8; ++e) {
                    float vsel = 0.f;
#pragma unroll
                    for (int gg = 0; gg < 4; ++gg) if (gg == gi) vsel = lg[4 + gg * 8 + e] + P.b_expert[gg * 8 + e];
                    el[e] = vsel; if (vsel > em) { em = vsel; e1 = e; }
                }
                float em2 = -INFINITY; int e2 = 0;
#pragma unroll
                for (int e = 0; e < 8; ++e) if (e != e1 && el[e] > em2) { em2 = el[e]; e2 = e; }
                const float p2 = expf(em2 - em);
                const float w1 = gwt / (1.f + p2), w2 = gwt * p2 / (1.f + p2);
                const int ex1 = gi * 8 + e1, ex2 = gi * 8 + e2;
                const unsigned pos1 = atomicAdd(&CNT[ex1], 1u); LIST[ex1 * ML + pos1] = r * 2 + 0; EW[r * 2 + 0] = w1;
                const unsigned pos2 = atomicAdd(&CNT[ex2], 1u); LIST[ex2 * ML + pos2] = r * 2 + 1; EW[r * 2 + 1] = w2;
            }
        }
    }
    SEAM(9);
    if (IN(10)) {
        int t = bid;
        int base = 0;
        for (int e = 0; e < NE; ++e) {
            const int cnt = (int)CNT[e];
            const int nt = ((cnt + 127) >> 7) * 4;
            for (; t < base + nt; t += G) {
                const int lt = t - base, rt = lt >> 2, ct = lt & 3;
                const int* lst = LIST + e * ML + rt * 128;
                const int nvalid = cnt - rt * 128;
                float ag[4][8], au[4][8];
                auto rp = [&](int i) -> const float* { return i < nvalid ? H2 + (size_t)(lst[i] >> 1) * DM : nullptr; };
                sgemm_tile(ag, (LAS float*)lds, rp, P.w_gate + (size_t)e * DM * EDIM, EDIM, DM, ct * 128, EDIM);
                sgemm_tile(au, (LAS float*)lds, rp, P.w_up + (size_t)e * DM * EDIM, EDIM, DM, ct * 128, EDIM);
                const int ty = tid >> 4, tx = tid & 15;
#pragma unroll
                for (int i = 0; i < 4; ++i) {
                    const int li = ty * 4 + i;
                    if (li < nvalid) {
                        const int aid = lst[li];
#pragma unroll
                        for (int j = 0; j < 8; ++j) ACT[(size_t)aid * EDIM + ct * 128 + tx * 8 + j] = silu_acc(ag[i][j]) * au[i][j];
                    }
                }
            }
            base += nt;
        }
    }
    SEAM(10);
    if (IN(11)) {
        int t = bid;
        int base = 0;
        for (int e = 0; e < NE; ++e) {
            const int cnt = (int)CNT[e];
            const int nt = ((cnt + 127) >> 7) * 8;
            for (; t < base + nt; t += G) {
                const int lt = t - base, rt = lt >> 3, ct = lt & 7;
                const int* lst = LIST + e * ML + rt * 128;
                const int nvalid = cnt - rt * 128;
                float acc[4][8];
                auto rp = [&](int i) -> const float* { return i < nvalid ? ACT + (size_t)lst[i] * EDIM : nullptr; };
                sgemm_tile(acc, (LAS float*)lds, rp, P.w_down + (size_t)e * EDIM * DM, DM, EDIM, ct * 128, DM);
                const int ty = tid >> 4, tx = tid & 15;
#pragma unroll
                for (int i = 0; i < 4; ++i) {
                    const int li = ty * 4 + i;
                    if (li < nvalid) {
                        const int aid = lst[li];
#pragma unroll
                        for (int j = 0; j < 8; ++j) Y[(size_t)aid * DM + ct * 128 + tx * 8 + j] = acc[i][j];
                    }
                }
            }
            base += nt;
        }
    }
    SEAM(11);
    if (IN(12)) {
        for (int r = gw; r < ML; r += NGW) {
            const float* g2 = MOD + (r / SEQ) * 6144 + 5120;
            const float w0 = EW[r * 2], w1 = EW[r * 2 + 1];
            f32x4 v[4]; float s = 0.f;
#pragma unroll
            for (int j = 0; j < 4; ++j) {
                const int c0 = j * 256 + lane * 4;
                const f32x4 xv = *(const f32x4*)(X1 + (size_t)r * DM + c0), y0 = *(const f32x4*)(Y + (size_t)(r * 2) * DM + c0), y1 = *(const f32x4*)(Y + (size_t)(r * 2 + 1) * DM + c0);
                const f32x4 gg = *(const f32x4*)(g2 + c0);
                v[j].x = xv.x + gg.x * (w0 * y0.x + w1 * y1.x); v[j].y = xv.y + gg.y * (w0 * y0.y + w1 * y1.y);
                v[j].z = xv.z + gg.z * (w0 * y0.z + w1 * y1.z); v[j].w = xv.w + gg.w * (w0 * y0.w + w1 * y1.w);
                s += v[j].x * v[j].x + v[j].y * v[j].y + v[j].z * v[j].z + v[j].w * v[j].w;
            }
            const float rstd = rsqrtf(wave_sum(s) * (1.f / DM) + EPS);
#pragma unroll
            for (int j = 0; j < 4; ++j) {
                const int c0 = j * 256 + lane * 4;
                const f32x4 nf = *(const f32x4*)(P.norm_final + c0);
                f32x4 o; o.x = v[j].x * rstd * nf.x; o.y = v[j].y * rstd * nf.y; o.z = v[j].z * rstd * nf.z; o.w = v[j].w * rstd * nf.w;
                *(f32x4*)(P.out + (size_t)r * DM + c0) = o;
            }
        }
    }
#undef IN
#undef SEAM
}

#ifndef N_LAUNCHES
#define N_LAUNCHES 1
#endif
constexpr int N_PHASES = 13;

extern "C" void kernel_launch(void* const* d_in, const int* in_sizes, int n_in, void* d_out, int out_size, void* d_ws, size_t ws_size, hipStream_t stream) {
    static int grid = 0;
    if (grid == 0) {
        if (n_in != 25 || out_size != ML * DM || ws_size < WS_END) { fprintf(stderr, "kernel_launch: unexpected problem (n_in %d out %d ws %zu need %zu)\n", n_in, out_size, ws_size, (size_t)WS_END); grid = -1; return; }
        int dev = 0, cus = 0, per_cu = 0;
        hipGetDevice(&dev);
        hipDeviceGetAttribute(&cus, hipDeviceAttributeMultiprocessorCount, dev);
        hipFuncSetAttribute((const void*)fwd_kernel, hipFuncAttributeMaxDynamicSharedMemorySize, LDS_BYTES);
        hipOccupancyMaxActiveBlocksPerMultiprocessor(&per_cu, (const void*)fwd_kernel, NTHREADS, LDS_BYTES);
        (void)hipGetLastError();
        if (per_cu < 1) { fprintf(stderr, "kernel_launch: occupancy query says %d\n", per_cu); }
        grid = cus;
    }
    if (grid < 0) return;
    hipMemsetAsync((char*)d_ws + WS_CTL, 0, CTL_ZERO_BYTES, stream);
    Args a{};
    const float** pp = (const float**)&a.p;
    for (int i = 0; i < 25; ++i) pp[i] = (const float*)d_in[i];
    a.p.out = (float*)d_out; a.p.ws = (unsigned char*)d_ws;
    if (N_LAUNCHES == 1) {
        a.ph_lo = 0; a.ph_hi = N_PHASES;
        hipLaunchKernelGGL(fwd_kernel, dim3(grid), dim3(NTHREADS), LDS_BYTES, stream, a);
    } else {
        for (int ph = 0; ph < N_PHASES; ++ph) { a.ph_lo = ph; a.ph_hi = ph + 1; hipLaunchKernelGGL(fwd_kernel, dim3(grid), dim3(NTHREADS), LDS_BYTES, stream, a); }
    }
}
```

```cpp
#include <hip/hip_runtime.h>
#include <cstdio>
#include <cstdint>

constexpr int DM = 1024, SEQ = 8192, NB = 2, CTXL = 256;
constexpr int ML = NB * SEQ;
constexpr int MC = NB * CTXL;
constexpr int MT = ML + MC;
constexpr int INC = 2320;
constexpr int PC = 2304;
constexpr int C_Z = 0, C_XBC = 512, C_Q = 1536, C_K = 2048, C_V = 2176;
constexpr int NCH = 132;
constexpr int NE = 32, EDIM = 512;
constexpr int MAXSLOT = 40960;
constexpr float EPS = 1e-6f;

constexpr size_t MiB = 1u << 20;
constexpr size_t WS_CTL = 0, CTL_ZERO_BYTES = 64 * 1024;
constexpr size_t WS_MODP = 1 * MiB;
constexpr size_t WS_MOD = WS_MODP + 16 * 3 * 6144 * 4;
constexpr size_t WS_ROPE = 3 * MiB;
constexpr size_t WS_DT = 5 * MiB;
constexpr size_t WS_ACS = 6 * MiB + 512 * 1024;
constexpr size_t WS_AL = 8 * MiB;
constexpr size_t WS_EW = 8 * MiB + 64 * 1024;
constexpr size_t WS_RSTD = 8 * MiB + 256 * 1024;
constexpr size_t WS_EID = 8 * MiB + 512 * 1024;
constexpr size_t WS_POS = 9 * MiB;
constexpr size_t WS_S2A = 10 * MiB;
constexpr size_t WS_WIN = 12 * MiB;
constexpr size_t WS_WOUT = 17 * MiB;
constexpr size_t WS_WGU = 20 * MiB;
constexpr size_t WS_WD = 84 * MiB;
constexpr size_t WS_HX = 116 * MiB;
constexpr size_t WS_P = 149 * MiB;
constexpr size_t WS_U = WS_P + (size_t)MT * PC * 2;
constexpr size_t WS_ACT = 229 * MiB;
constexpr size_t WS_S = WS_U + 33 * MiB;
constexpr size_t WS_END = WS_S + 33 * MiB;
static_assert(WS_END <= 292 * MiB, "ws budget");
static_assert(WS_P + (size_t)MAXSLOT * 1024 * 2 <= WS_ACT, "HS fits below ACT");
constexpr int CW_CNT = 64;
constexpr int CW_BAR = 1024;

constexpr int LDS_BYTES = 147456;
constexpr int LDS_TAB = 131072;
constexpr int NTHREADS = 512;

#define LAS __attribute__((address_space(3)))
typedef unsigned short bf16;

#define XB_TMO      128
#define XB_XCNT(j)  (256  + 64 * (j))
#define XB_XSUB(j)  (1280 + 64 * (j))
#define XB_XGEN(j)  (2304 + 64 * (j))
#define XB_TOP      3328
#define XB_TOPGEN   3392
#define XCD_BAR_WORDS 3456
#define XB_SPIN_CAP (1u << 18)
__device__ __forceinline__ unsigned xb_ld(unsigned* p)              { return __hip_atomic_load(p, __ATOMIC_RELAXED, __HIP_MEMORY_SCOPE_AGENT); }
__device__ __forceinline__ unsigned xb_add(unsigned* p, unsigned v) { return __hip_atomic_fetch_add(p, v, __ATOMIC_RELAXED, __HIP_MEMORY_SCOPE_AGENT); }
__device__ __forceinline__ unsigned xb_xcc_id() { return (unsigned)__builtin_amdgcn_s_getreg((3 << 11) | 20) & 0xFu; }
#define XB_SPIN(cond, bar) do { unsigned _sp = 0; while (cond) { __builtin_amdgcn_s_sleep(1); \
    if ((++_sp & 255u) == 0u) { if (xb_ld(&(bar)[XB_TMO])) break; if (_sp > XB_SPIN_CAP) { atomicAdd(&(bar)[XB_TMO], 1u); break; } } } } while (0)
struct XcdBarrier { unsigned* bar; unsigned x; volatile LAS unsigned* st; };
__device__ __forceinline__ XcdBarrier xcd_barrier_post(unsigned* bar, volatile LAS unsigned* st) {
    XcdBarrier b; b.bar = bar; b.x = xb_xcc_id(); b.st = st;
    if (threadIdx.x == 0) (void)xb_add(&bar[XB_XCNT(b.x)], 1u);
    return b;
}
__device__ __forceinline__ void xcd_barrier_complete(unsigned* bar, unsigned x, unsigned& nloc, unsigned& nx) {
    const unsigned G = gridDim.x * gridDim.y * gridDim.z;
    unsigned sum, cnt, mine, sp = 0u;
    for (;;) {
        sum = 0u; cnt = 0u; mine = 0u;
#pragma unroll
        for (unsigned j = 0; j < 16; ++j) { const unsigned c = xb_ld(&bar[XB_XCNT(j)]); sum += c; cnt += (c > 0u) ? 1u : 0u; mine = (j == x) ? c : mine; }
        if (sum == G) break;
        __builtin_amdgcn_s_sleep(1);
        if ((++sp & 255u) == 0u) { if (xb_ld(&bar[XB_TMO])) break; if (sp > XB_SPIN_CAP) { atomicAdd(&bar[XB_TMO], 1u); break; } }
    }
    nloc = mine > 0u ? mine : 1u; nx = cnt > 0u ? cnt : 1u;
}
__device__ __forceinline__ void xcd_barrier(const XcdBarrier& b) {
    asm volatile("s_waitcnt vmcnt(0)" ::: "memory");
    __syncthreads();
    if (threadIdx.x == 0) {
        unsigned* bar = b.bar;
        __builtin_amdgcn_s_waitcnt(0);
        unsigned nloc = b.st[0], nx = b.st[1];
        if (nloc == 0u) { xcd_barrier_complete(bar, b.x, nloc, nx); b.st[0] = nloc; b.st[1] = nx; }
        const unsigned old = xb_add(&bar[XB_XSUB(b.x)], 1u);
        const unsigned gen = old / nloc;
        if (old + 1u == (gen + 1u) * nloc) {
            __builtin_amdgcn_fence(__ATOMIC_RELEASE, "agent");
            asm volatile("s_waitcnt vmcnt(0)" ::: "memory");
            const unsigned og = xb_add(&bar[XB_TOP], 1u);
            const unsigned tg = og / nx;
            if (og + 1u == (tg + 1u) * nx) xb_add(&bar[XB_TOPGEN], 1u);
            else XB_SPIN(xb_ld(&bar[XB_TOPGEN]) == tg, bar);
            __builtin_amdgcn_fence(__ATOMIC_ACQUIRE, "agent");
            xb_add(&bar[XB_XGEN(b.x)], 1u);
            asm volatile("s_waitcnt vmcnt(0)" ::: "memory");
        } else {
            XB_SPIN(xb_ld(&bar[XB_XGEN(b.x)]) == gen, bar);
            __builtin_amdgcn_fence(__ATOMIC_ACQUIRE, "agent");
            asm volatile("s_waitcnt vmcnt(0)" ::: "memory");
        }
    }
    __syncthreads();
}


namespace pg8 {
#define PG8_LAS __attribute__((address_space(3)))
typedef unsigned short bf16_t;
typedef short bf16x8 __attribute__((ext_vector_type(8)));
typedef float f32x4 __attribute__((ext_vector_type(4)));
typedef unsigned u32x4 __attribute__((ext_vector_type(4)));
constexpr int BM = 256, BK = 64, HALF = 128, HTB = HALF * BK * 2  , STAGE_BYTES = 8 * HTB, NXCD = 8, WGM = 8;

__host__ __device__ __forceinline__ int lds_byte(int r, int c) { const int st = (r >> 4) * 2 + (c >> 5), rr = r & 15, cc = c & 31, ob = rr * 64 + cc * 2; return st * 1024 + (ob ^ (((ob >> 9) & 1) << 5)); }
__host__ __device__ __forceinline__ void stage_rc(int b, int& R, int& C) { const int st = b / 1024, sb = b % 1024, swz = sb ^ (((sb >> 9) & 1) << 5); R = (st >> 1) * 16 + swz / 64; C = (st & 1) * 32 + (swz % 64) / 2; }
__host__ __device__ __forceinline__ int perm32(int rho) { const int n = rho >> 4, i = rho & 15; return 8 * (i >> 2) + 4 * n + (i & 3); }

struct Unit { int pm, pn; };
struct Gemm { const bf16_t* A; const bf16_t* Bt; int M, N, K; };

struct StaticOrder {
    int nM, nN, nwg, G, c;
    __host__ __device__ void init(int M, int N, int G_, int c_) { nM = M / BM; nN = N / BM; nwg = nM * nN; G = G_; c = c_; }
    __host__ __device__ bool next(int i, Unit& u) const {
        const long L = (long)i * G + c; if (L >= nwg) return false;
        int wgid = (int)L; { const int q = nwg / NXCD, r = nwg % NXCD, xcd = wgid % NXCD, off = wgid / NXCD; wgid = (xcd < r ? xcd * (q + 1) : r * (q + 1) + (xcd - r) * q) + off; }
        const int nig = WGM * nN, gid = wgid / nig, fm = gid * WGM, gsz = (nM - fm) < WGM ? (nM - fm) : WGM;
        u.pm = fm + ((wgid % nig) % gsz); u.pn = (wgid % nig) / gsz; return true;
    }
    __device__ __forceinline__ void a_ready(const Unit&) const {}
    __device__ __forceinline__ void done(const Unit&) const {}
};

__device__ __forceinline__ unsigned cvt_pk_bf16(float lo, float hi) { unsigned r; asm volatile("v_cvt_pk_bf16_f32 %0, %1, %2" : "=v"(r) : "v"(lo), "v"(hi)); return r; }
typedef float f32x2 __attribute__((ext_vector_type(2)));
template <class Epi, class Sched, bool ALIGN_EPI = false, bool SP2 = false>
__device__ __forceinline__ void gemm_phase(PG8_LAS unsigned char* lds, const Gemm g, const Sched& S, const Epi& E) {
    const int tid = threadIdx.x, wid = __builtin_amdgcn_readfirstlane(tid >> 6), lane = tid & 63, wr = wid >> 2, wc = wid & 3, fr = lane & 15, fq = lane >> 4;
    const int K = g.K, nt = K / BK;
    unsigned voffA[2], voffB[2];
#pragma unroll
    for (int i = 0; i < 2; ++i) { int R, C; stage_rc(tid * 16 + i * 8192, R, C); const int Rb = Epi::PERM ? ((R & ~31) + perm32(R & 31)) : R;
        voffA[i] = (unsigned)(R * K + C) * 2u; voffB[i] = (unsigned)(Rb * K + C) * 2u; }
    const size_t kstep = (size_t)(BK * 2);
    const size_t hstep = (size_t)HALF * K * 2;
    const size_t tstep = 2 * hstep;
    const unsigned ldsw = (unsigned)wid * 1024u;
    const int aoff = lds_byte(wr * 64 + fr, fq * 8), boff = lds_byte(wc * 32 + fr, fq * 8);
#define PG8_SA(b, h) (((b) * 2 + (h)) * HTB)
#define PG8_SB(b, h) ((4 + (b) * 2 + (h)) * HTB)
#define PG8_STAGE(bufoff, gbase, voff) do { _Pragma("unroll") for (int _i = 0; _i < 2; ++_i) \
        __builtin_amdgcn_global_load_lds((const unsigned*)((const char*)(gbase) + (voff)[_i]), (PG8_LAS unsigned*)(lds + (bufoff) + ldsw + _i * 8192), 16, 0, 0); } while (0)
#define PG8_LDA(dst, b, h) do { _Pragma("unroll") for (int m = 0; m < 4; ++m) _Pragma("unroll") for (int k = 0; k < 2; ++k) dst[m][k] = *(const PG8_LAS bf16x8*)(lds + PG8_SA(b, h) + aoff + m * 2048 + k * 1024); } while (0)
#define PG8_LDB(dst, b, h) do { _Pragma("unroll") for (int n = 0; n < 2; ++n) _Pragma("unroll") for (int k = 0; k < 2; ++k) dst[n][k] = *(const PG8_LAS bf16x8*)(lds + PG8_SB(b, h) + boff + n * 2048 + k * 1024); } while (0)
#define PG8_MMA(ai, bj, At, Bt) do { __builtin_amdgcn_s_setprio(1); _Pragma("unroll") for (int m = 0; m < 4; ++m) _Pragma("unroll") for (int n = 0; n < 2; ++n) _Pragma("unroll") for (int k = 0; k < 2; ++k) \
        acc[ai][bj][m][n] = __builtin_amdgcn_mfma_f32_16x16x32_bf16(Bt[n][k], At[m][k], acc[ai][bj][m][n], 0, 0, 0); __builtin_amdgcn_s_setprio(0); } while (0)
#define PG8_WAIT_V(n) asm volatile("s_waitcnt vmcnt(" #n ")" ::: "memory")
#define PG8_WAIT_L(n) asm volatile("s_waitcnt lgkmcnt(" #n ")" ::: "memory")
#define PG8_BAR __builtin_amdgcn_s_barrier()
#define PG8_SCHED __builtin_amdgcn_sched_barrier(0)
    Unit cur, nxt; int ui = 0;
    if (!S.next(0, cur)) return;
    f32x4 acc[2][2][4][2];
#pragma unroll
    for (int a = 0; a < 2; ++a)
#pragma unroll
        for (int b = 0; b < 2; ++b)
#pragma unroll
            for (int m = 0; m < 4; ++m)
#pragma unroll
                for (int n = 0; n < 2; ++n) acc[a][b][m][n] = (f32x4){0.f, 0.f, 0.f, 0.f};
    bf16x8 At[4][2], B0[2][2], B1[2][2];
    const char* cA = (const char*)g.A + (size_t)cur.pm * tstep; const char* cB = (const char*)g.Bt + (size_t)cur.pn * tstep;
    S.a_ready(cur);
    if constexpr (SP2) {
        PG8_STAGE(PG8_SB(0, 0), cB, voffB); PG8_STAGE(PG8_SB(0, 1), cB + hstep, voffB); PG8_STAGE(PG8_SA(0, 0), cA, voffA); PG8_STAGE(PG8_SA(0, 1), cA + hstep, voffA);
        if (wr == 1) PG8_BAR;
        PG8_WAIT_V(2); PG8_BAR;
        PG8_STAGE(PG8_SB(1, 0), cB + kstep, voffB); PG8_STAGE(PG8_SA(1, 0), cA + kstep, voffA); PG8_STAGE(PG8_SB(1, 1), cB + hstep + kstep, voffB);
        PG8_WAIT_V(6); PG8_BAR;
    } else {
        PG8_STAGE(PG8_SB(0, 0), cB, voffB); PG8_STAGE(PG8_SA(0, 0), cA, voffA); PG8_STAGE(PG8_SB(0, 1), cB + hstep, voffB); PG8_STAGE(PG8_SA(0, 1), cA + hstep, voffA);
        if (wr == 1) PG8_BAR;
        PG8_WAIT_V(4); PG8_BAR;
        PG8_STAGE(PG8_SB(1, 0), cB + kstep, voffB); PG8_STAGE(PG8_SA(1, 0), cA + kstep, voffA); PG8_STAGE(PG8_SB(1, 1), cB + hstep + kstep, voffB);
        PG8_WAIT_V(6); PG8_BAR;
    }
    for (;;) {
        const bool has_next = S.next(ui + 1, nxt);
        const char* nA = has_next ? (const char*)g.A + (size_t)nxt.pm * tstep : cA; const char* nB = has_next ? (const char*)g.Bt + (size_t)nxt.pn * tstep : cB;
        for (int t = 0; t < nt; t += 2) {
            const bool last = (t == nt - 2);
            const char* a1 = cA + (size_t)(t + 1) * kstep;
            const char* a2 = last ? nA : cA + (size_t)(t + 2) * kstep; const char* b2 = last ? nB : cB + (size_t)(t + 2) * kstep;
            const char* a3 = a2 + kstep; const char* b3 = b2 + kstep;
            if (last && has_next) S.a_ready(nxt);
            if constexpr (SP2) {
            PG8_LDB(B0, 0, 0); PG8_LDB(B1, 0, 1); PG8_SCHED; PG8_LDA(At, 0, 0); PG8_STAGE(PG8_SA(1, 1), a1 + hstep, voffA);
            PG8_WAIT_V(8); PG8_WAIT_L(0); PG8_BAR; PG8_MMA(0, 0, At, B0); PG8_MMA(0, 1, At, B1); PG8_BAR; PG8_SCHED;
            PG8_LDA(At, 0, 1); PG8_STAGE(PG8_SB(0, 0), b2, voffB); PG8_STAGE(PG8_SB(0, 1), b2 + hstep, voffB); PG8_STAGE(PG8_SA(0, 0), a2, voffA);
            PG8_WAIT_V(8); PG8_WAIT_L(0); PG8_BAR; PG8_MMA(1, 0, At, B0); PG8_MMA(1, 1, At, B1); PG8_BAR; PG8_SCHED;
            PG8_LDB(B0, 1, 0); PG8_LDB(B1, 1, 1); PG8_SCHED; PG8_LDA(At, 1, 0); PG8_STAGE(PG8_SA(0, 1), a2 + hstep, voffA);
            PG8_WAIT_V(8); PG8_WAIT_L(0); PG8_BAR; PG8_MMA(0, 0, At, B0); PG8_MMA(0, 1, At, B1); PG8_BAR; PG8_SCHED;
            PG8_LDA(At, 1, 1); PG8_STAGE(PG8_SB(1, 0), b3, voffB); PG8_STAGE(PG8_SB(1, 1), b3 + hstep, voffB); PG8_STAGE(PG8_SA(1, 0), a3, voffA);
            PG8_WAIT_V(8); PG8_WAIT_L(0); PG8_BAR; PG8_MMA(1, 0, At, B0); PG8_MMA(1, 1, At, B1); PG8_BAR; PG8_SCHED;
            } else {
            PG8_LDB(B0, 0, 0); PG8_SCHED; PG8_LDA(At, 0, 0); PG8_STAGE(PG8_SA(1, 1), a1 + hstep, voffA);
            PG8_WAIT_L(8); PG8_BAR; PG8_WAIT_L(0); PG8_MMA(0, 0, At, B0); PG8_BAR; PG8_SCHED;
            PG8_LDB(B1, 0, 1); PG8_STAGE(PG8_SB(0, 0), b2, voffB);
            PG8_BAR; PG8_WAIT_L(0); PG8_MMA(0, 1, At, B1); PG8_BAR;
            PG8_LDA(At, 0, 1); PG8_STAGE(PG8_SA(0, 0), a2, voffA);
            PG8_BAR; PG8_WAIT_L(0); PG8_MMA(1, 0, At, B0); PG8_BAR; PG8_SCHED;
            PG8_STAGE(PG8_SB(0, 1), b2 + hstep, voffB);
            PG8_WAIT_V(6); PG8_BAR; PG8_MMA(1, 1, At, B1); PG8_BAR;
            PG8_LDB(B0, 1, 0); PG8_SCHED; PG8_LDA(At, 1, 0); PG8_STAGE(PG8_SA(0, 1), a2 + hstep, voffA);
            PG8_WAIT_L(8); PG8_BAR; PG8_WAIT_L(0); PG8_MMA(0, 0, At, B0); PG8_BAR; PG8_SCHED;
            PG8_LDB(B1, 1, 1); PG8_STAGE(PG8_SB(1, 0), b3, voffB);
            PG8_BAR; PG8_WAIT_L(0); PG8_MMA(0, 1, At, B1); PG8_BAR;
            PG8_LDA(At, 1, 1); PG8_STAGE(PG8_SA(1, 0), a3, voffA);
            PG8_BAR; PG8_WAIT_L(0); PG8_MMA(1, 0, At, B0); PG8_BAR; PG8_SCHED;
            PG8_STAGE(PG8_SB(1, 1), b3 + hstep, voffB);
            PG8_WAIT_V(6); PG8_BAR; PG8_MMA(1, 1, At, B1); PG8_BAR;
            }
        }
        if constexpr (ALIGN_EPI) { if (wr == 0) PG8_BAR; }
        if constexpr (!Epi::AFTER_DRAIN) { E(acc, cur, wr, wc, fr, fq); S.done(cur); }
        if (!has_next) break;
#pragma unroll
        for (int a = 0; a < 2; ++a)
#pragma unroll
            for (int b = 0; b < 2; ++b)
#pragma unroll
                for (int m = 0; m < 4; ++m)
#pragma unroll
                    for (int n = 0; n < 2; ++n) acc[a][b][m][n] = (f32x4){0.f, 0.f, 0.f, 0.f};
        cur = nxt; cA = nA; cB = nB; ++ui;
        if constexpr (ALIGN_EPI) { if (wr == 1) PG8_BAR; }
    }
    PG8_WAIT_V(0);
    if constexpr (!ALIGN_EPI) { if (wr == 0) PG8_BAR; }
    PG8_BAR;
    if constexpr (Epi::AFTER_DRAIN) { E.fused(acc, cur, wr, wc, fr, fq, lds, wid, lane); S.done(cur); }
#undef PG8_SA
#undef PG8_SB
#undef PG8_STAGE
#undef PG8_LDA
#undef PG8_LDB
#undef PG8_MMA
#undef PG8_WAIT_V
#undef PG8_WAIT_L
#undef PG8_BAR
#undef PG8_SCHED
}
}

typedef float f32x4 __attribute__((ext_vector_type(4)));
typedef unsigned u32x4 __attribute__((ext_vector_type(4)));
typedef unsigned u32x2 __attribute__((ext_vector_type(2)));
__device__ __forceinline__ float silu_acc(float x) { return x / (1.f + expf(-x)); }
__device__ __forceinline__ float silu_fast(float x) { return x * __builtin_amdgcn_rcpf(1.f + __expf(-x)); }
__device__ __forceinline__ float softplus_f(float x) { return fmaxf(x, 0.f) + log1pf(expf(-fabsf(x))); }
__device__ __forceinline__ float wave_sum(float v) {
#pragma unroll
    for (int o = 1; o < 64; o <<= 1) v += __shfl_xor(v, o);
    return v;
}
__device__ __forceinline__ float wave_max(float v) {
#pragma unroll
    for (int o = 1; o < 64; o <<= 1) v = fmaxf(v, __shfl_xor(v, o));
    return v;
}
__device__ __forceinline__ float bf2f(bf16 v) { return __uint_as_float((unsigned)v << 16); }
__device__ __forceinline__ float bflo(unsigned w) { return __uint_as_float(w << 16); }
__device__ __forceinline__ float bfhi(unsigned w) { return __uint_as_float(w & 0xffff0000u); }
__device__ __forceinline__ unsigned f2bf(float f) { unsigned u = __float_as_uint(f); return (u + 0x7fffu + ((u >> 16) & 1u)) >> 16; }
__device__ __forceinline__ unsigned pk2(float lo, float hi) { return f2bf(lo) | (f2bf(hi) << 16); }

struct Ptrs {
    const float *x, *c, *ctx, *c_ctx, *w_ada, *b_ada, *norm1, *w_in, *conv_w, *conv_b, *dt_bias, *a_log, *d_skip, *ssd_norm, *sinks,
                *w_out, *norm2, *w_group, *b_group, *w_expert, *b_expert, *w_gate, *w_up, *w_down, *norm_final;
    float* out; unsigned char* ws;
};

__device__ __forceinline__ void transpose_item(const float* W, int ldn, int sn0, int k0, bf16* WT, int Kp, int drow0, LAS float* scr, int lane) {
#pragma unroll 8
    for (int i = 0; i < 32; ++i) { const int kk = 2 * i + (lane >> 5); scr[kk * 33 + (lane & 31)] = W[(size_t)(k0 + kk) * ldn + sn0 + (lane & 31)]; }
    asm volatile("s_waitcnt lgkmcnt(0)" ::: "memory");
    const int c = lane & 7;
#pragma unroll
    for (int j = 0; j < 4; ++j) { const int n = (lane >> 3) + 8 * j; const LAS float* s = scr + (8 * c) * 33 + n;
        u32x4 o; o.x = pk2(s[0 * 33], s[1 * 33]); o.y = pk2(s[2 * 33], s[3 * 33]); o.z = pk2(s[4 * 33], s[5 * 33]); o.w = pk2(s[6 * 33], s[7 * 33]);
        *(u32x4*)(WT + (size_t)(drow0 + n) * Kp + k0 + 8 * c) = o; }
    asm volatile("s_waitcnt lgkmcnt(0)" ::: "memory");
}

__device__ __forceinline__ int chunk_row0(int q) { return q < 128 ? q * 128 : ML + (q - 128) * 128; }

struct EpiStoreBf16 {
    static constexpr bool PERM = true, AFTER_DRAIN = false;
    bf16* O; int ldc;
    __device__ __forceinline__ void operator()(const pg8::f32x4 (&acc)[2][2][4][2], const pg8::Unit& u, int wr, int wc, int fr, int fq) const {
        const int row0 = u.pm * 256 + wr * 64 + fr, col0 = u.pn * 256 + wc * 32 + 8 * fq;
#pragma unroll
        for (int ai = 0; ai < 2; ++ai)
#pragma unroll
            for (int m = 0; m < 4; ++m) { bf16* rowp = O + (size_t)(row0 + ai * 128 + m * 16) * ldc + col0;
#pragma unroll
                for (int bj = 0; bj < 2; ++bj) { const pg8::f32x4 v0 = acc[ai][bj][m][0], v1 = acc[ai][bj][m][1];
                    u32x4 w; w.x = pg8::cvt_pk_bf16(v0[0], v0[1]); w.y = pg8::cvt_pk_bf16(v0[2], v0[3]); w.z = pg8::cvt_pk_bf16(v1[0], v1[1]); w.w = pg8::cvt_pk_bf16(v1[2], v1[3]);
                    *(u32x4*)(rowp + bj * 128) = w; } }
    }
};
struct EpiOutProj {
    static constexpr bool PERM = false, AFTER_DRAIN = false;
    const float* x; const float* mod; float* X1;
    __device__ __forceinline__ void operator()(const pg8::f32x4 (&acc)[2][2][4][2], const pg8::Unit& u, int wr, int wc, int fr, int fq) const {
        const int row0 = u.pm * 256 + wr * 64 + fr, col0 = u.pn * 256 + wc * 32 + 4 * fq;
        const float* g1 = mod + (u.pm * 256 / SEQ) * 6144 + 2048;
        f32x4 gv[2][2];
#pragma unroll
        for (int bj = 0; bj < 2; ++bj)
#pragma unroll
            for (int n = 0; n < 2; ++n) gv[bj][n] = *(const f32x4*)(g1 + col0 + bj * 128 + n * 16);
#pragma unroll
        for (int ai = 0; ai < 2; ++ai)
#pragma unroll
            for (int m = 0; m < 4; ++m) { const size_t off = (size_t)(row0 + ai * 128 + m * 16) * DM + col0;
#pragma unroll
                for (int bj = 0; bj < 2; ++bj)
#pragma unroll
                    for (int n = 0; n < 2; ++n) { const f32x4 xv = *(const f32x4*)(x + off + bj * 128 + n * 16); const f32x4 a = acc[ai][bj][m][n];
                        f32x4 o; o.x = xv.x + gv[bj][n].x * a[0]; o.y = xv.y + gv[bj][n].y * a[1]; o.z = xv.z + gv[bj][n].z * a[2]; o.w = xv.w + gv[bj][n].w * a[3];
                        *(f32x4*)(X1 + off + bj * 128 + n * 16) = o; } }
    }
};
struct EpiGateUp {
    static constexpr bool PERM = true, AFTER_DRAIN = false;
    bf16* ACT;
    __device__ __forceinline__ void operator()(const pg8::f32x4 (&acc)[2][2][4][2], const pg8::Unit& u, int wr, int wc, int fr, int fq) const {
        const int row0 = u.pm * 256 + wr * 64 + fr, col0 = (u.pn & 3) * 128 + wc * 32 + 8 * fq;
#pragma unroll
        for (int ai = 0; ai < 2; ++ai)
#pragma unroll
            for (int m = 0; m < 4; ++m) {
                float r[8];
#pragma unroll
                for (int n = 0; n < 2; ++n)
#pragma unroll
                    for (int i = 0; i < 4; ++i) { const float g = acc[ai][0][m][n][i], up = acc[ai][1][m][n][i]; r[n * 4 + i] = silu_fast(g) * up; }
                u32x4 w; w.x = pg8::cvt_pk_bf16(r[0], r[1]); w.y = pg8::cvt_pk_bf16(r[2], r[3]); w.z = pg8::cvt_pk_bf16(r[4], r[5]); w.w = pg8::cvt_pk_bf16(r[6], r[7]);
                *(u32x4*)(ACT + (size_t)(row0 + ai * 128 + m * 16) * EDIM + col0) = w; }
    }
};
struct EpiDown {
    static constexpr bool PERM = true, AFTER_DRAIN = false;
    bf16* Y; const int* S2A;
    __device__ __forceinline__ void operator()(const pg8::f32x4 (&acc)[2][2][4][2], const pg8::Unit& u, int wr, int wc, int fr, int fq) const {
        const int row0 = u.pm * 256 + wr * 64 + fr, col0 = (u.pn & 3) * 256 + wc * 32 + 8 * fq;
#pragma unroll
        for (int ai = 0; ai < 2; ++ai)
#pragma unroll
            for (int m = 0; m < 4; ++m) { const int aid = S2A[row0 + ai * 128 + m * 16];
                if (aid >= 0) { bf16* rowp = Y + (size_t)aid * DM + col0;
#pragma unroll
                    for (int bj = 0; bj < 2; ++bj) { const pg8::f32x4 v0 = acc[ai][bj][m][0], v1 = acc[ai][bj][m][1];
                        u32x4 w; w.x = pg8::cvt_pk_bf16(v0[0], v0[1]); w.y = pg8::cvt_pk_bf16(v0[2], v0[3]); w.z = pg8::cvt_pk_bf16(v1[0], v1[1]); w.w = pg8::cvt_pk_bf16(v1[2], v1[3]);
                        *(u32x4*)(rowp + bj * 128) = w; } } }
    }
};
struct MoeOrder {
    const LAS int* pexp; int npan, G, c;
    __device__ __forceinline__ bool next(int i, pg8::Unit& u) const {
        const int L = i * G + c; if (L >= npan * 4) return false;
        const int p = L >> 2; u.pm = p; u.pn = pexp[p] * 4 + (L & 3); return true;
    }
    __device__ __forceinline__ void a_ready(const pg8::Unit&) const {}
    __device__ __forceinline__ void done(const pg8::Unit&) const {}
};

struct Args { Ptrs p; int ph_lo, ph_hi; };

__global__ void __launch_bounds__(NTHREADS, 2) fwd_kernel(Args args) {
    extern __shared__ __attribute__((aligned(16))) unsigned char lds_raw[];
    LAS unsigned char* lds = (LAS unsigned char*)lds_raw;
    const Ptrs& P = args.p;
    const int tid = threadIdx.x, lane = tid & 63, wave = __builtin_amdgcn_readfirstlane(tid >> 6);
    const int G = gridDim.x, bid = blockIdx.x;
    const int gtid = bid * NTHREADS + tid, NT = G * NTHREADS;
    const int gw = bid * 8 + wave, NGW = G * 8;
    unsigned char* ws = P.ws;
    unsigned* ctl = (unsigned*)(ws + WS_CTL);
    float* MODP = (float*)(ws + WS_MODP);
    float* MOD = (float*)(ws + WS_MOD);
    float* ROPEC = (float*)(ws + WS_ROPE);
    float* ROPES = ROPEC + 8192 * 32;
    float* DT = (float*)(ws + WS_DT);
    float* ACS = (float*)(ws + WS_ACS);
    float* AL = (float*)(ws + WS_AL);
    float* EW = (float*)(ws + WS_EW);
    float* RSTD = (float*)(ws + WS_RSTD);
    int* EID = (int*)(ws + WS_EID);
    int* POS = (int*)(ws + WS_POS);
    int* S2A = (int*)(ws + WS_S2A);
    bf16* WIN = (bf16*)(ws + WS_WIN);
    bf16* WOUT = (bf16*)(ws + WS_WOUT);
    bf16* WGU = (bf16*)(ws + WS_WGU);
    bf16* WD = (bf16*)(ws + WS_WD);
    bf16* HX = (bf16*)(ws + WS_HX);
    bf16* MIX = (bf16*)(ws + WS_HX);
    bf16* PR = (bf16*)(ws + WS_P);
    bf16* HS = (bf16*)(ws + WS_P);
    bf16* Y = (bf16*)(ws + WS_P);
    bf16* U = (bf16*)(ws + WS_U);
    bf16* ACT = (bf16*)(ws + WS_ACT);
    bf16* S = (bf16*)(ws + WS_S);
    float* X1 = P.out;
    unsigned* CNT = ctl + CW_CNT;

    volatile LAS unsigned* MISC = (volatile LAS unsigned*)(lds + LDS_BYTES - 64);
    if (tid < 16) MISC[tid] = 0u;
    __syncthreads();
    XcdBarrier bar = xcd_barrier_post(ctl + CW_BAR, MISC);
    const int lo = args.ph_lo, hi = args.ph_hi;
#define IN(k) (lo <= (k) && (k) < hi)
#define SEAM(k) do { if (IN(k) && IN((k) + 1)) xcd_barrier(bar); } while (0)

    if (IN(0)) {
        for (int idx = gtid; idx < 16 * 6144; idx += NT) {
            const int ks = idx / 6144, n = idx % 6144;
            float a0 = 0.f, a1 = 0.f, a2 = 0.f;
            for (int k = ks * 64; k < ks * 64 + 64; ++k) {
                const float w = P.w_ada[(size_t)k * 6144 + n];
                a0 += silu_acc(P.c[k]) * w; a1 += silu_acc(P.c[1024 + k]) * w; a2 += silu_acc(P.c_ctx[k]) * w;
            }
            MODP[(ks * 3 + 0) * 6144 + n] = a0; MODP[(ks * 3 + 1) * 6144 + n] = a1; MODP[(ks * 3 + 2) * 6144 + n] = a2;
        }
        for (int idx = gtid; idx < 8192 * 32; idx += NT) {
            const int pos = idx >> 5, f = idx & 31;
            const float inv = powf(10000.0f, -(float)(f & 15) / 16.0f);
            const float ang = (float)((f < 16) ? (pos >> 6) : (pos & 63)) * inv;
            ROPEC[idx] = cosf(ang); ROPES[idx] = sinf(ang);
        }
        LAS float* scr = (LAS float*)(lds + wave * 16384);
        constexpr int I_IN = 72 * 16, I_OUT = 32 * 16, I_GU = 32 * 16 * 16, I_D = 32 * 32 * 8;
        constexpr int NITEMS = I_IN + I_OUT + 2 * I_GU + I_D;
        for (int it = gw; it < NITEMS; it += NGW) {
            int r = it;
            if (r < I_IN) { const int g = r % 72, kb = r / 72, d0 = g * 32; transpose_item(P.w_in, INC, d0 + (d0 >= 1536 ? 16 : 0), kb * 64, WIN, 1024, d0, scr, lane); continue; } r -= I_IN;
            if (r < I_OUT) { const int g = r % 32, kb = r / 32; transpose_item(P.w_out, 1024, g * 32, kb * 64, WOUT, 1024, g * 32, scr, lane); continue; } r -= I_OUT;
            if (r < 2 * I_GU) { const int up = r >= I_GU; if (up) r -= I_GU; const int e = r >> 8, q = r & 255, g = q & 15, kb = q >> 4, c0 = g * 32;
                transpose_item((up ? P.w_up : P.w_gate) + (size_t)e * 1024 * 512, 512, c0, kb * 64, WGU, 1024, e * 1024 + (c0 >> 7) * 256 + (up ? 128 : 0) + (c0 & 127), scr, lane); continue; } r -= 2 * I_GU;
            { const int e = r >> 8, q = r & 255, g = q & 31, kb = q >> 5; transpose_item(P.w_down + (size_t)e * 512 * 1024, 1024, g * 32, kb * 64, WD, 512, e * 1024 + g * 32, scr, lane); }
        }
    }
    SEAM(0);
    if (IN(1)) {
        for (int idx = gtid; idx < 3 * 6144; idx += NT) {
            const int r = idx / 6144, n = idx % 6144;
            float a = P.b_ada[n];
            for (int ks = 0; ks < 16; ++ks) a += MODP[(ks * 3 + r) * 6144 + n];
            MOD[idx] = a;
        }
    }
    SEAM(1);
    if (IN(2)) {
        for (int r = gw; r < MT; r += NGW) {
            const float* src = r < ML ? P.x + (size_t)r * DM : P.ctx + (size_t)(r - ML) * DM;
            const float* mod = MOD + (r < ML ? (r / SEQ) : 2) * 6144;
            f32x4 v[4]; float s = 0.f;
#pragma unroll
            for (int j = 0; j < 4; ++j) { v[j] = *(const f32x4*)(src + j * 256 + lane * 4); s += v[j].x * v[j].x + v[j].y * v[j].y + v[j].z * v[j].z + v[j].w * v[j].w; }
            const float rstd = rsqrtf(wave_sum(s) * (1.f / DM) + EPS);
            float dp[16];
#pragma unroll
            for (int e = 0; e < 16; ++e) dp[e] = 0.f;
#pragma unroll
            for (int j = 0; j < 4; ++j) {
                const int c0 = j * 256 + lane * 4;
                const f32x4 g = *(const f32x4*)(P.norm1 + c0), sh = *(const f32x4*)(mod + c0), sc = *(const f32x4*)(mod + 1024 + c0);
                f32x4 o;
                o.x = v[j].x * rstd * g.x * (1.f + sc.x) + sh.x; o.y = v[j].y * rstd * g.y * (1.f + sc.y) + sh.y;
                o.z = v[j].z * rstd * g.z * (1.f + sc.z) + sh.z; o.w = v[j].w * rstd * g.w * (1.f + sc.w) + sh.w;
                u32x2 w; w.x = pk2(o.x, o.y); w.y = pk2(o.z, o.w);
                *(u32x2*)(HX + (size_t)r * DM + c0) = w;
#pragma unroll
                for (int cc = 0; cc < 4; ++cc) {
                    const float* wr_ = P.w_in + (size_t)(c0 + cc) * INC + 1536;
                    const float hv = o[cc];
#pragma unroll
                    for (int e4 = 0; e4 < 4; ++e4) { const f32x4 wv = *(const f32x4*)(wr_ + e4 * 4);
                        dp[e4 * 4 + 0] += hv * wv.x; dp[e4 * 4 + 1] += hv * wv.y; dp[e4 * 4 + 2] += hv * wv.z; dp[e4 * 4 + 3] += hv * wv.w; }
                }
            }
            float mine = 0.f;
#pragma unroll
            for (int e = 0; e < 16; ++e) { const float t = wave_sum(dp[e]); if (lane == e) mine = t; }
            if (lane < 16) DT[r * 16 + lane] = softplus_f(mine + P.dt_bias[lane]);
        }
    }
    SEAM(2);
    if (IN(3)) {
        pg8::Gemm g{HX, WIN, MT, PC, DM}; pg8::StaticOrder S_; S_.init(MT, PC, G, bid);
        EpiStoreBf16 E{PR, PC};
        pg8::gemm_phase<EpiStoreBf16, pg8::StaticOrder, true, true>(lds, g, S_, E);
    }
    SEAM(3);
    if (IN(4)) {
        for (int idx = gtid; idx < MT * 128; idx += NT) {
            const int r = idx >> 7, c0 = (idx & 127) * 8;
            int s0, sl;
            if (r < ML) { s0 = (r / SEQ) * SEQ; sl = SEQ; } else { s0 = ML + ((r - ML) / CTXL) * CTXL; sl = CTXL; }
            float a[8];
            { const f32x4 b0 = *(const f32x4*)(P.conv_b + c0), b1 = *(const f32x4*)(P.conv_b + c0 + 4); a[0] = b0.x; a[1] = b0.y; a[2] = b0.z; a[3] = b0.w; a[4] = b1.x; a[5] = b1.y; a[6] = b1.z; a[7] = b1.w; }
#pragma unroll
            for (int w = 0; w < 5; ++w) { const int rr = r + w - 2;
                if (rr >= s0 && rr < s0 + sl) {
                    const u32x4 xv = *(const u32x4*)(PR + (size_t)rr * PC + C_XBC + c0);
                    const f32x4 w0 = *(const f32x4*)(P.conv_w + w * 1024 + c0), w1 = *(const f32x4*)(P.conv_w + w * 1024 + c0 + 4);
                    a[0] += w0.x * bflo(xv.x); a[1] += w0.y * bfhi(xv.x); a[2] += w0.z * bflo(xv.y); a[3] += w0.w * bfhi(xv.y);
                    a[4] += w1.x * bflo(xv.z); a[5] += w1.y * bfhi(xv.z); a[6] += w1.z * bflo(xv.w); a[7] += w1.w * bfhi(xv.w);
                } }
            u32x4 o; o.x = pk2(silu_acc(a[0]), silu_acc(a[1])); o.y = pk2(silu_acc(a[2]), silu_acc(a[3])); o.z = pk2(silu_acc(a[4]), silu_acc(a[5])); o.w = pk2(silu_acc(a[6]), silu_acc(a[7]));
            *(u32x4*)(U + (size_t)r * 1024 + c0) = o;
        }
        for (int sidx = gtid; sidx < NCH * 16; sidx += NT) {
            const int q = sidx >> 4, dh = sidx & 15, dir = dh >> 3;
            const int r0 = chunk_row0(q);
            const float A = -expf(P.a_log[dh]);
            float cs = 0.f;
            if (dir == 0) { for (int i = 0; i < 128; ++i) { cs += DT[(r0 + i) * 16 + dh] * A; ACS[(q * 16 + dh) * 128 + i] = cs; } }
            else { for (int i = 127; i >= 0; --i) { cs += DT[(r0 + i) * 16 + dh] * A; ACS[(q * 16 + dh) * 128 + i] = cs; } }
            AL[q * 16 + dh] = cs;
        }
    }
    SEAM(4);
    if (IN(5)) {
        for (size_t idx = gtid; idx < (size_t)NCH * 16 * 8192; idx += NT) {
            const int n = (int)(idx & 127), p = (int)((idx >> 7) & 63), dh = (int)((idx >> 13) & 15), q = (int)(idx >> 17);
            const int head = dh & 7, g = head >> 2, r0 = chunk_row0(q);
            const float al = AL[q * 16 + dh];
            const float* acs = ACS + (q * 16 + dh) * 128;
            float a = 0.f;
            for (int j = 0; j < 128; ++j) {
                const bf16* u = U + (size_t)(r0 + j) * 1024;
                a += bf2f(u[512 + g * 128 + n]) * (expf(al - acs[j]) * DT[(r0 + j) * 16 + dh] * bf2f(u[head * 64 + p]));
            }
            S[idx] = (bf16)f2bf(a);
        }
    }
    SEAM(5);
    if (IN(6)) {
        for (int idx = gtid; idx < NB * 16 * 8192; idx += NT) {
            const int pn = idx & 8191, dh = (idx >> 13) & 15, b = idx >> 17, dir = dh >> 3;
            const int qa = dir == 0 ? 128 + 2 * b : 129 + 2 * b, qb = dir == 0 ? 129 + 2 * b : 128 + 2 * b;
            float h = bf2f(S[((size_t)qa * 16 + dh) * 8192 + pn]);
            h = expf(AL[qb * 16 + dh]) * h + bf2f(S[((size_t)qb * 16 + dh) * 8192 + pn]);
            for (int cc = 0; cc < 64; ++cc) {
                const int q = 64 * b + (dir == 0 ? cc : 63 - cc);
                const size_t o = ((size_t)q * 16 + dh) * 8192 + pn;
                const float tmp = bf2f(S[o]); S[o] = (bf16)f2bf(h); h = expf(AL[q * 16 + dh]) * h + tmp;
            }
        }
    }
    SEAM(6);
    if (IN(7)) {
        LAS float* cb = (LAS float*)lds;
        LAS float* red = cb + 256;
        for (int r = bid; r < ML; r += G) {
            const int q = r >> 7, i = r & 127, r0 = q * 128;
            __syncthreads();
            if (tid < 256) {
                const int g = tid >> 7, j = tid & 127;
                const bf16* ci = U + (size_t)r * 1024 + 768 + g * 128;
                const bf16* bj = U + (size_t)(r0 + j) * 1024 + 512 + g * 128;
                float a = 0.f;
                for (int n = 0; n < 128; ++n) a += bf2f(ci[n]) * bf2f(bj[n]);
                cb[tid] = a;
            }
            __syncthreads();
            const int head = tid >> 6, p = tid & 63, g = head >> 2;
            float y = 0.f;
            for (int dir = 0; dir < 2; ++dir) {
                const int dh = dir * 8 + head;
                const float* acs = ACS + (q * 16 + dh) * 128;
                const float ai = acs[i];
                const int j0 = dir == 0 ? 0 : i, j1 = dir == 0 ? i : 127;
                float a = 0.f;
                for (int j = j0; j <= j1; ++j) a += cb[g * 128 + j] * expf(ai - acs[j]) * DT[(r0 + j) * 16 + dh] * bf2f(U[(size_t)(r0 + j) * 1024 + head * 64 + p]);
                const bf16* hp = S + ((size_t)q * 16 + dh) * 8192 + p * 128;
                const bf16* ci = U + (size_t)r * 1024 + 768 + g * 128;
                float off = 0.f;
                for (int n = 0; n < 128; ++n) off += bf2f(ci[n]) * bf2f(hp[n]);
                y += a + expf(ai) * off;
            }
            y += P.d_skip[head] * bf2f(U[(size_t)r * 1024 + tid]);
            y *= silu_acc(bf2f(PR[(size_t)r * PC + C_Z + tid]));
            const float ss = wave_sum(y * y);
            if (lane == 0) red[wave] = ss;
            __syncthreads();
            float tot = 0.f;
#pragma unroll
            for (int w = 0; w < 8; ++w) tot += red[w];
            MIX[(size_t)r * 1024 + tid] = (bf16)f2bf(y * rsqrtf(tot * (1.f / 512.f) + EPS) * P.ssd_norm[tid]);
        }
        __syncthreads();
        LAS float* qs = (LAS float*)lds + wave * 640;
        LAS float* sc = qs + 64;
        for (int it = gw; it < ML * 8; it += NGW) {
            const int r = it >> 3, hq = it & 7, kvh = hq >> 2, b = r / SEQ, pos = r % SEQ;
            {
                const bf16* qp = PR + (size_t)r * PC + C_Q + hq * 64;
                const float qv = bf2f(qp[lane]), qo = bf2f(qp[lane ^ 32]);
                const float cs = ROPEC[pos * 32 + (lane & 31)], sn = ROPES[pos * 32 + (lane & 31)];
                qs[lane] = (qv * cs + (lane < 32 ? -qo : qo) * sn) * 0.125f;
            }
            __builtin_amdgcn_wave_barrier();
            const int klo = pos - 128 < 0 ? 0 : pos - 128, khi = pos + 128 > SEQ - 1 ? SEQ - 1 : pos + 128;
            const int nloc = khi - klo + 1, nk = nloc + CTXL;
            float mx = P.sinks[hq];
            for (int kk = lane; kk < nk; kk += 64) {
                float s = 0.f;
                if (kk < nloc) {
                    const int kp = klo + kk;
                    const bf16* kr = PR + (size_t)(b * SEQ + kp) * PC + C_K + kvh * 64;
                    for (int d = 0; d < 32; ++d) {
                        const float cs = ROPEC[kp * 32 + d], sn = ROPES[kp * 32 + d];
                        const float k0 = bf2f(kr[d]), k1 = bf2f(kr[d + 32]);
                        s += qs[d] * (k0 * cs - k1 * sn) + qs[d + 32] * (k1 * cs + k0 * sn);
                    }
                } else {
                    const bf16* kr = PR + (size_t)(ML + b * CTXL + (kk - nloc)) * PC + C_K + kvh * 64;
                    for (int d = 0; d < 64; ++d) s += qs[d] * bf2f(kr[d]);
                }
                sc[kk] = s; mx = fmaxf(mx, s);
            }
            __builtin_amdgcn_wave_barrier();
            mx = wave_max(mx);
            float sum = 0.f;
            for (int kk = lane; kk < nk; kk += 64) { const float e = expf(sc[kk] - mx); sc[kk] = e; sum += e; }
            sum = wave_sum(sum) + expf(P.sinks[hq] - mx);
            const float inv = 1.f / sum;
            __builtin_amdgcn_wave_barrier();
            float o = 0.f;
            for (int kk = 0; kk < nk; ++kk) {
                const int row = kk < nloc ? b * SEQ + klo + kk : ML + b * CTXL + (kk - nloc);
                o += sc[kk] * bf2f(PR[(size_t)row * PC + C_V + kvh * 64 + lane]);
            }
            MIX[(size_t)r * 1024 + 512 + hq * 64 + lane] = (bf16)f2bf(o * inv);
            __builtin_amdgcn_wave_barrier();
        }
    }
    SEAM(7);
    if (IN(8)) {
        pg8::Gemm g{MIX, WOUT, ML, DM, DM}; pg8::StaticOrder S_; S_.init(ML, DM, G, bid);
        EpiOutProj E{P.x, MOD, X1};
        pg8::gemm_phase<EpiOutProj, pg8::StaticOrder, false, true>(lds, g, S_, E);
    }
    SEAM(8);
    if (IN(9)) {
        for (int r = gw; r < ML; r += NGW) {
            const float* mod = MOD + (r / SEQ) * 6144;
            f32x4 v[4]; float s = 0.f;
#pragma unroll
            for (int j = 0; j < 4; ++j) { v[j] = *(const f32x4*)(X1 + (size_t)r * DM + j * 256 + lane * 4); s += v[j].x * v[j].x + v[j].y * v[j].y + v[j].z * v[j].z + v[j].w * v[j].w; }
            const float rstd = rsqrtf(wave_sum(s) * (1.f / DM) + EPS);
            float lg[36];
#pragma unroll
            for (int e = 0; e < 36; ++e) lg[e] = 0.f;
#pragma unroll 1
            for (int j = 0; j < 4; ++j) {
                const int c0 = j * 256 + lane * 4;
                const f32x4 g = *(const f32x4*)(P.norm2 + c0), sh = *(const f32x4*)(mod + 3072 + c0), scv = *(const f32x4*)(mod + 4096 + c0);
                f32x4 o;
                o.x = v[j].x * rstd * g.x * (1.f + scv.x) + sh.x; o.y = v[j].y * rstd * g.y * (1.f + scv.y) + sh.y;
                o.z = v[j].z * rstd * g.z * (1.f + scv.z) + sh.z; o.w = v[j].w * rstd * g.w * (1.f + scv.w) + sh.w;
#pragma unroll 1
                for (int cc = 0; cc < 4; ++cc) {
                    const float hv = o[cc];
                    const f32x4 wg = *(const f32x4*)(P.w_group + (size_t)(c0 + cc) * 4);
                    lg[0] += hv * wg.x; lg[1] += hv * wg.y; lg[2] += hv * wg.z; lg[3] += hv * wg.w;
                    const float* we = P.w_expert + (size_t)(c0 + cc) * 32;
#pragma unroll
                    for (int e4 = 0; e4 < 8; ++e4) { const f32x4 wv = *(const f32x4*)(we + e4 * 4);
                        lg[4 + e4 * 4 + 0] += hv * wv.x; lg[4 + e4 * 4 + 1] += hv * wv.y; lg[4 + e4 * 4 + 2] += hv * wv.z; lg[4 + e4 * 4 + 3] += hv * wv.w; }
                }
            }
#pragma unroll
            for (int e = 0; e < 36; ++e) lg[e] = wave_sum(lg[e]);
            if (lane == 0) {
                float gl[4]; float gm = -INFINITY; int gi = 0;
#pragma unroll
                for (int e = 0; e < 4; ++e) { gl[e] = lg[e] + P.b_group[e]; if (gl[e] > gm) { gm = gl[e]; gi = e; } }
                float gs = 0.f;
#pragma unroll
                for (int e = 0; e < 4; ++e) gs += expf(gl[e] - gm);
                const float gwt = 1.f / gs;
                float el[8]; float em = -INFINITY; int e1 = 0;
#pragma unroll
                for (int e = 0; e < 8; ++e) {
                    float vsel = 0.f;
#pragma unroll
                    for (int gg = 0; gg < 4; ++gg) if (gg == gi) vsel = lg[4 + gg * 8 + e] + P.b_expert[gg * 8 + e];
                    el[e] = vsel; if (vsel > em) { em = vsel; e1 = e; }
                }
                float em2 = -INFINITY; int e2 = 0;
#pragma unroll
                for (int e = 0; e < 8; ++e) if (e != e1 && el[e] > em2) { em2 = el[e]; e2 = e; }
                const float p2 = expf(em2 - em);
                const float w1 = gwt / (1.f + p2), w2 = gwt * p2 / (1.f + p2);
                const int ex1 = gi * 8 + e1, ex2 = gi * 8 + e2;
                RSTD[r] = rstd;
                EID[r * 2] = ex1; POS[r * 2] = (int)atomicAdd(&CNT[ex1], 1u); EW[r * 2] = w1;
                EID[r * 2 + 1] = ex2; POS[r * 2 + 1] = (int)atomicAdd(&CNT[ex2], 1u); EW[r * 2 + 1] = w2;
            }
        }
    }
    SEAM(9);
    LAS int* pbase = (LAS int*)(lds + LDS_TAB);
    LAS int* pexp = pbase + 64;
    int npan = 0;
    if (hi > 10 && lo <= 13) {
        __syncthreads();
        if (tid == 0) { int acc_ = 0; for (int e = 0; e < NE; ++e) { pbase[e] = acc_ * 256; const int np = ((int)CNT[e] + 255) >> 8; for (int k = 0; k < np; ++k) pexp[acc_ + k] = e; acc_ += np; } pbase[NE] = acc_ * 256; }
        __syncthreads();
        npan = pbase[NE] >> 8;
    }
    if (IN(10)) {
        for (int sidx = gtid; sidx < npan * 256; sidx += NT) S2A[sidx] = -1;
    }
    SEAM(10);
    if (IN(11)) {
        for (int r = gw; r < ML; r += NGW) {
            const float* mod = MOD + (r / SEQ) * 6144;
            const float rstd = RSTD[r];
            const int s0 = pbase[EID[r * 2]] + POS[r * 2], s1 = pbase[EID[r * 2 + 1]] + POS[r * 2 + 1];
            if (lane == 0) { S2A[s0] = r * 2; S2A[s1] = r * 2 + 1; }
#pragma unroll
            for (int j = 0; j < 4; ++j) {
                const int c0 = j * 256 + lane * 4;
                const f32x4 v = *(const f32x4*)(X1 + (size_t)r * DM + c0);
                const f32x4 g = *(const f32x4*)(P.norm2 + c0), sh = *(const f32x4*)(mod + 3072 + c0), scv = *(const f32x4*)(mod + 4096 + c0);
                u32x2 w;
                w.x = pk2(v.x * rstd * g.x * (1.f + scv.x) + sh.x, v.y * rstd * g.y * (1.f + scv.y) + sh.y);
                w.y = pk2(v.z * rstd * g.z * (1.f + scv.z) + sh.z, v.w * rstd * g.w * (1.f + scv.w) + sh.w);
                *(u32x2*)(HS + (size_t)s0 * DM + c0) = w; *(u32x2*)(HS + (size_t)s1 * DM + c0) = w;
            }
        }
    }
    SEAM(11);
    if (IN(12)) {
        pg8::Gemm g{HS, WGU, npan * 256, NE * 1024, DM}; MoeOrder S_{pexp, npan, G, bid};
        EpiGateUp E{ACT};
        pg8::gemm_phase<EpiGateUp, MoeOrder, true, true>(lds, g, S_, E);
    }
    SEAM(12);
    if (IN(13)) {
        pg8::Gemm g{ACT, WD, npan * 256, NE * 1024, EDIM}; MoeOrder S_{pexp, npan, G, bid};
        EpiDown E{Y, S2A};
        pg8::gemm_phase<EpiDown, MoeOrder, true, true>(lds, g, S_, E);
    }
    SEAM(13);
    if (IN(14)) {
        for (int r = gw; r < ML; r += NGW) {
            const float* g2 = MOD + (r / SEQ) * 6144 + 5120;
            const float w0 = EW[r * 2], w1 = EW[r * 2 + 1];
            f32x4 v[4]; float s = 0.f;
#pragma unroll
            for (int j = 0; j < 4; ++j) {
                const int c0 = j * 256 + lane * 4;
                const f32x4 xv = *(const f32x4*)(X1 + (size_t)r * DM + c0);
                const u32x2 y0 = *(const u32x2*)(Y + (size_t)(r * 2) * DM + c0), y1 = *(const u32x2*)(Y + (size_t)(r * 2 + 1) * DM + c0);
                const f32x4 gg = *(const f32x4*)(g2 + c0);
                v[j].x = xv.x + gg.x * (w0 * bflo(y0.x) + w1 * bflo(y1.x)); v[j].y = xv.y + gg.y * (w0 * bfhi(y0.x) + w1 * bfhi(y1.x));
                v[j].z = xv.z + gg.z * (w0 * bflo(y0.y) + w1 * bflo(y1.y)); v[j].w = xv.w + gg.w * (w0 * bfhi(y0.y) + w1 * bfhi(y1.y));
                s += v[j].x * v[j].x + v[j].y * v[j].y + v[j].z * v[j].z + v[j].w * v[j].w;
            }
            const float rstd = rsqrtf(wave_sum(s) * (1.f / DM) + EPS);
#pragma unroll
            for (int j = 0; j < 4; ++j) {
                const int c0 = j * 256 + lane * 4;
                const f32x4 nf = *(const f32x4*)(P.norm_final + c0);
                f32x4 o; o.x = v[j].x * rstd * nf.x; o.y = v[j].y * rstd * nf.y; o.z = v[j].z * rstd * nf.z; o.w = v[j].w * rstd * nf.w;
                *(f32x4*)(P.out + (size_t)r * DM + c0) = o;
            }
        }
    }
#undef IN
#undef SEAM
}

#ifndef N_LAUNCHES
#define N_LAUNCHES 1
#endif
constexpr int N_PHASES = 15;

extern "C" void kernel_launch(void* const* d_in, const int* in_sizes, int n_in, void* d_out, int out_size, void* d_ws, size_t ws_size, hipStream_t stream) {
    static int grid = 0;
    if (grid == 0) {
        if (n_in != 25 || out_size != ML * DM || ws_size < WS_END) { fprintf(stderr, "kernel_launch: unexpected problem (n_in %d out %d ws %zu need %zu)\n", n_in, out_size, ws_size, (size_t)WS_END); grid = -1; return; }
        int dev = 0, cus = 0, per_cu = 0;
        (void)hipGetDevice(&dev);
        (void)hipDeviceGetAttribute(&cus, hipDeviceAttributeMultiprocessorCount, dev);
        (void)hipFuncSetAttribute((const void*)fwd_kernel, hipFuncAttributeMaxDynamicSharedMemorySize, LDS_BYTES);
        (void)hipOccupancyMaxActiveBlocksPerMultiprocessor(&per_cu, (const void*)fwd_kernel, NTHREADS, LDS_BYTES);
        (void)hipGetLastError();
        if (per_cu < 1) { fprintf(stderr, "kernel_launch: occupancy query says %d\n", per_cu); }
        grid = cus;
    }
    if (grid < 0) return;
    (void)hipMemsetAsync((char*)d_ws + WS_CTL, 0, CTL_ZERO_BYTES, stream);
    Args a{};
    const float** pp = (const float**)&a.p;
    for (int i = 0; i < 25; ++i) pp[i] = (const float*)d_in[i];
    a.p.out = (float*)d_out; a.p.ws = (unsigned char*)d_ws;
    if (N_LAUNCHES == 1) {
        a.ph_lo = 0; a.ph_hi = N_PHASES;
        hipLaunchKernelGGL(fwd_kernel, dim3(grid), dim3(NTHREADS), LDS_BYTES, stream, a);
    } else {
        for (int ph = 0; ph < N_PHASES; ++ph) { a.ph_lo = ph; a.ph_hi = ph + 1; hipLaunchKernelGGL(fwd_kernel, dim3(grid), dim3(NTHREADS), LDS_BYTES, stream, a); }
    }
}
```

```cpp
#include <hip/hip_runtime.h>
#include <cstdio>
#include <cstdint>

constexpr int DM = 1024, SEQ = 8192, NB = 2, CTXL = 256;
constexpr int ML = NB * SEQ;
constexpr int MC = NB * CTXL;
constexpr int MT = ML + MC;
constexpr int INC = 2320;
constexpr int PC = 2304;
constexpr int C_Z = 0, C_XBC = 512, C_Q = 1536, C_K = 2048, C_V = 2176;
constexpr int NCH = 132;
constexpr int NE = 32, EDIM = 512;
constexpr int MAXSLOT = 40960;
constexpr float EPS = 1e-6f;

constexpr size_t MiB = 1u << 20;
constexpr size_t WS_CTL = 0, CTL_ZERO_BYTES = 64 * 1024;
constexpr size_t WS_MODP = 1 * MiB;
constexpr size_t WS_MOD = WS_MODP + 16 * 3 * 6144 * 4;
constexpr size_t WS_ROPE = 3 * MiB;
constexpr size_t WS_DT = 5 * MiB;
constexpr size_t WS_ACS = 6 * MiB + 512 * 1024;
constexpr size_t WS_AL = 8 * MiB;
constexpr size_t WS_EW = 8 * MiB + 64 * 1024;
constexpr size_t WS_RSTD = 8 * MiB + 256 * 1024;
constexpr size_t WS_EID = 8 * MiB + 512 * 1024;
constexpr size_t WS_POS = 9 * MiB;
constexpr size_t WS_S2A = 10 * MiB;
constexpr size_t WS_KR = 289 * MiB + 512 * 1024;
constexpr size_t WS_WIN = 12 * MiB;
constexpr size_t WS_WOUT = 17 * MiB;
constexpr size_t WS_WGU = 20 * MiB;
constexpr size_t WS_WD = 84 * MiB;
constexpr size_t WS_HX = 116 * MiB;
constexpr size_t WS_P = 149 * MiB;
constexpr size_t WS_U = WS_P + (size_t)MT * PC * 2;
constexpr size_t WS_ACT = 229 * MiB;
constexpr size_t WS_S = WS_U + 33 * MiB;
constexpr size_t WS_END = WS_S + 33 * MiB;
static_assert(WS_END <= WS_KR && WS_KR + (size_t)(MT + 128) * 128 * 2 <= 294 * MiB, "ws budget");
constexpr size_t WS_NEED = 294 * MiB;
static_assert(WS_P + (size_t)MAXSLOT * 1024 * 2 <= WS_ACT, "HS fits below ACT");
constexpr int CW_CNT = 64;
constexpr int CW_BAR = 1024;

constexpr int LDS_BYTES = 147456;
constexpr int LDS_TAB = 131072;
constexpr int NTHREADS = 512;

#define LAS __attribute__((address_space(3)))
typedef unsigned short bf16;

#define XB_TMO      128
#define XB_XCNT(j)  (256  + 64 * (j))
#define XB_XSUB(j)  (1280 + 64 * (j))
#define XB_XGEN(j)  (2304 + 64 * (j))
#define XB_TOP      3328
#define XB_TOPGEN   3392
#define XCD_BAR_WORDS 3456
#define XB_SPIN_CAP (1u << 18)
__device__ __forceinline__ unsigned xb_ld(unsigned* p)              { return __hip_atomic_load(p, __ATOMIC_RELAXED, __HIP_MEMORY_SCOPE_AGENT); }
__device__ __forceinline__ unsigned xb_add(unsigned* p, unsigned v) { return __hip_atomic_fetch_add(p, v, __ATOMIC_RELAXED, __HIP_MEMORY_SCOPE_AGENT); }
__device__ __forceinline__ unsigned xb_xcc_id() { return (unsigned)__builtin_amdgcn_s_getreg((3 << 11) | 20) & 0xFu; }
#define XB_SPIN(cond, bar) do { unsigned _sp = 0; while (cond) { __builtin_amdgcn_s_sleep(1); \
    if ((++_sp & 255u) == 0u) { if (xb_ld(&(bar)[XB_TMO])) break; if (_sp > XB_SPIN_CAP) { atomicAdd(&(bar)[XB_TMO], 1u); break; } } } } while (0)
struct XcdBarrier { unsigned* bar; unsigned x; volatile LAS unsigned* st; };
__device__ __forceinline__ XcdBarrier xcd_barrier_post(unsigned* bar, volatile LAS unsigned* st) {
    XcdBarrier b; b.bar = bar; b.x = xb_xcc_id(); b.st = st;
    if (threadIdx.x == 0) (void)xb_add(&bar[XB_XCNT(b.x)], 1u);
    return b;
}
__device__ __forceinline__ void xcd_barrier_complete(unsigned* bar, unsigned x, unsigned& nloc, unsigned& nx) {
    const unsigned G = gridDim.x * gridDim.y * gridDim.z;
    unsigned sum, cnt, mine, sp = 0u;
    for (;;) {
        sum = 0u; cnt = 0u; mine = 0u;
#pragma unroll
        for (unsigned j = 0; j < 16; ++j) { const unsigned c = xb_ld(&bar[XB_XCNT(j)]); sum += c; cnt += (c > 0u) ? 1u : 0u; mine = (j == x) ? c : mine; }
        if (sum == G) break;
        __builtin_amdgcn_s_sleep(1);
        if ((++sp & 255u) == 0u) { if (xb_ld(&bar[XB_TMO])) break; if (sp > XB_SPIN_CAP) { atomicAdd(&bar[XB_TMO], 1u); break; } }
    }
    nloc = mine > 0u ? mine : 1u; nx = cnt > 0u ? cnt : 1u;
}
__device__ __forceinline__ void xcd_barrier(const XcdBarrier& b) {
    asm volatile("s_waitcnt vmcnt(0)" ::: "memory");
    __syncthreads();
    if (threadIdx.x == 0) {
        unsigned* bar = b.bar;
        __builtin_amdgcn_s_waitcnt(0);
        unsigned nloc = b.st[0], nx = b.st[1];
        if (nloc == 0u) { xcd_barrier_complete(bar, b.x, nloc, nx); b.st[0] = nloc; b.st[1] = nx; }
        const unsigned old = xb_add(&bar[XB_XSUB(b.x)], 1u);
        const unsigned gen = old / nloc;
        if (old + 1u == (gen + 1u) * nloc) {
            __builtin_amdgcn_fence(__ATOMIC_RELEASE, "agent");
            asm volatile("s_waitcnt vmcnt(0)" ::: "memory");
            const unsigned og = xb_add(&bar[XB_TOP], 1u);
            const unsigned tg = og / nx;
            if (og + 1u == (tg + 1u) * nx) xb_add(&bar[XB_TOPGEN], 1u);
            else XB_SPIN(xb_ld(&bar[XB_TOPGEN]) == tg, bar);
            __builtin_amdgcn_fence(__ATOMIC_ACQUIRE, "agent");
            xb_add(&bar[XB_XGEN(b.x)], 1u);
            asm volatile("s_waitcnt vmcnt(0)" ::: "memory");
        } else {
            XB_SPIN(xb_ld(&bar[XB_XGEN(b.x)]) == gen, bar);
            __builtin_amdgcn_fence(__ATOMIC_ACQUIRE, "agent");
            asm volatile("s_waitcnt vmcnt(0)" ::: "memory");
        }
    }
    __syncthreads();
}


namespace pg8 {
#define PG8_LAS __attribute__((address_space(3)))
typedef unsigned short bf16_t;
typedef short bf16x8 __attribute__((ext_vector_type(8)));
typedef float f32x4 __attribute__((ext_vector_type(4)));
typedef unsigned u32x4 __attribute__((ext_vector_type(4)));
constexpr int BM = 256, BK = 64, HALF = 128, HTB = HALF * BK * 2  , STAGE_BYTES = 8 * HTB, NXCD = 8, WGM = 8;

__host__ __device__ __forceinline__ int lds_byte(int r, int c) { const int st = (r >> 4) * 2 + (c >> 5), rr = r & 15, cc = c & 31, ob = rr * 64 + cc * 2; return st * 1024 + (ob ^ (((ob >> 9) & 1) << 5)); }
__host__ __device__ __forceinline__ void stage_rc(int b, int& R, int& C) { const int st = b / 1024, sb = b % 1024, swz = sb ^ (((sb >> 9) & 1) << 5); R = (st >> 1) * 16 + swz / 64; C = (st & 1) * 32 + (swz % 64) / 2; }
__host__ __device__ __forceinline__ int perm32(int rho) { const int n = rho >> 4, i = rho & 15; return 8 * (i >> 2) + 4 * n + (i & 3); }

struct Unit { int pm, pn; };
struct Gemm { const bf16_t* A; const bf16_t* Bt; int M, N, K; };

struct StaticOrder {
    int nM, nN, nwg, G, c;
    __host__ __device__ void init(int M, int N, int G_, int c_) { nM = M / BM; nN = N / BM; nwg = nM * nN; G = G_; c = c_; }
    __host__ __device__ bool next(int i, Unit& u) const {
        const long L = (long)i * G + c; if (L >= nwg) return false;
        int wgid = (int)L; { const int q = nwg / NXCD, r = nwg % NXCD, xcd = wgid % NXCD, off = wgid / NXCD; wgid = (xcd < r ? xcd * (q + 1) : r * (q + 1) + (xcd - r) * q) + off; }
        const int nig = WGM * nN, gid = wgid / nig, fm = gid * WGM, gsz = (nM - fm) < WGM ? (nM - fm) : WGM;
        u.pm = fm + ((wgid % nig) % gsz); u.pn = (wgid % nig) / gsz; return true;
    }
    __device__ __forceinline__ void a_ready(const Unit&) const {}
    __device__ __forceinline__ void done(const Unit&) const {}
};

__device__ __forceinline__ unsigned cvt_pk_bf16(float lo, float hi) { unsigned r; asm volatile("v_cvt_pk_bf16_f32 %0, %1, %2" : "=v"(r) : "v"(lo), "v"(hi)); return r; }
typedef float f32x2 __attribute__((ext_vector_type(2)));
template <class Epi, class Sched, bool ALIGN_EPI = false, bool SP2 = false>
__device__ __forceinline__ void gemm_phase(PG8_LAS unsigned char* lds, const Gemm g, const Sched& S, const Epi& E) {
    const int tid = threadIdx.x, wid = __builtin_amdgcn_readfirstlane(tid >> 6), lane = tid & 63, wr = wid >> 2, wc = wid & 3, fr = lane & 15, fq = lane >> 4;
    const int K = g.K, nt = K / BK;
    unsigned voffA[2], voffB[2];
#pragma unroll
    for (int i = 0; i < 2; ++i) { int R, C; stage_rc(tid * 16 + i * 8192, R, C); const int Rb = Epi::PERM ? ((R & ~31) + perm32(R & 31)) : R;
        voffA[i] = (unsigned)(R * K + C) * 2u; voffB[i] = (unsigned)(Rb * K + C) * 2u; }
    const size_t kstep = (size_t)(BK * 2);
    const size_t hstep = (size_t)HALF * K * 2;
    const size_t tstep = 2 * hstep;
    const unsigned ldsw = (unsigned)wid * 1024u;
    const int aoff = lds_byte(wr * 64 + fr, fq * 8), boff = lds_byte(wc * 32 + fr, fq * 8);
#define PG8_SA(b, h) (((b) * 2 + (h)) * HTB)
#define PG8_SB(b, h) ((4 + (b) * 2 + (h)) * HTB)
#define PG8_STAGE(bufoff, gbase, voff) do { _Pragma("unroll") for (int _i = 0; _i < 2; ++_i) \
        __builtin_amdgcn_global_load_lds((const unsigned*)((const char*)(gbase) + (voff)[_i]), (PG8_LAS unsigned*)(lds + (bufoff) + ldsw + _i * 8192), 16, 0, 0); } while (0)
#define PG8_LDA(dst, b, h) do { _Pragma("unroll") for (int m = 0; m < 4; ++m) _Pragma("unroll") for (int k = 0; k < 2; ++k) dst[m][k] = *(const PG8_LAS bf16x8*)(lds + PG8_SA(b, h) + aoff + m * 2048 + k * 1024); } while (0)
#define PG8_LDB(dst, b, h) do { _Pragma("unroll") for (int n = 0; n < 2; ++n) _Pragma("unroll") for (int k = 0; k < 2; ++k) dst[n][k] = *(const PG8_LAS bf16x8*)(lds + PG8_SB(b, h) + boff + n * 2048 + k * 1024); } while (0)
#define PG8_MMA(ai, bj, At, Bt) do { __builtin_amdgcn_s_setprio(1); _Pragma("unroll") for (int m = 0; m < 4; ++m) _Pragma("unroll") for (int n = 0; n < 2; ++n) _Pragma("unroll") for (int k = 0; k < 2; ++k) \
        acc[ai][bj][m][n] = __builtin_amdgcn_mfma_f32_16x16x32_bf16(Bt[n][k], At[m][k], acc[ai][bj][m][n], 0, 0, 0); __builtin_amdgcn_s_setprio(0); } while (0)
#define PG8_WAIT_V(n) asm volatile("s_waitcnt vmcnt(" #n ")" ::: "memory")
#define PG8_WAIT_L(n) asm volatile("s_waitcnt lgkmcnt(" #n ")" ::: "memory")
#define PG8_BAR __builtin_amdgcn_s_barrier()
#define PG8_SCHED __builtin_amdgcn_sched_barrier(0)
    Unit cur, nxt; int ui = 0;
    if (!S.next(0, cur)) return;
    f32x4 acc[2][2][4][2];
#pragma unroll
    for (int a = 0; a < 2; ++a)
#pragma unroll
        for (int b = 0; b < 2; ++b)
#pragma unroll
            for (int m = 0; m < 4; ++m)
#pragma unroll
                for (int n = 0; n < 2; ++n) acc[a][b][m][n] = (f32x4){0.f, 0.f, 0.f, 0.f};
    bf16x8 At[4][2], B0[2][2], B1[2][2];
    const char* cA = (const char*)g.A + (size_t)cur.pm * tstep; const char* cB = (const char*)g.Bt + (size_t)cur.pn * tstep;
    S.a_ready(cur);
    if constexpr (SP2) {
        PG8_STAGE(PG8_SB(0, 0), cB, voffB); PG8_STAGE(PG8_SB(0, 1), cB + hstep, voffB); PG8_STAGE(PG8_SA(0, 0), cA, voffA); PG8_STAGE(PG8_SA(0, 1), cA + hstep, voffA);
        if (wr == 1) PG8_BAR;
        PG8_WAIT_V(2); PG8_BAR;
        PG8_STAGE(PG8_SB(1, 0), cB + kstep, voffB); PG8_STAGE(PG8_SA(1, 0), cA + kstep, voffA); PG8_STAGE(PG8_SB(1, 1), cB + hstep + kstep, voffB);
        PG8_WAIT_V(6); PG8_BAR;
    } else {
        PG8_STAGE(PG8_SB(0, 0), cB, voffB); PG8_STAGE(PG8_SA(0, 0), cA, voffA); PG8_STAGE(PG8_SB(0, 1), cB + hstep, voffB); PG8_STAGE(PG8_SA(0, 1), cA + hstep, voffA);
        if (wr == 1) PG8_BAR;
        PG8_WAIT_V(4); PG8_BAR;
        PG8_STAGE(PG8_SB(1, 0), cB + kstep, voffB); PG8_STAGE(PG8_SA(1, 0), cA + kstep, voffA); PG8_STAGE(PG8_SB(1, 1), cB + hstep + kstep, voffB);
        PG8_WAIT_V(6); PG8_BAR;
    }
    for (;;) {
        const bool has_next = S.next(ui + 1, nxt);
        const char* nA = has_next ? (const char*)g.A + (size_t)nxt.pm * tstep : cA; const char* nB = has_next ? (const char*)g.Bt + (size_t)nxt.pn * tstep : cB;
        for (int t = 0; t < nt; t += 2) {
            const bool last = (t == nt - 2);
            const char* a1 = cA + (size_t)(t + 1) * kstep;
            const char* a2 = last ? nA : cA + (size_t)(t + 2) * kstep; const char* b2 = last ? nB : cB + (size_t)(t + 2) * kstep;
            const char* a3 = a2 + kstep; const char* b3 = b2 + kstep;
            if (last && has_next) S.a_ready(nxt);
            if constexpr (SP2) {
            PG8_LDB(B0, 0, 0); PG8_LDB(B1, 0, 1); PG8_SCHED; PG8_LDA(At, 0, 0); PG8_STAGE(PG8_SA(1, 1), a1 + hstep, voffA);
            PG8_WAIT_V(8); PG8_WAIT_L(0); PG8_BAR; PG8_MMA(0, 0, At, B0); PG8_MMA(0, 1, At, B1); PG8_BAR; PG8_SCHED;
            PG8_LDA(At, 0, 1); PG8_STAGE(PG8_SB(0, 0), b2, voffB); PG8_STAGE(PG8_SB(0, 1), b2 + hstep, voffB); PG8_STAGE(PG8_SA(0, 0), a2, voffA);
            PG8_WAIT_V(8); PG8_WAIT_L(0); PG8_BAR; PG8_MMA(1, 0, At, B0); PG8_MMA(1, 1, At, B1); PG8_BAR; PG8_SCHED;
            PG8_LDB(B0, 1, 0); PG8_LDB(B1, 1, 1); PG8_SCHED; PG8_LDA(At, 1, 0); PG8_STAGE(PG8_SA(0, 1), a2 + hstep, voffA);
            PG8_WAIT_V(8); PG8_WAIT_L(0); PG8_BAR; PG8_MMA(0, 0, At, B0); PG8_MMA(0, 1, At, B1); PG8_BAR; PG8_SCHED;
            PG8_LDA(At, 1, 1); PG8_STAGE(PG8_SB(1, 0), b3, voffB); PG8_STAGE(PG8_SB(1, 1), b3 + hstep, voffB); PG8_STAGE(PG8_SA(1, 0), a3, voffA);
            PG8_WAIT_V(8); PG8_WAIT_L(0); PG8_BAR; PG8_MMA(1, 0, At, B0); PG8_MMA(1, 1, At, B1); PG8_BAR; PG8_SCHED;
            } else {
            PG8_LDB(B0, 0, 0); PG8_SCHED; PG8_LDA(At, 0, 0); PG8_STAGE(PG8_SA(1, 1), a1 + hstep, voffA);
            PG8_WAIT_L(8); PG8_BAR; PG8_WAIT_L(0); PG8_MMA(0, 0, At, B0); PG8_BAR; PG8_SCHED;
            PG8_LDB(B1, 0, 1); PG8_STAGE(PG8_SB(0, 0), b2, voffB);
            PG8_BAR; PG8_WAIT_L(0); PG8_MMA(0, 1, At, B1); PG8_BAR;
            PG8_LDA(At, 0, 1); PG8_STAGE(PG8_SA(0, 0), a2, voffA);
            PG8_BAR; PG8_WAIT_L(0); PG8_MMA(1, 0, At, B0); PG8_BAR; PG8_SCHED;
            PG8_STAGE(PG8_SB(0, 1), b2 + hstep, voffB);
            PG8_WAIT_V(6); PG8_BAR; PG8_MMA(1, 1, At, B1); PG8_BAR;
            PG8_LDB(B0, 1, 0); PG8_SCHED; PG8_LDA(At, 1, 0); PG8_STAGE(PG8_SA(0, 1), a2 + hstep, voffA);
            PG8_WAIT_L(8); PG8_BAR; PG8_WAIT_L(0); PG8_MMA(0, 0, At, B0); PG8_BAR; PG8_SCHED;
            PG8_LDB(B1, 1, 1); PG8_STAGE(PG8_SB(1, 0), b3, voffB);
            PG8_BAR; PG8_WAIT_L(0); PG8_MMA(0, 1, At, B1); PG8_BAR;
            PG8_LDA(At, 1, 1); PG8_STAGE(PG8_SA(1, 0), a3, voffA);
            PG8_BAR; PG8_WAIT_L(0); PG8_MMA(1, 0, At, B0); PG8_BAR; PG8_SCHED;
            PG8_STAGE(PG8_SB(1, 1), b3 + hstep, voffB);
            PG8_WAIT_V(6); PG8_BAR; PG8_MMA(1, 1, At, B1); PG8_BAR;
            }
        }
        if constexpr (ALIGN_EPI) { if (wr == 0) PG8_BAR; }
        if constexpr (!Epi::AFTER_DRAIN) { E(acc, cur, wr, wc, fr, fq); S.done(cur); }
        if (!has_next) break;
#pragma unroll
        for (int a = 0; a < 2; ++a)
#pragma unroll
            for (int b = 0; b < 2; ++b)
#pragma unroll
                for (int m = 0; m < 4; ++m)
#pragma unroll
                    for (int n = 0; n < 2; ++n) acc[a][b][m][n] = (f32x4){0.f, 0.f, 0.f, 0.f};
        cur = nxt; cA = nA; cB = nB; ++ui;
        if constexpr (ALIGN_EPI) { if (wr == 1) PG8_BAR; }
    }
    PG8_WAIT_V(0);
    if constexpr (!ALIGN_EPI) { if (wr == 0) PG8_BAR; }
    PG8_BAR;
    if constexpr (Epi::AFTER_DRAIN) { E.fused(acc, cur, wr, wc, fr, fq, lds, wid, lane); S.done(cur); }
#undef PG8_SA
#undef PG8_SB
#undef PG8_STAGE
#undef PG8_LDA
#undef PG8_LDB
#undef PG8_MMA
#undef PG8_WAIT_V
#undef PG8_WAIT_L
#undef PG8_BAR
#undef PG8_SCHED
}
}

typedef float f32x4 __attribute__((ext_vector_type(4)));
typedef unsigned u32x4 __attribute__((ext_vector_type(4)));
typedef unsigned u32x2 __attribute__((ext_vector_type(2)));
__device__ __forceinline__ float silu_acc(float x) { return x / (1.f + expf(-x)); }
__device__ __forceinline__ float silu_fast(float x) { return x * __builtin_amdgcn_rcpf(1.f + __expf(-x)); }
__device__ __forceinline__ float softplus_f(float x) { return fmaxf(x, 0.f) + log1pf(expf(-fabsf(x))); }
__device__ __forceinline__ float wave_sum(float v) {
#pragma unroll
    for (int o = 1; o < 64; o <<= 1) v += __shfl_xor(v, o);
    return v;
}
__device__ __forceinline__ float wave_max(float v) {
#pragma unroll
    for (int o = 1; o < 64; o <<= 1) v = fmaxf(v, __shfl_xor(v, o));
    return v;
}
__device__ __forceinline__ float bf2f(bf16 v) { return __uint_as_float((unsigned)v << 16); }
__device__ __forceinline__ float bflo(unsigned w) { return __uint_as_float(w << 16); }
__device__ __forceinline__ float bfhi(unsigned w) { return __uint_as_float(w & 0xffff0000u); }
__device__ __forceinline__ unsigned f2bf(float f) { unsigned u = __float_as_uint(f); return (u + 0x7fffu + ((u >> 16) & 1u)) >> 16; }
__device__ __forceinline__ unsigned pk2(float lo, float hi) { return f2bf(lo) | (f2bf(hi) << 16); }

struct Ptrs {
    const float *x, *c, *ctx, *c_ctx, *w_ada, *b_ada, *norm1, *w_in, *conv_w, *conv_b, *dt_bias, *a_log, *d_skip, *ssd_norm, *sinks,
                *w_out, *norm2, *w_group, *b_group, *w_expert, *b_expert, *w_gate, *w_up, *w_down, *norm_final;
    float* out; unsigned char* ws;
};

__device__ __forceinline__ void transpose_item(const float* W, int ldn, int sn0, int k0, bf16* WT, int Kp, int drow0, LAS float* scr, int lane) {
#pragma unroll 8
    for (int i = 0; i < 32; ++i) { const int kk = 2 * i + (lane >> 5); scr[kk * 33 + (lane & 31)] = W[(size_t)(k0 + kk) * ldn + sn0 + (lane & 31)]; }
    asm volatile("s_waitcnt lgkmcnt(0)" ::: "memory");
    const int c = lane & 7;
#pragma unroll
    for (int j = 0; j < 4; ++j) { const int n = (lane >> 3) + 8 * j; const LAS float* s = scr + (8 * c) * 33 + n;
        u32x4 o; o.x = pk2(s[0 * 33], s[1 * 33]); o.y = pk2(s[2 * 33], s[3 * 33]); o.z = pk2(s[4 * 33], s[5 * 33]); o.w = pk2(s[6 * 33], s[7 * 33]);
        *(u32x4*)(WT + (size_t)(drow0 + n) * Kp + k0 + 8 * c) = o; }
    asm volatile("s_waitcnt lgkmcnt(0)" ::: "memory");
}

__device__ __forceinline__ int chunk_row0(int q) { return q < 128 ? q * 128 : ML + (q - 128) * 128; }

struct EpiStoreBf16 {
    static constexpr bool PERM = true, AFTER_DRAIN = false;
    bf16* O; int ldc;
    __device__ __forceinline__ void operator()(const pg8::f32x4 (&acc)[2][2][4][2], const pg8::Unit& u, int wr, int wc, int fr, int fq) const {
        const int row0 = u.pm * 256 + wr * 64 + fr, col0 = u.pn * 256 + wc * 32 + 8 * fq;
#pragma unroll
        for (int ai = 0; ai < 2; ++ai)
#pragma unroll
            for (int m = 0; m < 4; ++m) { bf16* rowp = O + (size_t)(row0 + ai * 128 + m * 16) * ldc + col0;
#pragma unroll
                for (int bj = 0; bj < 2; ++bj) { const pg8::f32x4 v0 = acc[ai][bj][m][0], v1 = acc[ai][bj][m][1];
                    u32x4 w; w.x = pg8::cvt_pk_bf16(v0[0], v0[1]); w.y = pg8::cvt_pk_bf16(v0[2], v0[3]); w.z = pg8::cvt_pk_bf16(v1[0], v1[1]); w.w = pg8::cvt_pk_bf16(v1[2], v1[3]);
                    *(u32x4*)(rowp + bj * 128) = w; } }
    }
};
struct EpiOutProj {
    static constexpr bool PERM = false, AFTER_DRAIN = false;
    const float* x; const float* mod; float* X1;
    __device__ __forceinline__ void operator()(const pg8::f32x4 (&acc)[2][2][4][2], const pg8::Unit& u, int wr, int wc, int fr, int fq) const {
        const int row0 = u.pm * 256 + wr * 64 + fr, col0 = u.pn * 256 + wc * 32 + 4 * fq;
        const float* g1 = mod + (u.pm * 256 / SEQ) * 6144 + 2048;
        f32x4 gv[2][2];
#pragma unroll
        for (int bj = 0; bj < 2; ++bj)
#pragma unroll
            for (int n = 0; n < 2; ++n) gv[bj][n] = *(const f32x4*)(g1 + col0 + bj * 128 + n * 16);
#pragma unroll
        for (int ai = 0; ai < 2; ++ai)
#pragma unroll
            for (int m = 0; m < 4; ++m) { const size_t off = (size_t)(row0 + ai * 128 + m * 16) * DM + col0;
#pragma unroll
                for (int bj = 0; bj < 2; ++bj)
#pragma unroll
                    for (int n = 0; n < 2; ++n) { const f32x4 xv = *(const f32x4*)(x + off + bj * 128 + n * 16); const f32x4 a = acc[ai][bj][m][n];
                        f32x4 o; o.x = xv.x + gv[bj][n].x * a[0]; o.y = xv.y + gv[bj][n].y * a[1]; o.z = xv.z + gv[bj][n].z * a[2]; o.w = xv.w + gv[bj][n].w * a[3];
                        *(f32x4*)(X1 + off + bj * 128 + n * 16) = o; } }
    }
};
struct EpiGateUp {
    static constexpr bool PERM = true, AFTER_DRAIN = false;
    bf16* ACT;
    __device__ __forceinline__ void operator()(const pg8::f32x4 (&acc)[2][2][4][2], const pg8::Unit& u, int wr, int wc, int fr, int fq) const {
        const int row0 = u.pm * 256 + wr * 64 + fr, col0 = (u.pn & 3) * 128 + wc * 32 + 8 * fq;
#pragma unroll
        for (int ai = 0; ai < 2; ++ai)
#pragma unroll
            for (int m = 0; m < 4; ++m) {
                float r[8];
#pragma unroll
                for (int n = 0; n < 2; ++n)
#pragma unroll
                    for (int i = 0; i < 4; ++i) { const float g = acc[ai][0][m][n][i], up = acc[ai][1][m][n][i]; r[n * 4 + i] = silu_fast(g) * up; }
                u32x4 w; w.x = pg8::cvt_pk_bf16(r[0], r[1]); w.y = pg8::cvt_pk_bf16(r[2], r[3]); w.z = pg8::cvt_pk_bf16(r[4], r[5]); w.w = pg8::cvt_pk_bf16(r[6], r[7]);
                *(u32x4*)(ACT + (size_t)(row0 + ai * 128 + m * 16) * EDIM + col0) = w; }
    }
};
struct EpiDown {
    static constexpr bool PERM = true, AFTER_DRAIN = false;
    bf16* Y; const int* S2A;
    __device__ __forceinline__ void operator()(const pg8::f32x4 (&acc)[2][2][4][2], const pg8::Unit& u, int wr, int wc, int fr, int fq) const {
        const int row0 = u.pm * 256 + wr * 64 + fr, col0 = (u.pn & 3) * 256 + wc * 32 + 8 * fq;
#pragma unroll
        for (int ai = 0; ai < 2; ++ai)
#pragma unroll
            for (int m = 0; m < 4; ++m) { const int aid = S2A[row0 + ai * 128 + m * 16];
                if (aid >= 0) { bf16* rowp = Y + (size_t)aid * DM + col0;
#pragma unroll
                    for (int bj = 0; bj < 2; ++bj) { const pg8::f32x4 v0 = acc[ai][bj][m][0], v1 = acc[ai][bj][m][1];
                        u32x4 w; w.x = pg8::cvt_pk_bf16(v0[0], v0[1]); w.y = pg8::cvt_pk_bf16(v0[2], v0[3]); w.z = pg8::cvt_pk_bf16(v1[0], v1[1]); w.w = pg8::cvt_pk_bf16(v1[2], v1[3]);
                        *(u32x4*)(rowp + bj * 128) = w; } } }
    }
};
struct MoeOrder {
    const LAS int* pexp; int npan, G, c;
    __device__ __forceinline__ bool next(int i, pg8::Unit& u) const {
        const int L = i * G + c; if (L >= npan * 4) return false;
        const int p = L >> 2; u.pm = p; u.pn = pexp[p] * 4 + (L & 3); return true;
    }
    __device__ __forceinline__ void a_ready(const pg8::Unit&) const {}
    __device__ __forceinline__ void done(const pg8::Unit&) const {}
};

struct Args { Ptrs p; int ph_lo, ph_hi; };

__global__ void __launch_bounds__(NTHREADS, 2) fwd_kernel(Args args) {
    extern __shared__ __attribute__((aligned(16))) unsigned char lds_raw[];
    LAS unsigned char* lds = (LAS unsigned char*)lds_raw;
    const Ptrs& P = args.p;
    const int tid = threadIdx.x, lane = tid & 63, wave = __builtin_amdgcn_readfirstlane(tid >> 6);
    const int G = gridDim.x, bid = blockIdx.x;
    const int gtid = bid * NTHREADS + tid, NT = G * NTHREADS;
    const int gw = bid * 8 + wave, NGW = G * 8;
    unsigned char* ws = P.ws;
    unsigned* ctl = (unsigned*)(ws + WS_CTL);
    float* MODP = (float*)(ws + WS_MODP);
    float* MOD = (float*)(ws + WS_MOD);
    float* ROPEC = (float*)(ws + WS_ROPE);
    float* ROPES = ROPEC + 8192 * 32;
    float* DT = (float*)(ws + WS_DT);
    float* ACS = (float*)(ws + WS_ACS);
    float* AL = (float*)(ws + WS_AL);
    float* EW = (float*)(ws + WS_EW);
    float* RSTD = (float*)(ws + WS_RSTD);
    int* EID = (int*)(ws + WS_EID);
    int* POS = (int*)(ws + WS_POS);
    int* S2A = (int*)(ws + WS_S2A);
    bf16* WIN = (bf16*)(ws + WS_WIN);
    bf16* WOUT = (bf16*)(ws + WS_WOUT);
    bf16* WGU = (bf16*)(ws + WS_WGU);
    bf16* WD = (bf16*)(ws + WS_WD);
    bf16* HX = (bf16*)(ws + WS_HX);
    bf16* MIX = (bf16*)(ws + WS_HX);
    bf16* PR = (bf16*)(ws + WS_P);
    bf16* HS = (bf16*)(ws + WS_P);
    bf16* Y = (bf16*)(ws + WS_P);
    bf16* U = (bf16*)(ws + WS_U);
    bf16* ACT = (bf16*)(ws + WS_ACT);
    bf16* S = (bf16*)(ws + WS_S);
    bf16* KR = (bf16*)(ws + WS_KR);
    float* X1 = P.out;
    unsigned* CNT = ctl + CW_CNT;

    volatile LAS unsigned* MISC = (volatile LAS unsigned*)(lds + LDS_BYTES - 64);
    if (tid < 16) MISC[tid] = 0u;
    __syncthreads();
    XcdBarrier bar = xcd_barrier_post(ctl + CW_BAR, MISC);
    const int lo = args.ph_lo, hi = args.ph_hi;
#define IN(k) (lo <= (k) && (k) < hi)
#define SEAM(k) do { if (IN(k) && IN((k) + 1)) xcd_barrier(bar); } while (0)

    if (IN(0)) {
        for (int idx = gtid; idx < 16 * 6144; idx += NT) {
            const int ks = idx / 6144, n = idx % 6144;
            float a0 = 0.f, a1 = 0.f, a2 = 0.f;
            for (int k = ks * 64; k < ks * 64 + 64; ++k) {
                const float w = P.w_ada[(size_t)k * 6144 + n];
                a0 += silu_acc(P.c[k]) * w; a1 += silu_acc(P.c[1024 + k]) * w; a2 += silu_acc(P.c_ctx[k]) * w;
            }
            MODP[(ks * 3 + 0) * 6144 + n] = a0; MODP[(ks * 3 + 1) * 6144 + n] = a1; MODP[(ks * 3 + 2) * 6144 + n] = a2;
        }
        for (int idx = gtid; idx < 8192 * 32; idx += NT) {
            const int pos = idx >> 5, f = idx & 31;
            const float inv = powf(10000.0f, -(float)(f & 15) / 16.0f);
            const float ang = (float)((f < 16) ? (pos >> 6) : (pos & 63)) * inv;
            ROPEC[idx] = cosf(ang); ROPES[idx] = sinf(ang);
        }
        LAS float* scr = (LAS float*)(lds + wave * 16384);
        constexpr int I_IN = 72 * 16, I_OUT = 32 * 16, I_GU = 32 * 16 * 16, I_D = 32 * 32 * 8;
        constexpr int NITEMS = I_IN + I_OUT + 2 * I_GU + I_D;
        for (int it = gw; it < NITEMS; it += NGW) {
            int r = it;
            if (r < I_IN) { const int g = r % 72, kb = r / 72, d0 = g * 32; transpose_item(P.w_in, INC, d0 + (d0 >= 1536 ? 16 : 0), kb * 64, WIN, 1024, d0, scr, lane); continue; } r -= I_IN;
            if (r < I_OUT) { const int g = r % 32, kb = r / 32; transpose_item(P.w_out, 1024, g * 32, kb * 64, WOUT, 1024, g * 32, scr, lane); continue; } r -= I_OUT;
            if (r < 2 * I_GU) { const int up = r >= I_GU; if (up) r -= I_GU; const int e = r >> 8, q = r & 255, g = q & 15, kb = q >> 4, c0 = g * 32;
                transpose_item((up ? P.w_up : P.w_gate) + (size_t)e * 1024 * 512, 512, c0, kb * 64, WGU, 1024, e * 1024 + (c0 >> 7) * 256 + (up ? 128 : 0) + (c0 & 127), scr, lane); continue; } r -= 2 * I_GU;
            { const int e = r >> 8, q = r & 255, g = q & 31, kb = q >> 5; transpose_item(P.w_down + (size_t)e * 512 * 1024, 1024, g * 32, kb * 64, WD, 512, e * 1024 + g * 32, scr, lane); }
        }
    }
    SEAM(0);
    if (IN(1)) {
        for (int idx = gtid; idx < 3 * 6144; idx += NT) {
            const int r = idx / 6144, n = idx % 6144;
            float a = P.b_ada[n];
            for (int ks = 0; ks < 16; ++ks) a += MODP[(ks * 3 + r) * 6144 + n];
            MOD[idx] = a;
        }
    }
    SEAM(1);
    if (IN(2)) {
        for (int r = gw; r < MT; r += NGW) {
            const float* src = r < ML ? P.x + (size_t)r * DM : P.ctx + (size_t)(r - ML) * DM;
            const float* mod = MOD + (r < ML ? (r / SEQ) : 2) * 6144;
            f32x4 v[4]; float s = 0.f;
#pragma unroll
            for (int j = 0; j < 4; ++j) { v[j] = *(const f32x4*)(src + j * 256 + lane * 4); s += v[j].x * v[j].x + v[j].y * v[j].y + v[j].z * v[j].z + v[j].w * v[j].w; }
            const float rstd = rsqrtf(wave_sum(s) * (1.f / DM) + EPS);
            float dp[16];
#pragma unroll
            for (int e = 0; e < 16; ++e) dp[e] = 0.f;
#pragma unroll
            for (int j = 0; j < 4; ++j) {
                const int c0 = j * 256 + lane * 4;
                const f32x4 g = *(const f32x4*)(P.norm1 + c0), sh = *(const f32x4*)(mod + c0), sc = *(const f32x4*)(mod + 1024 + c0);
                f32x4 o;
                o.x = v[j].x * rstd * g.x * (1.f + sc.x) + sh.x; o.y = v[j].y * rstd * g.y * (1.f + sc.y) + sh.y;
                o.z = v[j].z * rstd * g.z * (1.f + sc.z) + sh.z; o.w = v[j].w * rstd * g.w * (1.f + sc.w) + sh.w;
                u32x2 w; w.x = pk2(o.x, o.y); w.y = pk2(o.z, o.w);
                *(u32x2*)(HX + (size_t)r * DM + c0) = w;
#pragma unroll
                for (int cc = 0; cc < 4; ++cc) {
                    const float* wr_ = P.w_in + (size_t)(c0 + cc) * INC + 1536;
                    const float hv = o[cc];
#pragma unroll
                    for (int e4 = 0; e4 < 4; ++e4) { const f32x4 wv = *(const f32x4*)(wr_ + e4 * 4);
                        dp[e4 * 4 + 0] += hv * wv.x; dp[e4 * 4 + 1] += hv * wv.y; dp[e4 * 4 + 2] += hv * wv.z; dp[e4 * 4 + 3] += hv * wv.w; }
                }
            }
            float mine = 0.f;
#pragma unroll
            for (int e = 0; e < 16; ++e) { const float t = wave_sum(dp[e]); if (lane == e) mine = t; }
            if (lane < 16) DT[r * 16 + lane] = softplus_f(mine + P.dt_bias[lane]);
        }
    }
    SEAM(2);
    if (IN(3)) {
        pg8::Gemm g{HX, WIN, MT, PC, DM}; pg8::StaticOrder S_; S_.init(MT, PC, G, bid);
        EpiStoreBf16 E{PR, PC};
        pg8::gemm_phase<EpiStoreBf16, pg8::StaticOrder, true, true>(lds, g, S_, E);
    }
    SEAM(3);
    if (IN(4)) {
        for (int idx = gtid; idx < MT * 128; idx += NT) {
            const int r = idx >> 7, c0 = (idx & 127) * 8;
            int s0, sl;
            if (r < ML) { s0 = (r / SEQ) * SEQ; sl = SEQ; } else { s0 = ML + ((r - ML) / CTXL) * CTXL; sl = CTXL; }
            float a[8];
            { const f32x4 b0 = *(const f32x4*)(P.conv_b + c0), b1 = *(const f32x4*)(P.conv_b + c0 + 4); a[0] = b0.x; a[1] = b0.y; a[2] = b0.z; a[3] = b0.w; a[4] = b1.x; a[5] = b1.y; a[6] = b1.z; a[7] = b1.w; }
#pragma unroll
            for (int w = 0; w < 5; ++w) { const int rr = r + w - 2;
                if (rr >= s0 && rr < s0 + sl) {
                    const u32x4 xv = *(const u32x4*)(PR + (size_t)rr * PC + C_XBC + c0);
                    const f32x4 w0 = *(const f32x4*)(P.conv_w + w * 1024 + c0), w1 = *(const f32x4*)(P.conv_w + w * 1024 + c0 + 4);
                    a[0] += w0.x * bflo(xv.x); a[1] += w0.y * bfhi(xv.x); a[2] += w0.z * bflo(xv.y); a[3] += w0.w * bfhi(xv.y);
                    a[4] += w1.x * bflo(xv.z); a[5] += w1.y * bfhi(xv.z); a[6] += w1.z * bflo(xv.w); a[7] += w1.w * bfhi(xv.w);
                } }
            u32x4 o; o.x = pk2(silu_acc(a[0]), silu_acc(a[1])); o.y = pk2(silu_acc(a[2]), silu_acc(a[3])); o.z = pk2(silu_acc(a[4]), silu_acc(a[5])); o.w = pk2(silu_acc(a[6]), silu_acc(a[7]));
            *(u32x4*)(U + (size_t)r * 1024 + c0) = o;
        }
        for (int idx = gtid; idx < MT * 8; idx += NT) {
            const int r = idx >> 3, kvh = (idx >> 2) & 1, d0 = (idx & 3) * 8;
            const u32x4 ka = *(const u32x4*)(PR + (size_t)r * PC + C_K + kvh * 64 + d0), kb = *(const u32x4*)(PR + (size_t)r * PC + C_K + kvh * 64 + 32 + d0);
            u32x4 oa = ka, ob = kb;
            if (r < ML) {
                const int pos = r % SEQ;
                const f32x4 c0 = *(const f32x4*)(ROPEC + pos * 32 + d0), c1 = *(const f32x4*)(ROPEC + pos * 32 + d0 + 4), s0_ = *(const f32x4*)(ROPES + pos * 32 + d0), s1_ = *(const f32x4*)(ROPES + pos * 32 + d0 + 4);
                const float cs[8] = {c0.x, c0.y, c0.z, c0.w, c1.x, c1.y, c1.z, c1.w}, sn[8] = {s0_.x, s0_.y, s0_.z, s0_.w, s1_.x, s1_.y, s1_.z, s1_.w};
                const unsigned kaw[4] = {ka.x, ka.y, ka.z, ka.w}, kbw[4] = {kb.x, kb.y, kb.z, kb.w};
                unsigned oaw[4], obw[4];
#pragma unroll
                for (int i = 0; i < 4; ++i) {
                    const float a0 = bflo(kaw[i]), a1 = bfhi(kaw[i]), b0 = bflo(kbw[i]), b1 = bfhi(kbw[i]);
                    oaw[i] = pk2(a0 * cs[2 * i] - b0 * sn[2 * i], a1 * cs[2 * i + 1] - b1 * sn[2 * i + 1]);
                    obw[i] = pk2(b0 * cs[2 * i] + a0 * sn[2 * i], b1 * cs[2 * i + 1] + a1 * sn[2 * i + 1]);
                }
                oa = (u32x4){oaw[0], oaw[1], oaw[2], oaw[3]}; ob = (u32x4){obw[0], obw[1], obw[2], obw[3]};
            }
            *(u32x4*)(KR + (size_t)r * 128 + kvh * 64 + d0) = oa; *(u32x4*)(KR + (size_t)r * 128 + kvh * 64 + 32 + d0) = ob;
        }
        for (int sidx = gtid; sidx < NCH * 16; sidx += NT) {
            const int q = sidx >> 4, dh = sidx & 15, dir = dh >> 3;
            const int r0 = chunk_row0(q);
            const float A = -expf(P.a_log[dh]);
            float cs = 0.f;
            if (dir == 0) { for (int i = 0; i < 128; ++i) { cs += DT[(r0 + i) * 16 + dh] * A; ACS[(q * 16 + dh) * 128 + i] = cs; } }
            else { for (int i = 127; i >= 0; --i) { cs += DT[(r0 + i) * 16 + dh] * A; ACS[(q * 16 + dh) * 128 + i] = cs; } }
            AL[q * 16 + dh] = cs;
        }
    }
    SEAM(4);
    if (IN(5)) {
        for (size_t idx = gtid; idx < (size_t)NCH * 16 * 8192; idx += NT) {
            const int n = (int)(idx & 127), p = (int)((idx >> 7) & 63), dh = (int)((idx >> 13) & 15), q = (int)(idx >> 17);
            const int head = dh & 7, g = head >> 2, r0 = chunk_row0(q);
            const float al = AL[q * 16 + dh];
            const float* acs = ACS + (q * 16 + dh) * 128;
            float a = 0.f;
            for (int j = 0; j < 128; ++j) {
                const bf16* u = U + (size_t)(r0 + j) * 1024;
                a += bf2f(u[512 + g * 128 + n]) * (expf(al - acs[j]) * DT[(r0 + j) * 16 + dh] * bf2f(u[head * 64 + p]));
            }
            S[idx] = (bf16)f2bf(a);
        }
    }
    SEAM(5);
    if (IN(6)) {
        for (int idx = gtid; idx < NB * 16 * 8192; idx += NT) {
            const int pn = idx & 8191, dh = (idx >> 13) & 15, b = idx >> 17, dir = dh >> 3;
            const int qa = dir == 0 ? 128 + 2 * b : 129 + 2 * b, qb = dir == 0 ? 129 + 2 * b : 128 + 2 * b;
            float h = bf2f(S[((size_t)qa * 16 + dh) * 8192 + pn]);
            h = expf(AL[qb * 16 + dh]) * h + bf2f(S[((size_t)qb * 16 + dh) * 8192 + pn]);
            for (int cc = 0; cc < 64; ++cc) {
                const int q = 64 * b + (dir == 0 ? cc : 63 - cc);
                const size_t o = ((size_t)q * 16 + dh) * 8192 + pn;
                const float tmp = bf2f(S[o]); S[o] = (bf16)f2bf(h); h = expf(AL[q * 16 + dh]) * h + tmp;
            }
        }
    }
    SEAM(6);
    if (IN(7)) {
        LAS float* cb = (LAS float*)lds;
        LAS float* red = cb + 256;
        for (int r = bid; r < ML; r += G) {
            const int q = r >> 7, i = r & 127, r0 = q * 128;
            __syncthreads();
            if (tid < 256) {
                const int g = tid >> 7, j = tid & 127;
                const bf16* ci = U + (size_t)r * 1024 + 768 + g * 128;
                const bf16* bj = U + (size_t)(r0 + j) * 1024 + 512 + g * 128;
                float a = 0.f;
                for (int n = 0; n < 128; ++n) a += bf2f(ci[n]) * bf2f(bj[n]);
                cb[tid] = a;
            }
            __syncthreads();
            const int head = tid >> 6, p = tid & 63, g = head >> 2;
            float y = 0.f;
            for (int dir = 0; dir < 2; ++dir) {
                const int dh = dir * 8 + head;
                const float* acs = ACS + (q * 16 + dh) * 128;
                const float ai = acs[i];
                const int j0 = dir == 0 ? 0 : i, j1 = dir == 0 ? i : 127;
                float a = 0.f;
                for (int j = j0; j <= j1; ++j) a += cb[g * 128 + j] * expf(ai - acs[j]) * DT[(r0 + j) * 16 + dh] * bf2f(U[(size_t)(r0 + j) * 1024 + head * 64 + p]);
                const bf16* hp = S + ((size_t)q * 16 + dh) * 8192 + p * 128;
                const bf16* ci = U + (size_t)r * 1024 + 768 + g * 128;
                float off = 0.f;
                for (int n = 0; n < 128; ++n) off += bf2f(ci[n]) * bf2f(hp[n]);
                y += a + expf(ai) * off;
            }
            y += P.d_skip[head] * bf2f(U[(size_t)r * 1024 + tid]);
            y *= silu_acc(bf2f(PR[(size_t)r * PC + C_Z + tid]));
            const float ss = wave_sum(y * y);
            if (lane == 0) red[wave] = ss;
            __syncthreads();
            float tot = 0.f;
#pragma unroll
            for (int w = 0; w < 8; ++w) tot += red[w];
            MIX[(size_t)r * 1024 + tid] = (bf16)f2bf(y * rsqrtf(tot * (1.f / 512.f) + EPS) * P.ssd_norm[tid]);
        }
        __syncthreads();
        {
            typedef float f32x16 __attribute__((ext_vector_type(16)));
            typedef short s16x8 __attribute__((ext_vector_type(8)));
            typedef short s16x4 __attribute__((ext_vector_type(4)));
            const int r32 = lane & 31, hi_ = lane >> 5;
            LAS unsigned char* Kb = lds;
            LAS unsigned char* Vb = lds + 8192;
            LAS float* wsf = (LAS float*)(lds + 16384) + wave * 64;
            const float C2 = 0.125f * 1.4426950408889634f;
            const int vboff = ((lane >> 4) & 1) * 32 + (lane & 3) * 8 + (4 * hi_ + ((lane & 15) >> 2)) * 64;
            for (int L = bid; L < 512; L += G) {
                const int pair = L & 1, kvh = (L >> 1) & 1, nb = (L >> 2) & 63, b = L >> 8;
                const int hq = kvh * 4 + pair * 2 + (wave >> 2), qq = (wave & 3) * 32 + r32;
                const int qrow = b * SEQ + nb * 128 + qq, pos = nb * 128 + qq;
                s16x8 qr[4];
                {
                    const bf16* qp = PR + (size_t)qrow * PC + C_Q + hq * 64 + 8 * hi_;
                    u32x4 raw[4];
#pragma unroll
                    for (int d0 = 0; d0 < 4; ++d0) raw[d0] = *(const u32x4*)(qp + 16 * d0);
#pragma unroll
                    for (int dd = 0; dd < 2; ++dd) {
                        const float* cp = ROPEC + pos * 32 + 16 * dd + 8 * hi_; const float* sp = ROPES + pos * 32 + 16 * dd + 8 * hi_;
                        const f32x4 c0 = *(const f32x4*)cp, c1 = *(const f32x4*)(cp + 4), s0_ = *(const f32x4*)sp, s1_ = *(const f32x4*)(sp + 4);
                        const float cs[8] = {c0.x, c0.y, c0.z, c0.w, c1.x, c1.y, c1.z, c1.w}, sn[8] = {s0_.x, s0_.y, s0_.z, s0_.w, s1_.x, s1_.y, s1_.z, s1_.w};
                        const unsigned aw[4] = {raw[dd].x, raw[dd].y, raw[dd].z, raw[dd].w}, bw[4] = {raw[dd + 2].x, raw[dd + 2].y, raw[dd + 2].z, raw[dd + 2].w};
                        unsigned oa[4], ob[4];
#pragma unroll
                        for (int i = 0; i < 4; ++i) {
                            const float a0 = bflo(aw[i]), a1 = bfhi(aw[i]), b0 = bflo(bw[i]), b1 = bfhi(bw[i]);
                            oa[i] = pk2((a0 * cs[2 * i] - b0 * sn[2 * i]) * C2, (a1 * cs[2 * i + 1] - b1 * sn[2 * i + 1]) * C2);
                            ob[i] = pk2((b0 * cs[2 * i] + a0 * sn[2 * i]) * C2, (b1 * cs[2 * i + 1] + a1 * sn[2 * i + 1]) * C2);
                        }
                        qr[dd] = __builtin_bit_cast(s16x8, (u32x4){oa[0], oa[1], oa[2], oa[3]});
                        qr[dd + 2] = __builtin_bit_cast(s16x8, (u32x4){ob[0], ob[1], ob[2], ob[3]});
                    }
                }
                f32x16 o0 = {0.f}, o1 = {0.f};
#pragma unroll
                for (int r = 0; r < 16; ++r) { o0[r] = 0.f; o1[r] = 0.f; }
                float m_run = -INFINITY, l_run = 0.f;
                const int tfirst = 0;
                auto tile_row0 = [&](int t) -> int { return t < 4 ? ML + b * CTXL + 64 * t : b * SEQ + (nb - 1) * 128 + 64 * (t - 4); };
                auto tile_ok = [&](int t) -> bool { return !((nb == 0 && (t == 4 || t == 5)) || (nb == 63 && (t == 8 || t == 9))); };
                u32x4 kreg, vreg;
                {
                    const int row0 = tile_row0(tfirst);
                    kreg = *(const u32x4*)(KR + (size_t)(row0 + lane) * 128 + kvh * 64 + wave * 8);
                    vreg = *(const u32x4*)(PR + (size_t)(row0 + 16 * (wave & 3) + (lane >> 2)) * PC + C_V + kvh * 64 + (wave >> 2) * 32 + (lane & 3) * 8);
                }
                for (int t = 0; t < 10; ++t) {
                    if (!tile_ok(t)) continue;
                    __syncthreads();
                    *(LAS u32x4*)(Kb + wave * 1024 + lane * 16) = kreg;
                    *(LAS u32x4*)(Vb + wave * 1024 + lane * 16) = vreg;
                    __syncthreads();
                    {
                        int tn = t + 1; while (tn < 10 && !tile_ok(tn)) ++tn;
                        if (tn < 10) {
                            const int row0 = tile_row0(tn);
                            kreg = *(const u32x4*)(KR + (size_t)(row0 + lane) * 128 + kvh * 64 + wave * 8);
                            vreg = *(const u32x4*)(PR + (size_t)(row0 + 16 * (wave & 3) + (lane >> 2)) * PC + C_V + kvh * 64 + (wave >> 2) * 32 + (lane & 3) * 8);
                        }
                    }
                    f32x16 p0, p1;
#pragma unroll
                    for (int r = 0; r < 16; ++r) { p0[r] = 0.f; p1[r] = 0.f; }
#pragma unroll
                    for (int d0 = 0; d0 < 4; ++d0) {
                        const s16x8 b0 = *(const LAS s16x8*)(Kb + d0 * 2048 + hi_ * 1024 + r32 * 16);
                        const s16x8 b1 = *(const LAS s16x8*)(Kb + d0 * 2048 + hi_ * 1024 + r32 * 16 + 512);
                        p0 = __builtin_amdgcn_mfma_f32_32x32x16_bf16(b0, qr[d0], p0, 0, 0, 0);
                        p1 = __builtin_amdgcn_mfma_f32_32x32x16_bf16(b1, qr[d0], p1, 0, 0, 0);
                    }
                    if (t == 4 || t == 5) {
                        const int kb0 = 64 * (t - 4) + 4 * hi_;
#pragma unroll
                        for (int r = 0; r < 16; ++r) { const int kk = kb0 + (r & 3) + 8 * (r >> 2); if (kk < qq) p0[r] = -INFINITY; if (kk + 32 < qq) p1[r] = -INFINITY; }
                    } else if (t >= 8) {
                        const int kb0 = 64 * (t - 8) + 4 * hi_;
#pragma unroll
                        for (int r = 0; r < 16; ++r) { const int kk = kb0 + (r & 3) + 8 * (r >> 2); if (kk > qq) p0[r] = -INFINITY; if (kk + 32 > qq) p1[r] = -INFINITY; }
                    }
                    float mx = fmaxf(p0[0], p1[0]);
#pragma unroll
                    for (int r = 1; r < 16; ++r) mx = fmaxf(mx, fmaxf(p0[r], p1[r]));
                    mx = fmaxf(mx, __shfl_xor(mx, 32));
                    const float m_new = fmaxf(m_run, mx);
                    const float alpha = __builtin_amdgcn_exp2f(m_run - m_new);
                    m_run = m_new;
                    float rs = 0.f;
#pragma unroll
                    for (int r = 0; r < 16; ++r) { p0[r] = __builtin_amdgcn_exp2f(p0[r] - m_new); p1[r] = __builtin_amdgcn_exp2f(p1[r] - m_new); rs += p0[r] + p1[r]; }
                    l_run = l_run * alpha + rs;
                    if (__any(alpha != 1.0f)) {
                        if (hi_ == 0) wsf[r32] = alpha;
                        __builtin_amdgcn_wave_barrier();
#pragma unroll
                        for (int r = 0; r < 16; ++r) { const float a = wsf[(r & 3) + 8 * (r >> 2) + 4 * hi_]; o0[r] *= a; o1[r] *= a; }
                        __builtin_amdgcn_wave_barrier();
                    }
                    s16x8 pa[4];
                    pa[0] = __builtin_bit_cast(s16x8, (u32x4){pg8::cvt_pk_bf16(p0[0], p0[1]), pg8::cvt_pk_bf16(p0[2], p0[3]), pg8::cvt_pk_bf16(p0[4], p0[5]), pg8::cvt_pk_bf16(p0[6], p0[7])});
                    pa[1] = __builtin_bit_cast(s16x8, (u32x4){pg8::cvt_pk_bf16(p0[8], p0[9]), pg8::cvt_pk_bf16(p0[10], p0[11]), pg8::cvt_pk_bf16(p0[12], p0[13]), pg8::cvt_pk_bf16(p0[14], p0[15])});
                    pa[2] = __builtin_bit_cast(s16x8, (u32x4){pg8::cvt_pk_bf16(p1[0], p1[1]), pg8::cvt_pk_bf16(p1[2], p1[3]), pg8::cvt_pk_bf16(p1[4], p1[5]), pg8::cvt_pk_bf16(p1[6], p1[7])});
                    pa[3] = __builtin_bit_cast(s16x8, (u32x4){pg8::cvt_pk_bf16(p1[8], p1[9]), pg8::cvt_pk_bf16(p1[10], p1[11]), pg8::cvt_pk_bf16(p1[12], p1[13]), pg8::cvt_pk_bf16(p1[14], p1[15])});
#pragma unroll
                    for (int ks = 0; ks < 4; ++ks) {
                        typedef short v4i16_t __attribute__((ext_vector_type(4)));
                        const s16x4 l0 = __builtin_bit_cast(s16x4, __builtin_amdgcn_ds_read_tr16_b64_v4i16((LAS v4i16_t*)(Vb + vboff + ks * 1024)));
                        const s16x4 h0 = __builtin_bit_cast(s16x4, __builtin_amdgcn_ds_read_tr16_b64_v4i16((LAS v4i16_t*)(Vb + vboff + ks * 1024 + 512)));
                        const s16x4 l1 = __builtin_bit_cast(s16x4, __builtin_amdgcn_ds_read_tr16_b64_v4i16((LAS v4i16_t*)(Vb + vboff + 4096 + ks * 1024)));
                        const s16x4 h1 = __builtin_bit_cast(s16x4, __builtin_amdgcn_ds_read_tr16_b64_v4i16((LAS v4i16_t*)(Vb + vboff + 4096 + ks * 1024 + 512)));
                        const s16x8 v0 = (s16x8){l0[0], l0[1], l0[2], l0[3], h0[0], h0[1], h0[2], h0[3]}, v1 = (s16x8){l1[0], l1[1], l1[2], l1[3], h1[0], h1[1], h1[2], h1[3]};
                        o0 = __builtin_amdgcn_mfma_f32_32x32x16_bf16(pa[ks], v0, o0, 0, 0, 0);
                        o1 = __builtin_amdgcn_mfma_f32_32x32x16_bf16(pa[ks], v1, o1, 0, 0, 0);
                    }
                }
                float l_tot = l_run + __shfl_xor(l_run, 32);
                l_tot += __builtin_amdgcn_exp2f(P.sinks[hq] * 1.4426950408889634f - m_run);
                if (hi_ == 0) wsf[r32] = 1.0f / l_tot;
                __builtin_amdgcn_wave_barrier();
                bf16* orow = MIX + (size_t)(b * SEQ + nb * 128 + (wave & 3) * 32) * 1024 + 512 + hq * 64 + r32;
#pragma unroll
                for (int r = 0; r < 16; ++r) { const int qi = (r & 3) + 8 * (r >> 2) + 4 * hi_; const float inv = wsf[qi];
                    orow[(size_t)qi * 1024] = (bf16)f2bf(o0[r] * inv); orow[(size_t)qi * 1024 + 32] = (bf16)f2bf(o1[r] * inv); }
                __builtin_amdgcn_wave_barrier();
            }
        }
    }
    SEAM(7);
    if (IN(8)) {
        pg8::Gemm g{MIX, WOUT, ML, DM, DM}; pg8::StaticOrder S_; S_.init(ML, DM, G, bid);
        EpiOutProj E{P.x, MOD, X1};
        pg8::gemm_phase<EpiOutProj, pg8::StaticOrder, false, true>(lds, g, S_, E);
    }
    SEAM(8);
    if (IN(9)) {
        for (int r = gw; r < ML; r += NGW) {
            const float* mod = MOD + (r / SEQ) * 6144;
            f32x4 v[4]; float s = 0.f;
#pragma unroll
            for (int j = 0; j < 4; ++j) { v[j] = *(const f32x4*)(X1 + (size_t)r * DM + j * 256 + lane * 4); s += v[j].x * v[j].x + v[j].y * v[j].y + v[j].z * v[j].z + v[j].w * v[j].w; }
            const float rstd = rsqrtf(wave_sum(s) * (1.f / DM) + EPS);
            float lg[36];
#pragma unroll
            for (int e = 0; e < 36; ++e) lg[e] = 0.f;
#pragma unroll 1
            for (int j = 0; j < 4; ++j) {
                const int c0 = j * 256 + lane * 4;
                const f32x4 g = *(const f32x4*)(P.norm2 + c0), sh = *(const f32x4*)(mod + 3072 + c0), scv = *(const f32x4*)(mod + 4096 + c0);
                f32x4 o;
                o.x = v[j].x * rstd * g.x * (1.f + scv.x) + sh.x; o.y = v[j].y * rstd * g.y * (1.f + scv.y) + sh.y;
                o.z = v[j].z * rstd * g.z * (1.f + scv.z) + sh.z; o.w = v[j].w * rstd * g.w * (1.f + scv.w) + sh.w;
#pragma unroll 1
                for (int cc = 0; cc < 4; ++cc) {
                    const float hv = o[cc];
                    const f32x4 wg = *(const f32x4*)(P.w_group + (size_t)(c0 + cc) * 4);
                    lg[0] += hv * wg.x; lg[1] += hv * wg.y; lg[2] += hv * wg.z; lg[3] += hv * wg.w;
                    const float* we = P.w_expert + (size_t)(c0 + cc) * 32;
#pragma unroll
                    for (int e4 = 0; e4 < 8; ++e4) { const f32x4 wv = *(const f32x4*)(we + e4 * 4);
                        lg[4 + e4 * 4 + 0] += hv * wv.x; lg[4 + e4 * 4 + 1] += hv * wv.y; lg[4 + e4 * 4 + 2] += hv * wv.z; lg[4 + e4 * 4 + 3] += hv * wv.w; }
                }
            }
#pragma unroll
            for (int e = 0; e < 36; ++e) lg[e] = wave_sum(lg[e]);
            if (lane == 0) {
                float gl[4]; float gm = -INFINITY; int gi = 0;
#pragma unroll
                for (int e = 0; e < 4; ++e) { gl[e] = lg[e] + P.b_group[e]; if (gl[e] > gm) { gm = gl[e]; gi = e; } }
                float gs = 0.f;
#pragma unroll
                for (int e = 0; e < 4; ++e) gs += expf(gl[e] - gm);
                const float gwt = 1.f / gs;
                float el[8]; float em = -INFINITY; int e1 = 0;
#pragma unroll
                for (int e = 0; e < 8; ++e) {
                    float vsel = 0.f;
#pragma unroll
                    for (int gg = 0; gg < 4; ++gg) if (gg == gi) vsel = lg[4 + gg * 8 + e] + P.b_expert[gg * 8 + e];
                    el[e] = vsel; if (vsel > em) { em = vsel; e1 = e; }
                }
                float em2 = -INFINITY; int e2 = 0;
#pragma unroll
                for (int e = 0; e < 8; ++e) if (e != e1 && el[e] > em2) { em2 = el[e]; e2 = e; }
                const float p2 = expf(em2 - em);
                const float w1 = gwt / (1.f + p2), w2 = gwt * p2 / (1.f + p2);
                const int ex1 = gi * 8 + e1, ex2 = gi * 8 + e2;
                RSTD[r] = rstd;
                EID[r * 2] = ex1; POS[r * 2] = (int)atomicAdd(&CNT[ex1], 1u); EW[r * 2] = w1;
                EID[r * 2 + 1] = ex2; POS[r * 2 + 1] = (int)atomicAdd(&CNT[ex2], 1u); EW[r * 2 + 1] = w2;
            }
        }
    }
    SEAM(9);
    LAS int* pbase = (LAS int*)(lds + LDS_TAB);
    LAS int* pexp = pbase + 64;
    int npan = 0;
    if (hi > 10 && lo <= 13) {
        __syncthreads();
        if (tid == 0) { int acc_ = 0; for (int e = 0; e < NE; ++e) { pbase[e] = acc_ * 256; const int np = ((int)CNT[e] + 255) >> 8; for (int k = 0; k < np; ++k) pexp[acc_ + k] = e; acc_ += np; } pbase[NE] = acc_ * 256; }
        __syncthreads();
        npan = pbase[NE] >> 8;
    }
    if (IN(10)) {
        for (int sidx = gtid; sidx < npan * 256; sidx += NT) S2A[sidx] = -1;
    }
    SEAM(10);
    if (IN(11)) {
        for (int r = gw; r < ML; r += NGW) {
            const float* mod = MOD + (r / SEQ) * 6144;
            const float rstd = RSTD[r];
            const int s0 = pbase[EID[r * 2]] + POS[r * 2], s1 = pbase[EID[r * 2 + 1]] + POS[r * 2 + 1];
            if (lane == 0) { S2A[s0] = r * 2; S2A[s1] = r * 2 + 1; }
#pragma unroll
            for (int j = 0; j < 4; ++j) {
                const int c0 = j * 256 + lane * 4;
                const f32x4 v = *(const f32x4*)(X1 + (size_t)r * DM + c0);
                const f32x4 g = *(const f32x4*)(P.norm2 + c0), sh = *(const f32x4*)(mod + 3072 + c0), scv = *(const f32x4*)(mod + 4096 + c0);
                u32x2 w;
                w.x = pk2(v.x * rstd * g.x * (1.f + scv.x) + sh.x, v.y * rstd * g.y * (1.f + scv.y) + sh.y);
                w.y = pk2(v.z * rstd * g.z * (1.f + scv.z) + sh.z, v.w * rstd * g.w * (1.f + scv.w) + sh.w);
                *(u32x2*)(HS + (size_t)s0 * DM + c0) = w; *(u32x2*)(HS + (size_t)s1 * DM + c0) = w;
            }
        }
    }
    SEAM(11);
    if (IN(12)) {
        pg8::Gemm g{HS, WGU, npan * 256, NE * 1024, DM}; MoeOrder S_{pexp, npan, G, bid};
        EpiGateUp E{ACT};
        pg8::gemm_phase<EpiGateUp, MoeOrder, true, true>(lds, g, S_, E);
    }
    SEAM(12);
    if (IN(13)) {
        pg8::Gemm g{ACT, WD, npan * 256, NE * 1024, EDIM}; MoeOrder S_{pexp, npan, G, bid};
        EpiDown E{Y, S2A};
        pg8::gemm_phase<EpiDown, MoeOrder, true, true>(lds, g, S_, E);
    }
    SEAM(13);
    if (IN(14)) {
        for (int r = gw; r < ML; r += NGW) {
            const float* g2 = MOD + (r / SEQ) * 6144 + 5120;
            const float w0 = EW[r * 2], w1 = EW[r * 2 + 1];
            f32x4 v[4]; float s = 0.f;
#pragma unroll
            for (int j = 0; j < 4; ++j) {
                const int c0 = j * 256 + lane * 4;
                const f32x4 xv = *(const f32x4*)(X1 + (size_t)r * DM + c0);
                const u32x2 y0 = *(const u32x2*)(Y + (size_t)(r * 2) * DM + c0), y1 = *(const u32x2*)(Y + (size_t)(r * 2 + 1) * DM + c0);
                const f32x4 gg = *(const f32x4*)(g2 + c0);
                v[j].x = xv.x + gg.x * (w0 * bflo(y0.x) + w1 * bflo(y1.x)); v[j].y = xv.y + gg.y * (w0 * bfhi(y0.x) + w1 * bfhi(y1.x));
                v[j].z = xv.z + gg.z * (w0 * bflo(y0.y) + w1 * bflo(y1.y)); v[j].w = xv.w + gg.w * (w0 * bfhi(y0.y) + w1 * bfhi(y1.y));
                s += v[j].x * v[j].x + v[j].y * v[j].y + v[j].z * v[j].z + v[j].w * v[j].w;
            }
            const float rstd = rsqrtf(wave_sum(s) * (1.f / DM) + EPS);
#pragma unroll
            for (int j = 0; j < 4; ++j) {
                const int c0 = j * 256 + lane * 4;
                const f32x4 nf = *(const f32x4*)(P.norm_final + c0);
                f32x4 o; o.x = v[j].x * rstd * nf.x; o.y = v[j].y * rstd * nf.y; o.z = v[j].z * rstd * nf.z; o.w = v[j].w * rstd * nf.w;
                *(f32x4*)(P.out + (size_t)r * DM + c0) = o;
            }
        }
    }
#undef IN
#undef SEAM
}

#ifndef N_LAUNCHES
#define N_LAUNCHES 1
#endif
constexpr int N_PHASES = 15;

extern "C" void kernel_launch(void* const* d_in, const int* in_sizes, int n_in, void* d_out, int out_size, void* d_ws, size_t ws_size, hipStream_t stream) {
    static int grid = 0;
    if (grid == 0) {
        if (n_in != 25 || out_size != ML * DM || ws_size < WS_NEED) { fprintf(stderr, "kernel_launch: unexpected problem (n_in %d out %d ws %zu need %zu)\n", n_in, out_size, ws_size, (size_t)WS_NEED); grid = -1; return; }
        int dev = 0, cus = 0, per_cu = 0;
        (void)hipGetDevice(&dev);
        (void)hipDeviceGetAttribute(&cus, hipDeviceAttributeMultiprocessorCount, dev);
        (void)hipFuncSetAttribute((const void*)fwd_kernel, hipFuncAttributeMaxDynamicSharedMemorySize, LDS_BYTES);
        (void)hipOccupancyMaxActiveBlocksPerMultiprocessor(&per_cu, (const void*)fwd_kernel, NTHREADS, LDS_BYTES);
        (void)hipGetLastError();
        if (per_cu < 1) { fprintf(stderr, "kernel_launch: occupancy query says %d\n", per_cu); }
        grid = cus;
    }
    if (grid < 0) return;
    (void)hipMemsetAsync((char*)d_ws + WS_CTL, 0, CTL_ZERO_BYTES, stream);
    Args a{};
    const float** pp = (const float**)&a.p;
    for (int i = 0; i < 25; ++i) pp[i] = (const float*)d_in[i];
    a.p.out = (float*)d_out; a.p.ws = (unsigned char*)d_ws;
    if (N_LAUNCHES == 1) {
        a.ph_lo = 0; a.ph_hi = N_PHASES;
        hipLaunchKernelGGL(fwd_kernel, dim3(grid), dim3(NTHREADS), LDS_BYTES, stream, a);
    } else {
        for (int ph = 0; ph < N_PHASES; ++ph) { a.ph_lo = ph; a.ph_hi = ph + 1; hipLaunchKernelGGL(fwd_kernel, dim3(grid), dim3(NTHREADS), LDS_BYTES, stream, a); }
    }
}
```

```cpp
#include <hip/hip_runtime.h>
#include <cstdio>
#include <cstdint>

constexpr int DM = 1024, SEQ = 8192, NB = 2, CTXL = 256;
constexpr int ML = NB * SEQ;
constexpr int MC = NB * CTXL;
constexpr int MT = ML + MC;
constexpr int INC = 2320;
constexpr int PC = 2304;
constexpr int C_Z = 0, C_XBC = 512, C_Q = 1536, C_K = 2048, C_V = 2176;
constexpr int NCH = 132;
constexpr int NE = 32, EDIM = 512;
constexpr int MAXSLOT = 40960;
constexpr float EPS = 1e-6f;

constexpr size_t MiB = 1u << 20;
constexpr size_t WS_CTL = 0, CTL_ZERO_BYTES = 64 * 1024;
constexpr size_t WS_MODP = 1 * MiB;
constexpr size_t WS_MOD = WS_MODP + 16 * 3 * 6144 * 4;
constexpr size_t WS_ROPE = 3 * MiB;
constexpr size_t WS_DT = 5 * MiB;
constexpr size_t WS_ACS = 6 * MiB + 512 * 1024;
constexpr size_t WS_AL = 8 * MiB;
constexpr size_t WS_EW = 8 * MiB + 64 * 1024;
constexpr size_t WS_RSTD = 8 * MiB + 256 * 1024;
constexpr size_t WS_EID = 8 * MiB + 512 * 1024;
constexpr size_t WS_POS = 9 * MiB;
constexpr size_t WS_LIST = 10 * MiB;
constexpr size_t WS_FV = 8 * MiB + 16 * 1024;
constexpr size_t WS_RB = 8 * MiB + 32 * 1024;
constexpr size_t WS_F1 = 8 * MiB + 40 * 1024;
constexpr size_t WS_DB = 8 * MiB + 56 * 1024;
constexpr size_t WS_WDT = 9 * MiB + 256 * 1024;
constexpr size_t WS_WR = 9 * MiB + 512 * 1024;
constexpr size_t WS_WIN = 12 * MiB;
constexpr size_t WS_WOUT = 17 * MiB;
constexpr size_t WS_WGU = 20 * MiB;
constexpr size_t WS_WD = 84 * MiB;
constexpr size_t WS_HX = 116 * MiB;
constexpr size_t WS_XST = 116 * MiB;
constexpr size_t WS_BT = WS_XST + (size_t)NCH * 512 * 128 * 2;
constexpr size_t WS_P = 149 * MiB;
constexpr size_t WS_X1 = 149 * MiB;
constexpr size_t WS_U = WS_P + (size_t)MT * PC * 2;
constexpr size_t WS_S = WS_U + 33 * MiB;
constexpr size_t WS_KR = 289 * MiB + 512 * 1024;
constexpr size_t WS_HS = 213 * MiB;
constexpr size_t WS_NEED = 294 * MiB;
static_assert(WS_BT + (size_t)NCH * 256 * 128 * 2 <= WS_P, "XST/BT fit in the HX slot");
static_assert(WS_S + 33 * MiB <= WS_KR && WS_KR + (size_t)(MT + 128) * 128 * 2 <= WS_NEED, "ws budget");
static_assert(WS_X1 + (size_t)ML * 1024 * 4 <= WS_HS && WS_HS + (size_t)MAXSLOT * 1024 * 2 <= WS_NEED, "X1 | HS");
constexpr int CW_CNT = 8192;
constexpr int CW_BAR = 1024;

constexpr int LDS_BYTES = 147456;
constexpr int LDS_TAB = 131072;
constexpr int NTHREADS = 512;

#define LAS __attribute__((address_space(3)))
typedef unsigned short bf16;

#define XB_TMO      128
#define XB_XCNT(j)  (256  + 64 * (j))
#define XB_XSUB(j)  (1280 + 64 * (j))
#define XB_XGEN(j)  (2304 + 64 * (j))
#define XB_TOP      3328
#define XB_TOPGEN   3392
#define XCD_BAR_WORDS 3456
#define XB_SPIN_CAP (1u << 18)
__device__ __forceinline__ unsigned xb_ld(unsigned* p)              { return __hip_atomic_load(p, __ATOMIC_RELAXED, __HIP_MEMORY_SCOPE_AGENT); }
__device__ __forceinline__ unsigned xb_add(unsigned* p, unsigned v) { return __hip_atomic_fetch_add(p, v, __ATOMIC_RELAXED, __HIP_MEMORY_SCOPE_AGENT); }
__device__ __forceinline__ unsigned xb_xcc_id() { return (unsigned)__builtin_amdgcn_s_getreg((3 << 11) | 20) & 0xFu; }
#define XB_SPIN(cond, bar) do { unsigned _sp = 0; while (cond) { __builtin_amdgcn_s_sleep(1); \
    if ((++_sp & 255u) == 0u) { if (xb_ld(&(bar)[XB_TMO])) break; if (_sp > XB_SPIN_CAP) { atomicAdd(&(bar)[XB_TMO], 1u); break; } } } } while (0)
struct XcdBarrier { unsigned* bar; unsigned x; volatile LAS unsigned* st; };
__device__ __forceinline__ XcdBarrier xcd_barrier_post(unsigned* bar, volatile LAS unsigned* st) {
    XcdBarrier b; b.bar = bar; b.x = xb_xcc_id(); b.st = st;
    if (threadIdx.x == 0) (void)xb_add(&bar[XB_XCNT(b.x)], 1u);
    return b;
}
__device__ __forceinline__ void xcd_barrier_complete(unsigned* bar, unsigned x, unsigned& nloc, unsigned& nx) {
    const unsigned G = gridDim.x * gridDim.y * gridDim.z;
    unsigned sum, cnt, mine, sp = 0u;
    for (;;) {
        sum = 0u; cnt = 0u; mine = 0u;
#pragma unroll
        for (unsigned j = 0; j < 16; ++j) { const unsigned c = xb_ld(&bar[XB_XCNT(j)]); sum += c; cnt += (c > 0u) ? 1u : 0u; mine = (j == x) ? c : mine; }
        if (sum == G) break;
        __builtin_amdgcn_s_sleep(1);
        if ((++sp & 255u) == 0u) { if (xb_ld(&bar[XB_TMO])) break; if (sp > XB_SPIN_CAP) { atomicAdd(&bar[XB_TMO], 1u); break; } }
    }
    nloc = mine > 0u ? mine : 1u; nx = cnt > 0u ? cnt : 1u;
}
__device__ __forceinline__ void xcd_barrier(const XcdBarrier& b) {
    asm volatile("s_waitcnt vmcnt(0)" ::: "memory");
    __syncthreads();
    if (threadIdx.x == 0) {
        unsigned* bar = b.bar;
        __builtin_amdgcn_s_waitcnt(0);
        unsigned nloc = b.st[0], nx = b.st[1];
        if (nloc == 0u) { xcd_barrier_complete(bar, b.x, nloc, nx); b.st[0] = nloc; b.st[1] = nx; }
        const unsigned old = xb_add(&bar[XB_XSUB(b.x)], 1u);
        const unsigned gen = old / nloc;
        if (old + 1u == (gen + 1u) * nloc) {
            __builtin_amdgcn_fence(__ATOMIC_RELEASE, "agent");
            asm volatile("s_waitcnt vmcnt(0)" ::: "memory");
            const unsigned og = xb_add(&bar[XB_TOP], 1u);
            const unsigned tg = og / nx;
            if (og + 1u == (tg + 1u) * nx) xb_add(&bar[XB_TOPGEN], 1u);
            else XB_SPIN(xb_ld(&bar[XB_TOPGEN]) == tg, bar);
            __builtin_amdgcn_fence(__ATOMIC_ACQUIRE, "agent");
            xb_add(&bar[XB_XGEN(b.x)], 1u);
            asm volatile("s_waitcnt vmcnt(0)" ::: "memory");
        } else {
            XB_SPIN(xb_ld(&bar[XB_XGEN(b.x)]) == gen, bar);
            __builtin_amdgcn_fence(__ATOMIC_ACQUIRE, "agent");
            asm volatile("s_waitcnt vmcnt(0)" ::: "memory");
        }
    }
    __syncthreads();
}


namespace pg8 {
#define PG8_LAS __attribute__((address_space(3)))
typedef unsigned short bf16_t;
typedef short bf16x8 __attribute__((ext_vector_type(8)));
typedef float f32x4 __attribute__((ext_vector_type(4)));
typedef unsigned u32x4 __attribute__((ext_vector_type(4)));
constexpr int BM = 256, BK = 64, HALF = 128, HTB = HALF * BK * 2  , STAGE_BYTES = 8 * HTB, NXCD = 8, WGM = 8;

__host__ __device__ __forceinline__ int lds_byte(int r, int c) { const int st = (r >> 4) * 2 + (c >> 5), rr = r & 15, cc = c & 31, ob = rr * 64 + cc * 2; return st * 1024 + (ob ^ (((ob >> 9) & 1) << 5)); }
__host__ __device__ __forceinline__ void stage_rc(int b, int& R, int& C) { const int st = b / 1024, sb = b % 1024, swz = sb ^ (((sb >> 9) & 1) << 5); R = (st >> 1) * 16 + swz / 64; C = (st & 1) * 32 + (swz % 64) / 2; }
__host__ __device__ __forceinline__ int perm32(int rho) { const int n = rho >> 4, i = rho & 15; return 8 * (i >> 2) + 4 * n + (i & 3); }

struct Unit { int pm, pn; };
struct Gemm { const bf16_t* A; const bf16_t* Bt; int M, N, K; };

struct StaticOrder {
    static constexpr bool GATHER = false;
    int nM, nN, nwg, G, c;
    __host__ __device__ void init(int M, int N, int G_, int c_) { nM = M / BM; nN = N / BM; nwg = nM * nN; G = G_; c = c_; }
    __host__ __device__ bool next(int i, Unit& u) const {
        const long L = (long)i * G + c; if (L >= nwg) return false;
        int wgid = (int)L; { const int q = nwg / NXCD, r = nwg % NXCD, xcd = wgid % NXCD, off = wgid / NXCD; wgid = (xcd < r ? xcd * (q + 1) : r * (q + 1) + (xcd - r) * q) + off; }
        const int nig = WGM * nN, gid = wgid / nig, fm = gid * WGM, gsz = (nM - fm) < WGM ? (nM - fm) : WGM;
        u.pm = fm + ((wgid % nig) % gsz); u.pn = (wgid % nig) / gsz; return true;
    }
    __device__ __forceinline__ void a_ready(const Unit&) const {}
    __device__ __forceinline__ void done(const Unit&) const {}
};

__device__ __forceinline__ unsigned cvt_pk_bf16(float lo, float hi) { unsigned r; asm volatile("v_cvt_pk_bf16_f32 %0, %1, %2" : "=v"(r) : "v"(lo), "v"(hi)); return r; }
typedef float f32x2 __attribute__((ext_vector_type(2)));
template <class Epi, class Sched, bool ALIGN_EPI = false, bool SP2 = false>
__device__ __forceinline__ void gemm_phase(PG8_LAS unsigned char* lds, const Gemm g, const Sched& S, const Epi& E) {
    const int tid = threadIdx.x, wid = __builtin_amdgcn_readfirstlane(tid >> 6), lane = tid & 63, wr = wid >> 2, wc = wid & 3, fr = lane & 15, fq = lane >> 4;
    const int K = g.K, nt = K / BK;
    unsigned voffA[2], voffB[2]; int gR[2], gC[2]; unsigned gvc[2][2] = {{0u, 0u}, {0u, 0u}}, gvn[2][2] = {{0u, 0u}, {0u, 0u}};
#pragma unroll
    for (int i = 0; i < 2; ++i) { int R, C; stage_rc(tid * 16 + i * 8192, R, C); const int Rb = Epi::PERM ? ((R & ~31) + perm32(R & 31)) : R;
        voffA[i] = (unsigned)(R * K + C) * 2u; gR[i] = R; gC[i] = C; voffB[i] = (unsigned)(Rb * K + C) * 2u; }
    const size_t kstep = (size_t)(BK * 2);
    const size_t hstep = (size_t)HALF * K * 2;
    const size_t tstep = 2 * hstep;
    const unsigned ldsw = (unsigned)wid * 1024u;
    const int aoff = lds_byte(wr * 64 + fr, fq * 8), boff = lds_byte(wc * 32 + fr, fq * 8);
#define PG8_SA(b, h) (((b) * 2 + (h)) * HTB)
#define PG8_SB(b, h) ((4 + (b) * 2 + (h)) * HTB)
#define PG8_STAGE(bufoff, gbase, voff) do { _Pragma("unroll") for (int _i = 0; _i < 2; ++_i) \
        __builtin_amdgcn_global_load_lds((const unsigned*)((const char*)(gbase) + (voff)[_i]), (PG8_LAS unsigned*)(lds + (bufoff) + ldsw + _i * 8192), 16, 0, 0); } while (0)
#define PG8_STAGE_A(bufoff, ptr, h, nx) do { if constexpr (Sched::GATHER) { _Pragma("unroll") for (int _i = 0; _i < 2; ++_i) { const unsigned _o = (nx) ? gvn[h][_i] : gvc[h][_i]; \
        __builtin_amdgcn_global_load_lds((const unsigned*)((const char*)(ptr) + _o), (PG8_LAS unsigned*)(lds + (bufoff) + ldsw + _i * 8192), 16, 0, 0); } } \
        else { PG8_STAGE(bufoff, (ptr) + (h) * hstep, voffA); } } while (0)
#define PG8_LDA(dst, b, h) do { _Pragma("unroll") for (int m = 0; m < 4; ++m) _Pragma("unroll") for (int k = 0; k < 2; ++k) dst[m][k] = *(const PG8_LAS bf16x8*)(lds + PG8_SA(b, h) + aoff + m * 2048 + k * 1024); } while (0)
#define PG8_LDB(dst, b, h) do { _Pragma("unroll") for (int n = 0; n < 2; ++n) _Pragma("unroll") for (int k = 0; k < 2; ++k) dst[n][k] = *(const PG8_LAS bf16x8*)(lds + PG8_SB(b, h) + boff + n * 2048 + k * 1024); } while (0)
#define PG8_MMA(ai, bj, At, Bt) do { __builtin_amdgcn_s_setprio(1); _Pragma("unroll") for (int m = 0; m < 4; ++m) _Pragma("unroll") for (int n = 0; n < 2; ++n) _Pragma("unroll") for (int k = 0; k < 2; ++k) \
        acc[ai][bj][m][n] = __builtin_amdgcn_mfma_f32_16x16x32_bf16(Bt[n][k], At[m][k], acc[ai][bj][m][n], 0, 0, 0); __builtin_amdgcn_s_setprio(0); } while (0)
#define PG8_WAIT_V(n) asm volatile("s_waitcnt vmcnt(" #n ")" ::: "memory")
#define PG8_WAIT_L(n) asm volatile("s_waitcnt lgkmcnt(" #n ")" ::: "memory")
#define PG8_BAR __builtin_amdgcn_s_barrier()
#define PG8_SCHED __builtin_amdgcn_sched_barrier(0)
    Unit cur, nxt; int ui = 0;
    if (!S.next(0, cur)) return;
    f32x4 acc[2][2][4][2];
#pragma unroll
    for (int a = 0; a < 2; ++a)
#pragma unroll
        for (int b = 0; b < 2; ++b)
#pragma unroll
            for (int m = 0; m < 4; ++m)
#pragma unroll
                for (int n = 0; n < 2; ++n) acc[a][b][m][n] = (f32x4){0.f, 0.f, 0.f, 0.f};
    bf16x8 At[4][2], B0[2][2], B1[2][2];
    const char* cA = (const char*)g.A + (Sched::GATHER ? (size_t)0 : (size_t)cur.pm * tstep);
    if constexpr (Sched::GATHER) { _Pragma("unroll") for (int h = 0; h < 2; ++h) _Pragma("unroll") for (int i = 0; i < 2; ++i) gvc[h][i] = (unsigned)S.arow(cur, h * HALF + gR[i]) * (unsigned)(K * 2) + (unsigned)(gC[i] * 2); }
    const char* cB = (const char*)g.Bt + (size_t)cur.pn * tstep;
    S.a_ready(cur);
    if constexpr (SP2) {
        PG8_STAGE(PG8_SB(0, 0), cB, voffB); PG8_STAGE(PG8_SB(0, 1), cB + hstep, voffB); PG8_STAGE_A(PG8_SA(0, 0), cA, 0, false); PG8_STAGE_A(PG8_SA(0, 1), cA, 1, false);
        if (wr == 1) PG8_BAR;
        PG8_WAIT_V(2); PG8_BAR;
        PG8_STAGE(PG8_SB(1, 0), cB + kstep, voffB); PG8_STAGE_A(PG8_SA(1, 0), cA + kstep, 0, false); PG8_STAGE(PG8_SB(1, 1), cB + hstep + kstep, voffB);
        PG8_WAIT_V(6); PG8_BAR;
    } else {
        PG8_STAGE(PG8_SB(0, 0), cB, voffB); PG8_STAGE_A(PG8_SA(0, 0), cA, 0, false); PG8_STAGE(PG8_SB(0, 1), cB + hstep, voffB); PG8_STAGE_A(PG8_SA(0, 1), cA, 1, false);
        if (wr == 1) PG8_BAR;
        PG8_WAIT_V(4); PG8_BAR;
        PG8_STAGE(PG8_SB(1, 0), cB + kstep, voffB); PG8_STAGE_A(PG8_SA(1, 0), cA + kstep, 0, false); PG8_STAGE(PG8_SB(1, 1), cB + hstep + kstep, voffB);
        PG8_WAIT_V(6); PG8_BAR;
    }
    for (;;) {
        const bool has_next = S.next(ui + 1, nxt);
        const char* nA = has_next ? (const char*)g.A + (Sched::GATHER ? (size_t)0 : (size_t)nxt.pm * tstep) : cA;
        if constexpr (Sched::GATHER) { _Pragma("unroll") for (int h = 0; h < 2; ++h) _Pragma("unroll") for (int i = 0; i < 2; ++i) gvn[h][i] = has_next ? (unsigned)S.arow(nxt, h * HALF + gR[i]) * (unsigned)(K * 2) + (unsigned)(gC[i] * 2) : gvc[h][i]; }
        const char* nB = has_next ? (const char*)g.Bt + (size_t)nxt.pn * tstep : cB;
        for (int t = 0; t < nt; t += 2) {
            const bool last = (t == nt - 2);
            const char* a1 = cA + (size_t)(t + 1) * kstep;
            const char* a2 = last ? nA : cA + (size_t)(t + 2) * kstep; const char* b2 = last ? nB : cB + (size_t)(t + 2) * kstep;
            const char* a3 = a2 + kstep; const char* b3 = b2 + kstep;
            if (last && has_next) S.a_ready(nxt);
            if constexpr (SP2) {
            PG8_LDB(B0, 0, 0); PG8_LDB(B1, 0, 1); PG8_SCHED; PG8_LDA(At, 0, 0); PG8_STAGE_A(PG8_SA(1, 1), a1, 1, false);
            PG8_WAIT_V(8); PG8_WAIT_L(0); PG8_BAR; PG8_MMA(0, 0, At, B0); PG8_MMA(0, 1, At, B1); PG8_BAR; PG8_SCHED;
            PG8_LDA(At, 0, 1); PG8_STAGE(PG8_SB(0, 0), b2, voffB); PG8_STAGE(PG8_SB(0, 1), b2 + hstep, voffB); PG8_STAGE_A(PG8_SA(0, 0), a2, 0, last);
            PG8_WAIT_V(8); PG8_WAIT_L(0); PG8_BAR; PG8_MMA(1, 0, At, B0); PG8_MMA(1, 1, At, B1); PG8_BAR; PG8_SCHED;
            PG8_LDB(B0, 1, 0); PG8_LDB(B1, 1, 1); PG8_SCHED; PG8_LDA(At, 1, 0); PG8_STAGE_A(PG8_SA(0, 1), a2, 1, last);
            PG8_WAIT_V(8); PG8_WAIT_L(0); PG8_BAR; PG8_MMA(0, 0, At, B0); PG8_MMA(0, 1, At, B1); PG8_BAR; PG8_SCHED;
            PG8_LDA(At, 1, 1); PG8_STAGE(PG8_SB(1, 0), b3, voffB); PG8_STAGE(PG8_SB(1, 1), b3 + hstep, voffB); PG8_STAGE_A(PG8_SA(1, 0), a3, 0, last);
            PG8_WAIT_V(8); PG8_WAIT_L(0); PG8_BAR; PG8_MMA(1, 0, At, B0); PG8_MMA(1, 1, At, B1); PG8_BAR; PG8_SCHED;
            } else {
            PG8_LDB(B0, 0, 0); PG8_SCHED; PG8_LDA(At, 0, 0); PG8_STAGE_A(PG8_SA(1, 1), a1, 1, false);
            PG8_WAIT_L(8); PG8_BAR; PG8_WAIT_L(0); PG8_MMA(0, 0, At, B0); PG8_BAR; PG8_SCHED;
            PG8_LDB(B1, 0, 1); PG8_STAGE(PG8_SB(0, 0), b2, voffB);
            PG8_BAR; PG8_WAIT_L(0); PG8_MMA(0, 1, At, B1); PG8_BAR;
            PG8_LDA(At, 0, 1); PG8_STAGE_A(PG8_SA(0, 0), a2, 0, last);
            PG8_BAR; PG8_WAIT_L(0); PG8_MMA(1, 0, At, B0); PG8_BAR; PG8_SCHED;
            PG8_STAGE(PG8_SB(0, 1), b2 + hstep, voffB);
            PG8_WAIT_V(6); PG8_BAR; PG8_MMA(1, 1, At, B1); PG8_BAR;
            PG8_LDB(B0, 1, 0); PG8_SCHED; PG8_LDA(At, 1, 0); PG8_STAGE_A(PG8_SA(0, 1), a2, 1, last);
            PG8_WAIT_L(8); PG8_BAR; PG8_WAIT_L(0); PG8_MMA(0, 0, At, B0); PG8_BAR; PG8_SCHED;
            PG8_LDB(B1, 1, 1); PG8_STAGE(PG8_SB(1, 0), b3, voffB);
            PG8_BAR; PG8_WAIT_L(0); PG8_MMA(0, 1, At, B1); PG8_BAR;
            PG8_LDA(At, 1, 1); PG8_STAGE_A(PG8_SA(1, 0), a3, 0, last);
            PG8_BAR; PG8_WAIT_L(0); PG8_MMA(1, 0, At, B0); PG8_BAR; PG8_SCHED;
            PG8_STAGE(PG8_SB(1, 1), b3 + hstep, voffB);
            PG8_WAIT_V(6); PG8_BAR; PG8_MMA(1, 1, At, B1); PG8_BAR;
            }
        }
        if constexpr (ALIGN_EPI) { if (wr == 0) PG8_BAR; }
        if constexpr (!Epi::AFTER_DRAIN) { E(acc, cur, wr, wc, fr, fq); S.done(cur); }
        if (!has_next) break;
#pragma unroll
        for (int a = 0; a < 2; ++a)
#pragma unroll
            for (int b = 0; b < 2; ++b)
#pragma unroll
                for (int m = 0; m < 4; ++m)
#pragma unroll
                    for (int n = 0; n < 2; ++n) acc[a][b][m][n] = (f32x4){0.f, 0.f, 0.f, 0.f};
        cur = nxt; cA = nA; cB = nB; ++ui;
        if constexpr (Sched::GATHER) { _Pragma("unroll") for (int h = 0; h < 2; ++h) _Pragma("unroll") for (int i = 0; i < 2; ++i) gvc[h][i] = gvn[h][i]; }
        if constexpr (ALIGN_EPI) { if (wr == 1) PG8_BAR; }
    }
    PG8_WAIT_V(0);
    if constexpr (!ALIGN_EPI) { if (wr == 0) PG8_BAR; }
    PG8_BAR;
    if constexpr (Epi::AFTER_DRAIN) { E.fused(acc, cur, wr, wc, fr, fq, lds, wid, lane); S.done(cur); }
#undef PG8_SA
#undef PG8_SB
#undef PG8_STAGE
#undef PG8_STAGE_A
#undef PG8_LDA
#undef PG8_LDB
#undef PG8_MMA
#undef PG8_WAIT_V
#undef PG8_WAIT_L
#undef PG8_BAR
#undef PG8_SCHED
}
}

typedef float f32x4 __attribute__((ext_vector_type(4)));
typedef unsigned u32x4 __attribute__((ext_vector_type(4)));
typedef unsigned u32x2 __attribute__((ext_vector_type(2)));
__device__ __forceinline__ float silu_acc(float x) { return x / (1.f + expf(-x)); }
__device__ __forceinline__ float silu_fast(float x) { return x * __builtin_amdgcn_rcpf(1.f + __expf(-x)); }
__device__ __forceinline__ float softplus_f(float x) { return fmaxf(x, 0.f) + log1pf(expf(-fabsf(x))); }
__device__ __forceinline__ float wave_sum(float v) {
#pragma unroll
    for (int o = 1; o < 64; o <<= 1) v += __shfl_xor(v, o);
    return v;
}
__device__ __forceinline__ float wave_max(float v) {
#pragma unroll
    for (int o = 1; o < 64; o <<= 1) v = fmaxf(v, __shfl_xor(v, o));
    return v;
}
__device__ __forceinline__ float bf2f(bf16 v) { return __uint_as_float((unsigned)v << 16); }
__device__ __forceinline__ float bflo(unsigned w) { return __uint_as_float(w << 16); }
__device__ __forceinline__ float bfhi(unsigned w) { return __uint_as_float(w & 0xffff0000u); }
__device__ __forceinline__ unsigned f2bf(float f) { unsigned u = __float_as_uint(f); return (u + 0x7fffu + ((u >> 16) & 1u)) >> 16; }
__device__ __forceinline__ unsigned pk2(float lo, float hi) { return f2bf(lo) | (f2bf(hi) << 16); }

struct Ptrs {
    const float *x, *c, *ctx, *c_ctx, *w_ada, *b_ada, *norm1, *w_in, *conv_w, *conv_b, *dt_bias, *a_log, *d_skip, *ssd_norm, *sinks,
                *w_out, *norm2, *w_group, *b_group, *w_expert, *b_expert, *w_gate, *w_up, *w_down, *norm_final;
    float* out; unsigned char* ws;
};

__device__ __forceinline__ void transpose_item(const float* W, int ldn, int sn0, int k0, bf16* WT, int Kp, int drow0, LAS float* scr, int lane) {
    f32x4 v[16];
#pragma unroll
    for (int i = 0; i < 16; ++i) v[i] = *(const f32x4*)(W + (size_t)(k0 + 4 * i + (lane >> 4)) * ldn + sn0 + (lane & 15) * 4);
#pragma unroll
    for (int i = 0; i < 16; ++i) { LAS float* d = scr + (4 * i + (lane >> 4)) * 65 + (lane & 15) * 4; d[0] = v[i].x; d[1] = v[i].y; d[2] = v[i].z; d[3] = v[i].w; }
    asm volatile("s_waitcnt lgkmcnt(0)" ::: "memory");
    const int c = lane & 7;
#pragma unroll
    for (int j = 0; j < 8; ++j) { const int n = (lane >> 3) + 8 * j; const LAS float* s = scr + (8 * c) * 65 + n;
        u32x4 o; o.x = pg8::cvt_pk_bf16(s[0 * 65], s[1 * 65]); o.y = pg8::cvt_pk_bf16(s[2 * 65], s[3 * 65]); o.z = pg8::cvt_pk_bf16(s[4 * 65], s[5 * 65]); o.w = pg8::cvt_pk_bf16(s[6 * 65], s[7 * 65]);
        *(u32x4*)(WT + (size_t)(drow0 + n) * Kp + k0 + 8 * c) = o; }
    asm volatile("s_waitcnt lgkmcnt(0)" ::: "memory");
}

constexpr int CONV_IN = 36 * 16, CONV_OUT = 16 * 16, CONV_GU = 32 * 8 * 16, CONV_D = 32 * 16 * 8, CONV_ITEMS = CONV_IN + CONV_OUT + 2 * CONV_GU + CONV_D;
constexpr int CONV_N0 = CONV_IN + CONV_OUT + 6144;
__device__ __forceinline__ void conv_item(const Ptrs& P, int it, bf16* WIN, bf16* WOUT, bf16* WGU, bf16* WD, LAS float* scr, int lane) {
    int r = it;
    if (r < CONV_IN) { const int g = r % 36, kb = r / 36, d0 = g * 64; transpose_item(P.w_in, INC, d0 + (d0 >= 1536 ? 16 : 0), kb * 64, WIN, 1024, d0, scr, lane); return; } r -= CONV_IN;
    if (r < CONV_OUT) { const int g = r % 16, kb = r / 16; transpose_item(P.w_out, 1024, g * 64, kb * 64, WOUT, 1024, g * 64, scr, lane); return; } r -= CONV_OUT;
    if (r < 2 * CONV_GU) { const int up = r >= CONV_GU; if (up) r -= CONV_GU; const int e = r >> 7, q = r & 127, g = q & 7, kb = q >> 3, c0 = g * 64;
        transpose_item((up ? P.w_up : P.w_gate) + (size_t)e * 1024 * 512, 512, c0, kb * 64, WGU, 1024, e * 1024 + (c0 >> 7) * 256 + (up ? 128 : 0) + (c0 & 127), scr, lane); return; } r -= 2 * CONV_GU;
    { const int e = r >> 7, q = r & 127, g = q & 15, kb = q >> 4; transpose_item(P.w_down + (size_t)e * 512 * 1024, 1024, g * 64, kb * 64, WD, 512, e * 1024 + g * 64, scr, lane); }
}
__device__ __forceinline__ int chunk_row0(int q) { return q < 128 ? q * 128 : ML + (q - 128) * 128; }

struct EpiStoreBf16 {
    static constexpr bool PERM = true, AFTER_DRAIN = false;
    bf16* O; int ldc;
    __device__ __forceinline__ void operator()(const pg8::f32x4 (&acc)[2][2][4][2], const pg8::Unit& u, int wr, int wc, int fr, int fq) const {
        const int row0 = u.pm * 256 + wr * 64 + fr, col0 = u.pn * 256 + wc * 32 + 8 * fq;
#pragma unroll
        for (int ai = 0; ai < 2; ++ai)
#pragma unroll
            for (int m = 0; m < 4; ++m) { bf16* rowp = O + (size_t)(row0 + ai * 128 + m * 16) * ldc + col0;
#pragma unroll
                for (int bj = 0; bj < 2; ++bj) { const pg8::f32x4 v0 = acc[ai][bj][m][0], v1 = acc[ai][bj][m][1];
                    u32x4 w; w.x = pg8::cvt_pk_bf16(v0[0], v0[1]); w.y = pg8::cvt_pk_bf16(v0[2], v0[3]); w.z = pg8::cvt_pk_bf16(v1[0], v1[1]); w.w = pg8::cvt_pk_bf16(v1[2], v1[3]);
                    *(u32x4*)(rowp + bj * 128) = w; } }
    }
};
struct EpiOutProj {
    static constexpr bool PERM = false, AFTER_DRAIN = false;
    const float* x; const float* mod; float* X1; float* SSQP;
    __device__ __forceinline__ void operator()(const pg8::f32x4 (&acc)[2][2][4][2], const pg8::Unit& u, int wr, int wc, int fr, int fq) const {
        const int row0 = u.pm * 256 + wr * 64 + fr, col0 = u.pn * 256 + wc * 32 + 4 * fq;
        const float* g1 = mod + (u.pm * 256 / SEQ) * 6144 + 2048;
        f32x4 gv[2][2];
#pragma unroll
        for (int bj = 0; bj < 2; ++bj)
#pragma unroll
            for (int n = 0; n < 2; ++n) gv[bj][n] = *(const f32x4*)(g1 + col0 + bj * 128 + n * 16);
#pragma unroll
        for (int ai = 0; ai < 2; ++ai)
#pragma unroll
            for (int m = 0; m < 4; ++m) { const size_t off = (size_t)(row0 + ai * 128 + m * 16) * DM + col0;
                float s_ = 0.f;
#pragma unroll
                for (int bj = 0; bj < 2; ++bj)
#pragma unroll
                    for (int n = 0; n < 2; ++n) { const f32x4 xv = *(const f32x4*)(x + off + bj * 128 + n * 16); const f32x4 a = acc[ai][bj][m][n];
                        f32x4 o; o.x = xv.x + gv[bj][n].x * a[0]; o.y = xv.y + gv[bj][n].y * a[1]; o.z = xv.z + gv[bj][n].z * a[2]; o.w = xv.w + gv[bj][n].w * a[3];
                        s_ += o.x * o.x + o.y * o.y + o.z * o.z + o.w * o.w;
                        *(f32x4*)(X1 + off + bj * 128 + n * 16) = o; }
                s_ += __shfl_xor(s_, 16); s_ += __shfl_xor(s_, 32);
                if (fq == 0) SSQP[(size_t)(row0 + ai * 128 + m * 16) * 16 + u.pn * 4 + wc] = s_; }
    }
};
struct EpiGateUp {
    static constexpr bool PERM = true, AFTER_DRAIN = false;
    bf16* ACT;
    __device__ __forceinline__ void operator()(const pg8::f32x4 (&acc)[2][2][4][2], const pg8::Unit& u, int wr, int wc, int fr, int fq) const {
        const int row0 = u.pm * 256 + wr * 64 + fr, col0 = (u.pn & 3) * 128 + wc * 32 + 8 * fq;
#pragma unroll
        for (int ai = 0; ai < 2; ++ai)
#pragma unroll
            for (int m = 0; m < 4; ++m) {
                float r[8];
#pragma unroll
                for (int n = 0; n < 2; ++n)
#pragma unroll
                    for (int i = 0; i < 4; ++i) { const float g = acc[ai][0][m][n][i], up = acc[ai][1][m][n][i]; r[n * 4 + i] = silu_fast(g) * up; }
                u32x4 w; w.x = pg8::cvt_pk_bf16(r[0], r[1]); w.y = pg8::cvt_pk_bf16(r[2], r[3]); w.z = pg8::cvt_pk_bf16(r[4], r[5]); w.w = pg8::cvt_pk_bf16(r[6], r[7]);
                *(u32x4*)(ACT + (size_t)(row0 + ai * 128 + m * 16) * EDIM + col0) = w; }
    }
};
struct EpiDown {
    static constexpr bool PERM = true, AFTER_DRAIN = false;
    bf16* Y; const int* LIST; const LAS int* tab;
    __device__ __forceinline__ void operator()(const pg8::f32x4 (&acc)[2][2][4][2], const pg8::Unit& u, int wr, int wc, int fr, int fq) const {
        const int e = u.pn >> 2, pos0 = (u.pm - tab[e]) * 256 + wr * 64 + fr, cnt = tab[64 + e], col0 = (u.pn & 3) * 256 + wc * 32 + 8 * fq;
#pragma unroll
        for (int ai = 0; ai < 2; ++ai)
#pragma unroll
            for (int m = 0; m < 4; ++m) { const int pos = pos0 + ai * 128 + m * 16;
                if (pos < cnt) { const int aid = LIST[e * ML + pos]; bf16* rowp = Y + (size_t)aid * DM + col0;
#pragma unroll
                    for (int bj = 0; bj < 2; ++bj) { const pg8::f32x4 v0 = acc[ai][bj][m][0], v1 = acc[ai][bj][m][1];
                        u32x4 w; w.x = pg8::cvt_pk_bf16(v0[0], v0[1]); w.y = pg8::cvt_pk_bf16(v0[2], v0[3]); w.z = pg8::cvt_pk_bf16(v1[0], v1[1]); w.w = pg8::cvt_pk_bf16(v1[2], v1[3]);
                        *(u32x4*)(rowp + bj * 128) = w; } } }
    }
};
template <bool G_> struct MoeOrder {
    static constexpr bool GATHER = G_;
    const LAS int* tab; const int* LIST; int G, c;
    __device__ __forceinline__ bool next(int i, pg8::Unit& u) const {
        const int L = i * G + c; if (L >= tab[32] * 4) return false;
        const int p = L >> 2; u.pm = p; u.pn = tab[128 + p] * 4 + (L & 3); return true;
    }
    __device__ __forceinline__ int arow(const pg8::Unit& u, int r) const {
        const int e = u.pn >> 2, pos = (u.pm - tab[e]) * 256 + r;
        return pos < tab[64 + e] ? (LIST[e * ML + pos] >> 1) : 0;
    }
    __device__ __forceinline__ void a_ready(const pg8::Unit&) const {}
    __device__ __forceinline__ void done(const pg8::Unit&) const {}
};

struct Args { Ptrs p; int ph_lo, ph_hi; };

__global__ void __launch_bounds__(NTHREADS, 2) fwd_kernel(Args args) {
    extern __shared__ __attribute__((aligned(16))) unsigned char lds_raw[];
    LAS unsigned char* lds = (LAS unsigned char*)lds_raw;
    const Ptrs& P = args.p;
    const int tid = threadIdx.x, lane = tid & 63, wave = __builtin_amdgcn_readfirstlane(tid >> 6);
    const int G = gridDim.x, bid = blockIdx.x;
    const int gtid = bid * NTHREADS + tid, NT = G * NTHREADS;
    const int gw = bid * 8 + wave, NGW = G * 8;
    unsigned char* ws = P.ws;
    unsigned* ctl = (unsigned*)(ws + WS_CTL);
    float* MODP = (float*)(ws + WS_MODP);
    float* MOD = (float*)(ws + WS_MOD);
    float* ROPEC = (float*)(ws + WS_ROPE);
    float* ROPES = ROPEC + 8192 * 32;
    float* DT = (float*)(ws + WS_DT);
    float* ACS = (float*)(ws + WS_ACS);
    float* SSQP = (float*)(ws + WS_ACS);
    float* AL = (float*)(ws + WS_AL);
    float* EW = (float*)(ws + WS_EW);
    int* LIST = (int*)(ws + WS_LIST);
    float* FV = (float*)(ws + WS_FV);
    bf16* WRH = (bf16*)(ws + WS_WR);
    bf16* WRL = WRH + 48 * 1024;
    float* F1V = (float*)(ws + WS_F1);
    float* DBV = (float*)(ws + WS_DB);
    bf16* WDH = (bf16*)(ws + WS_WDT);
    bf16* WDL = WDH + 3 * 16 * 1024;
    bf16* WIN = (bf16*)(ws + WS_WIN);
    bf16* WOUT = (bf16*)(ws + WS_WOUT);
    bf16* WGU = (bf16*)(ws + WS_WGU);
    bf16* WD = (bf16*)(ws + WS_WD);
    bf16* HX = (bf16*)(ws + WS_HX);
    bf16* MIX = (bf16*)P.out;
    bf16* XST = (bf16*)(ws + WS_XST);
    bf16* BT = (bf16*)(ws + WS_BT);
    bf16* PR = (bf16*)(ws + WS_P);
    bf16* H2 = (bf16*)(ws + WS_HS);
    bf16* Y = (bf16*)(ws + WS_HS);
    bf16* U = (bf16*)(ws + WS_U);
    bf16* ACT = (bf16*)P.out;
    bf16* S = (bf16*)(ws + WS_S);
    bf16* KR = (bf16*)(ws + WS_KR);
    float* X1 = (float*)(ws + WS_X1);
    unsigned* CNT = ctl + CW_CNT;

    volatile LAS unsigned* MISC = (volatile LAS unsigned*)(lds + LDS_BYTES - 64);
    if (tid < 16) MISC[tid] = 0u;
    __syncthreads();
    XcdBarrier bar = xcd_barrier_post(ctl + CW_BAR, MISC);
    const int lo = args.ph_lo, hi = args.ph_hi;
#define IN(k) (lo <= (k) && (k) < hi)
#define SEAM(k) do { if (IN(k) && IN((k) + 1)) xcd_barrier(bar); } while (0)

    if (IN(0)) {
        LAS float* sc3 = (LAS float*)lds;
        for (int i = tid; i < 3072; i += NTHREADS) sc3[i] = silu_acc(i < 2048 ? P.c[i] : P.c_ctx[i - 2048]);
        __syncthreads();
        for (int idx = gtid; idx < 16 * 6144; idx += NT) {
            const int ks = idx / 6144, n = idx % 6144;
            float a0 = 0.f, a1 = 0.f, a2 = 0.f;
#pragma unroll 8
            for (int k = ks * 64; k < ks * 64 + 64; ++k) {
                const float w = P.w_ada[(size_t)k * 6144 + n];
                a0 += sc3[k] * w; a1 += sc3[1024 + k] * w; a2 += sc3[2048 + k] * w;
            }
            MODP[(ks * 3 + 0) * 6144 + n] = a0; MODP[(ks * 3 + 1) * 6144 + n] = a1; MODP[(ks * 3 + 2) * 6144 + n] = a2;
        }
        __syncthreads();
        for (int idx = gtid; idx < 8192 * 32; idx += NT) {
            const int pos = idx >> 5, f = idx & 31;
            const float inv = powf(10000.0f, -(float)(f & 15) / 16.0f);
            const float ang = (float)((f < 16) ? (pos >> 6) : (pos & 63)) * inv;
            ROPEC[idx] = cosf(ang); ROPES[idx] = sinf(ang);
        }
        LAS float* scr = (LAS float*)(lds + wave * 16640);
        for (int it = wave * G + bid; it < CONV_N0; it += NGW) conv_item(P, it, WIN, WOUT, WGU, WD, scr, lane);
    }
    SEAM(0);
    if (IN(1)) {
        auto modv = [&](int r, int n) -> float { float a = P.b_ada[n]; for (int ks = 0; ks < 16; ++ks) a += MODP[(ks * 3 + r) * 6144 + n]; return a; };
        for (int idx = gtid; idx < 3 * 6144; idx += NT) MOD[idx] = modv(idx / 6144, idx % 6144);
        for (int idx = gtid; idx < 3 * 1024; idx += NT) {
            const int k = idx & 1023, m = idx >> 10;
            const float f = P.norm1[k] * (1.f + modv(m, 1024 + k));
            F1V[idx] = f;
#pragma unroll
            for (int j4 = 0; j4 < 4; ++j4) { const f32x4 wv = *(const f32x4*)(P.w_in + (size_t)k * INC + 1536 + 4 * j4);
#pragma unroll
                for (int jj = 0; jj < 4; ++jj) { const float v = wv[jj] * f; const unsigned h = f2bf(v); WDH[(m * 16 + 4 * j4 + jj) * 1024 + k] = (bf16)h; WDL[(m * 16 + 4 * j4 + jj) * 1024 + k] = (bf16)f2bf(v - __uint_as_float(h << 16)); } }
        }
        for (int idx = gtid; idx < 2 * 1024; idx += NT) { const int k = idx & 1023, b = idx >> 10; FV[idx] = P.norm2[k] * (1.f + modv(b, 4096 + k)); }
        for (int idx = gtid; idx < 48 * 1024; idx += NT) {
            const int k = idx & 1023, n = idx >> 10;
            const float v = n < 4 ? P.w_group[k * 4 + n] : (n < 36 ? P.w_expert[k * 32 + n - 4] : 0.f); const unsigned h = f2bf(v);
            WRH[idx] = (bf16)h; WRL[idx] = (bf16)f2bf(v - __uint_as_float(h << 16));
        }
        for (int o = wave * G + bid; o < 48; o += NGW) {
            float a = 0.f; const int m = o >> 4, j = o & 15;
            for (int k = lane; k < 1024; k += 64) a += modv(m, k) * P.w_in[(size_t)k * INC + 1536 + j];
            a = wave_sum(a); if (lane == 0) DBV[o] = a + P.dt_bias[j];
        }
    }
    SEAM(1);
    if (IN(2)) {
        typedef short s16x8 __attribute__((ext_vector_type(8)));
        const int l15 = lane & 15, c4 = lane >> 4;
        for (int task = wave * G + bid; task < MT / 16; task += NGW) {
            const int r0 = task * 16, m = r0 < ML ? r0 / SEQ : 2;
            const int rr = r0 + l15;
            const float* xr = (rr < ML ? P.x + (size_t)rr * DM : P.ctx + (size_t)(rr - ML) * DM) + 8 * c4;
            const bf16* wh = WDH + ((size_t)m * 16 + l15) * 1024 + 8 * c4;
            const bf16* wl = WDL + ((size_t)m * 16 + l15) * 1024 + 8 * c4;
            pg8::f32x4 acc = {0.f, 0.f, 0.f, 0.f};
            float ssq = 0.f;
#pragma unroll 4
            for (int s = 0; s < 32; ++s) {
                const f32x4 xa = *(const f32x4*)(xr + 32 * s), xb = *(const f32x4*)(xr + 32 * s + 4);
                ssq += xa.x * xa.x + xa.y * xa.y + xa.z * xa.z + xa.w * xa.w + xb.x * xb.x + xb.y * xb.y + xb.z * xb.z + xb.w * xb.w;
                const u32x4 hw = {pg8::cvt_pk_bf16(xa.x, xa.y), pg8::cvt_pk_bf16(xa.z, xa.w), pg8::cvt_pk_bf16(xb.x, xb.y), pg8::cvt_pk_bf16(xb.z, xb.w)};
                const u32x4 lw = {pg8::cvt_pk_bf16(xa.x - bflo(hw.x), xa.y - bfhi(hw.x)), pg8::cvt_pk_bf16(xa.z - bflo(hw.y), xa.w - bfhi(hw.y)),
                                  pg8::cvt_pk_bf16(xb.x - bflo(hw.z), xb.y - bfhi(hw.z)), pg8::cvt_pk_bf16(xb.z - bflo(hw.w), xb.w - bfhi(hw.w))};
                const s16x8 ah = __builtin_bit_cast(s16x8, hw), alo = __builtin_bit_cast(s16x8, lw);
                const s16x8 bh = *(const s16x8*)(wh + 32 * s), bl = *(const s16x8*)(wl + 32 * s);
                acc = __builtin_amdgcn_mfma_f32_16x16x32_bf16(ah, bh, acc, 0, 0, 0);
                acc = __builtin_amdgcn_mfma_f32_16x16x32_bf16(ah, bl, acc, 0, 0, 0);
                acc = __builtin_amdgcn_mfma_f32_16x16x32_bf16(alo, bh, acc, 0, 0, 0);
            }
            ssq += __shfl_xor(ssq, 16); ssq += __shfl_xor(ssq, 32);
            const float rstd = rsqrtf(ssq * (1.f / DM) + EPS);
            const float db = DBV[m * 16 + l15];
#pragma unroll
            for (int rg = 0; rg < 4; ++rg) { const float rs_ = __shfl(rstd, 4 * c4 + rg); DT[(r0 + 4 * c4 + rg) * 16 + l15] = softplus_f(acc[rg] * rs_ + db); }
            bf16* ho = HX + (size_t)rr * DM + 8 * c4;
            const float* fv = F1V + m * 1024 + 8 * c4; const float* shv = MOD + m * 6144 + 8 * c4;
#pragma unroll 4
            for (int s = 0; s < 32; ++s) {
                const f32x4 xa = *(const f32x4*)(xr + 32 * s), xb = *(const f32x4*)(xr + 32 * s + 4);
                const f32x4 fa = *(const f32x4*)(fv + 32 * s), fb = *(const f32x4*)(fv + 32 * s + 4), sa = *(const f32x4*)(shv + 32 * s), sb = *(const f32x4*)(shv + 32 * s + 4);
                u32x4 o;
                o.x = pg8::cvt_pk_bf16(xa.x * rstd * fa.x + sa.x, xa.y * rstd * fa.y + sa.y); o.y = pg8::cvt_pk_bf16(xa.z * rstd * fa.z + sa.z, xa.w * rstd * fa.w + sa.w);
                o.z = pg8::cvt_pk_bf16(xb.x * rstd * fb.x + sb.x, xb.y * rstd * fb.y + sb.y); o.w = pg8::cvt_pk_bf16(xb.z * rstd * fb.z + sb.z, xb.w * rstd * fb.w + sb.w);
                *(u32x4*)(ho + 32 * s) = o;
            }
        }
    }
    SEAM(2);
    if (IN(3)) {
        pg8::Gemm g{HX, WIN, MT, PC, DM}; pg8::StaticOrder S_; S_.init(MT, PC, G, bid);
        EpiStoreBf16 E{PR, PC};
        pg8::gemm_phase<EpiStoreBf16, pg8::StaticOrder, true, true>(lds, g, S_, E);
        const int nwg = (MT / 256) * (PC / 256), extra = nwg % G;
        if (extra == 0 || bid >= extra) {
            const int nfill = extra == 0 ? G : G - extra, rank = extra == 0 ? bid : bid - extra;
            LAS float* scr = (LAS float*)(lds + wave * 16640);
            for (int it = CONV_N0 + wave * nfill + rank; it < CONV_ITEMS; it += nfill * 8) conv_item(P, it, WIN, WOUT, WGU, WD, scr, lane);
        }
    }
    SEAM(3);
    if (IN(4)) {
        {
            const int sub = tid >> 8, t8 = tid & 255, cg8 = t8 & 7, jq = t8 >> 3;
            LAS unsigned char* T = lds + sub * 17408;
            for (int ip = bid; ip < NCH * 8; ip += G) {
                const int q = ip >> 3, cg = (ip & 7) * 2 + sub, r0 = chunk_row0(q), c0 = cg * 64 + cg8 * 8;
                int s0, sl;
                if (q < 128) { s0 = (q >> 6) * SEQ; sl = SEQ; } else { s0 = ML + ((q - 128) >> 1) * CTXL; sl = CTXL; }
                u32x4 xin[8];
#pragma unroll
                for (int w = 0; w < 8; ++w) { const int rr = r0 + 4 * jq + w - 2; xin[w] = (u32x4){0u, 0u, 0u, 0u};
                    if (rr >= s0 && rr < s0 + sl) xin[w] = *(const u32x4*)(PR + (size_t)rr * PC + C_XBC + c0); }
                f32x4 wlo[5], whi[5];
#pragma unroll
                for (int w = 0; w < 5; ++w) { wlo[w] = *(const f32x4*)(P.conv_w + w * 1024 + c0); whi[w] = *(const f32x4*)(P.conv_w + w * 1024 + c0 + 4); }
                const f32x4 b0 = *(const f32x4*)(P.conv_b + c0), b1 = *(const f32x4*)(P.conv_b + c0 + 4);
                __syncthreads();
                unsigned ow[4][4];
#pragma unroll
                for (int jr = 0; jr < 4; ++jr) {
                    float a[8] = {b0.x, b0.y, b0.z, b0.w, b1.x, b1.y, b1.z, b1.w};
#pragma unroll
                    for (int w = 0; w < 5; ++w) { const u32x4 xv = xin[jr + w];
                        a[0] += wlo[w].x * bflo(xv.x); a[1] += wlo[w].y * bfhi(xv.x); a[2] += wlo[w].z * bflo(xv.y); a[3] += wlo[w].w * bfhi(xv.y);
                        a[4] += whi[w].x * bflo(xv.z); a[5] += whi[w].y * bfhi(xv.z); a[6] += whi[w].z * bflo(xv.w); a[7] += whi[w].w * bfhi(xv.w); }
#pragma unroll
                    for (int i = 0; i < 4; ++i) ow[jr][i] = pg8::cvt_pk_bf16(silu_fast(a[2 * i]), silu_fast(a[2 * i + 1]));
                    *(u32x4*)(U + (size_t)(r0 + 4 * jq + jr) * 1024 + c0) = (u32x4){ow[jr][0], ow[jr][1], ow[jr][2], ow[jr][3]};
                }
                if (cg < 12) {
#pragma unroll
                    for (int i = 0; i < 8; ++i) {
                        const unsigned e0 = (i & 1) ? (ow[0][i >> 1] >> 16) : (ow[0][i >> 1] & 0xffffu), e1 = (i & 1) ? (ow[1][i >> 1] >> 16) : (ow[1][i >> 1] & 0xffffu);
                        const unsigned e2 = (i & 1) ? (ow[2][i >> 1] >> 16) : (ow[2][i >> 1] & 0xffffu), e3 = (i & 1) ? (ow[3][i >> 1] >> 16) : (ow[3][i >> 1] & 0xffffu);
                        *(LAS u32x2*)(T + (cg8 * 8 + i) * 272 + jq * 8) = (u32x2){e0 | (e1 << 16), e2 | (e3 << 16)};
                    }
                }
                __syncthreads();
                if (cg < 12) {
                    bf16* dst = cg < 8 ? XST + ((size_t)q * 512 + cg * 64) * 128 : BT + ((size_t)q * 256 + (cg - 8) * 64) * 128;
#pragma unroll
                    for (int hh = 0; hh < 4; ++hh) { const int pc = t8 + 256 * hh, row = pc >> 4, ch = pc & 15; const u32x4 v = *(const LAS u32x4*)(T + row * 272 + ch * 16); *(u32x4*)(dst + (size_t)row * 128 + ch * 8) = v; }
                }
            }
            __syncthreads();
        }
        for (int idx = gtid; idx < MT * 8; idx += NT) {
            const int r = idx >> 3, kvh = (idx >> 2) & 1, d0 = (idx & 3) * 8;
            const u32x4 ka = *(const u32x4*)(PR + (size_t)r * PC + C_K + kvh * 64 + d0), kb = *(const u32x4*)(PR + (size_t)r * PC + C_K + kvh * 64 + 32 + d0);
            u32x4 oa = ka, ob = kb;
            if (r < ML) {
                const int pos = r % SEQ;
                const f32x4 c0 = *(const f32x4*)(ROPEC + pos * 32 + d0), c1 = *(const f32x4*)(ROPEC + pos * 32 + d0 + 4), s0_ = *(const f32x4*)(ROPES + pos * 32 + d0), s1_ = *(const f32x4*)(ROPES + pos * 32 + d0 + 4);
                const float cs[8] = {c0.x, c0.y, c0.z, c0.w, c1.x, c1.y, c1.z, c1.w}, sn[8] = {s0_.x, s0_.y, s0_.z, s0_.w, s1_.x, s1_.y, s1_.z, s1_.w};
                const unsigned kaw[4] = {ka.x, ka.y, ka.z, ka.w}, kbw[4] = {kb.x, kb.y, kb.z, kb.w};
                unsigned oaw[4], obw[4];
#pragma unroll
                for (int i = 0; i < 4; ++i) {
                    const float a0 = bflo(kaw[i]), a1 = bfhi(kaw[i]), b0 = bflo(kbw[i]), b1 = bfhi(kbw[i]);
                    oaw[i] = pk2(a0 * cs[2 * i] - b0 * sn[2 * i], a1 * cs[2 * i + 1] - b1 * sn[2 * i + 1]);
                    obw[i] = pk2(b0 * cs[2 * i] + a0 * sn[2 * i], b1 * cs[2 * i + 1] + a1 * sn[2 * i + 1]);
                }
                oa = (u32x4){oaw[0], oaw[1], oaw[2], oaw[3]}; ob = (u32x4){obw[0], obw[1], obw[2], obw[3]};
            }
            *(u32x4*)(KR + (size_t)r * 128 + kvh * 64 + d0) = oa; *(u32x4*)(KR + (size_t)r * 128 + kvh * 64 + 32 + d0) = ob;
        }
        for (int sidx = wave * G + bid; sidx < NCH * 16; sidx += NGW) {
            const int q = sidx >> 4, dh = sidx & 15, dir = dh >> 3;
            const int r0 = chunk_row0(q);
            const float A = -expf(P.a_log[dh]);
            const int i0 = dir == 0 ? 2 * lane : 127 - 2 * lane, i1 = dir == 0 ? 2 * lane + 1 : 126 - 2 * lane;
            const float v0 = DT[(r0 + i0) * 16 + dh] * A, v1 = DT[(r0 + i1) * 16 + dh] * A;
            float incl = v0 + v1;
#pragma unroll
            for (int o = 1; o < 64; o <<= 1) { const float t = __shfl_up(incl, o); if (lane >= o) incl += t; }
            const float excl = incl - (v0 + v1);
            ACS[(q * 16 + dh) * 128 + i0] = excl + v0; ACS[(q * 16 + dh) * 128 + i1] = incl;
            if (lane == 63) AL[q * 16 + dh] = incl;
        }
    }
    SEAM(4);
    if (IN(5)) {
        typedef short s16x8 __attribute__((ext_vector_type(8)));
        const int l15 = lane & 15, l4 = lane >> 4;
        for (int it5 = bid; it5 < 256 + 64 * 4; it5 += G) {
            const bool piece = it5 >= 256;
            if (piece && ((it5 - 256) & 3)) continue;
            const int un = piece ? 256 + ((it5 - 256) >> 5) : it5, nt_lo = piece ? ((it5 - 256) >> 2) & 7 : 0, nt_hi = piece ? nt_lo + 1 : 8;
            const int q = un >> 1, g = un & 1, head = g * 4 + (wave & 3), dh = (wave >> 2) * 8 + head, r0 = chunk_row0(q);
            const float al = AL[q * 16 + dh];
            pg8::f32x4 acc[8][4];
#pragma unroll
            for (int a = 0; a < 8; ++a)
#pragma unroll
                for (int b_ = 0; b_ < 4; ++b_) acc[a][b_] = (pg8::f32x4){0.f, 0.f, 0.f, 0.f};
            const bf16* bt = BT + ((size_t)q * 256 + g * 128 + l15) * 128 + 8 * l4;
            const bf16* xt = XST + ((size_t)q * 512 + head * 64 + l15) * 128 + 8 * l4;
#pragma unroll 1
            for (int ks = 0; ks < 4; ++ks) {
                float wj[8];
                {   const int j0 = 32 * ks + 8 * l4;
                    const f32x4 a0 = *(const f32x4*)(ACS + (q * 16 + dh) * 128 + j0), a1 = *(const f32x4*)(ACS + (q * 16 + dh) * 128 + j0 + 4);
                    const float av[8] = {a0.x, a0.y, a0.z, a0.w, a1.x, a1.y, a1.z, a1.w};
#pragma unroll
                    for (int i = 0; i < 8; ++i) wj[i] = __expf(al - av[i]) * DT[(r0 + j0 + i) * 16 + dh]; }
                s16x8 xf[4];
#pragma unroll
                for (int pt = 0; pt < 4; ++pt) {
                    const u32x4 raw = *(const u32x4*)(xt + (size_t)pt * 16 * 128 + 32 * ks);
                    u32x4 o; o.x = pk2(bflo(raw.x) * wj[0], bfhi(raw.x) * wj[1]); o.y = pk2(bflo(raw.y) * wj[2], bfhi(raw.y) * wj[3]);
                    o.z = pk2(bflo(raw.z) * wj[4], bfhi(raw.z) * wj[5]); o.w = pk2(bflo(raw.w) * wj[6], bfhi(raw.w) * wj[7]);
                    xf[pt] = __builtin_bit_cast(s16x8, o);
                }
#pragma unroll
                for (int nt = 0; nt < 8; ++nt) {
                    if (nt < nt_lo || nt >= nt_hi) continue;
                    const s16x8 bf = *(const s16x8*)(bt + (size_t)nt * 16 * 128 + 32 * ks);
#pragma unroll
                    for (int pt = 0; pt < 4; ++pt) acc[nt][pt] = __builtin_amdgcn_mfma_f32_16x16x32_bf16(bf, xf[pt], acc[nt][pt], 0, 0, 0);
                }
            }
            bf16* so = S + ((size_t)q * 16 + dh) * 8192;
#pragma unroll
            for (int nt = 0; nt < 8; ++nt)
#pragma unroll
                for (int pt = 0; pt < 4; ++pt) { if (nt < nt_lo || nt >= nt_hi) continue; u32x2 w; w.x = pg8::cvt_pk_bf16(acc[nt][pt][0], acc[nt][pt][1]); w.y = pg8::cvt_pk_bf16(acc[nt][pt][2], acc[nt][pt][3]);
                    *(u32x2*)(so + (size_t)(16 * pt + l15) * 128 + 16 * nt + 4 * l4) = w; }
        }
    }
    SEAM(5);
    if (IN(6)) {
        for (int idx = gtid; idx < NB * 16 * 2048; idx += NT) {
            const int pn = (idx & 2047) * 4, dh = (idx >> 11) & 15, b = idx >> 15, dir = dh >> 3;
            const int qa = dir == 0 ? 128 + 2 * b : 129 + 2 * b, qb = dir == 0 ? 129 + 2 * b : 128 + 2 * b;
            float h[4];
            {   const u32x2 sa = *(const u32x2*)(S + ((size_t)qa * 16 + dh) * 8192 + pn), sb = *(const u32x2*)(S + ((size_t)qb * 16 + dh) * 8192 + pn);
                const float e = __expf(AL[qb * 16 + dh]);
                h[0] = e * bflo(sa.x) + bflo(sb.x); h[1] = e * bfhi(sa.x) + bfhi(sb.x); h[2] = e * bflo(sa.y) + bflo(sb.y); h[3] = e * bfhi(sa.y) + bfhi(sb.y); }
            for (int c8 = 0; c8 < 64; c8 += 8) {
                u32x2 t[8]; float e[8];
#pragma unroll
                for (int k = 0; k < 8; ++k) { const int q = 64 * b + (dir == 0 ? c8 + k : 63 - c8 - k); t[k] = *(const u32x2*)(S + ((size_t)q * 16 + dh) * 8192 + pn); e[k] = __expf(AL[q * 16 + dh]); }
#pragma unroll
                for (int k = 0; k < 8; ++k) { const int q = 64 * b + (dir == 0 ? c8 + k : 63 - c8 - k);
                    u32x2 o; o.x = pk2(h[0], h[1]); o.y = pk2(h[2], h[3]);
                    *(u32x2*)(S + ((size_t)q * 16 + dh) * 8192 + pn) = o;
                    h[0] = e[k] * h[0] + bflo(t[k].x); h[1] = e[k] * h[1] + bfhi(t[k].x); h[2] = e[k] * h[2] + bflo(t[k].y); h[3] = e[k] * h[3] + bfhi(t[k].y); }
            }
        }
    }
    SEAM(6);
    if (IN(7)) {
        {
            typedef short s16x8 __attribute__((ext_vector_type(8)));
            constexpr int CBP = 132;
            LAS float* CBs = (LAS float*)lds;
            LAS float* vec = (LAS float*)(lds + 69632) + wave * 512;
            LAS float* red = (LAS float*)(lds + 86016);
            const int l15 = lane & 15, l4 = lane >> 4;
            for (int un = bid; un < 256; un += G) {
                const int q = un >> 1, i0 = (un & 1) * 64, r0 = q * 128;
                __syncthreads();
                {
                    const int g = wave >> 2, it = wave & 3;
                    pg8::f32x4 cacc[8];
#pragma unroll
                    for (int a = 0; a < 8; ++a) cacc[a] = (pg8::f32x4){0.f, 0.f, 0.f, 0.f};
                    const bf16* cp = U + (size_t)(r0 + i0 + 16 * it + l15) * 1024 + 768 + g * 128 + 8 * l4;
                    const bf16* bp = U + (size_t)(r0 + l15) * 1024 + 512 + g * 128 + 8 * l4;
#pragma unroll
                    for (int ks = 0; ks < 4; ++ks) {
                        const s16x8 af = *(const s16x8*)(cp + 32 * ks);
#pragma unroll
                        for (int jt = 0; jt < 8; ++jt) { const s16x8 bf = *(const s16x8*)(bp + (size_t)jt * 16 * 1024 + 32 * ks); cacc[jt] = __builtin_amdgcn_mfma_f32_16x16x32_bf16(af, bf, cacc[jt], 0, 0, 0); }
                    }
#pragma unroll
                    for (int jt = 0; jt < 8; ++jt)
#pragma unroll
                        for (int rg = 0; rg < 4; ++rg) CBs[(g * 64 + 16 * it + 4 * l4 + rg) * CBP + 16 * jt + l15] = cacc[jt][rg];
                }
                const int head = wave, g = head >> 2;
                {
#pragma unroll
                    for (int hh = 0; hh < 2; ++hh) { const int j = lane + 64 * hh;
                        vec[j] = ACS[(q * 16 + head) * 128 + j]; vec[128 + j] = ACS[(q * 16 + 8 + head) * 128 + j];
                        vec[256 + j] = DT[(r0 + j) * 16 + head]; vec[384 + j] = DT[(r0 + j) * 16 + 8 + head]; }
                }
                __syncthreads();
                pg8::f32x4 acc[4][4];
#pragma unroll
                for (int a = 0; a < 4; ++a)
#pragma unroll
                    for (int b_ = 0; b_ < 4; ++b_) acc[a][b_] = (pg8::f32x4){0.f, 0.f, 0.f, 0.f};
                const bf16* xt = XST + ((size_t)q * 512 + head * 64 + l15) * 128 + 8 * l4;
#pragma unroll 2
                for (int ks = 0; ks < 4; ++ks) {
                    s16x8 xf[4];
#pragma unroll
                    for (int pt = 0; pt < 4; ++pt) xf[pt] = *(const s16x8*)(xt + (size_t)pt * 16 * 128 + 32 * ks);
                    const int j0 = 32 * ks + 8 * l4;
                    float afj[8], abj[8], dfj[8], dbj[8];
#pragma unroll
                    for (int i = 0; i < 8; ++i) { afj[i] = vec[j0 + i]; abj[i] = vec[128 + j0 + i]; dfj[i] = vec[256 + j0 + i]; dbj[i] = vec[384 + j0 + i]; }
#pragma unroll
                    for (int it = 0; it < 4; ++it) {
                        const int i = i0 + 16 * it + l15;
                        const float afi = vec[i], abi = vec[128 + i];
                        const LAS float* cbp = CBs + (g * 64 + 16 * it + l15) * CBP + j0;
                        const pg8::f32x4 c0 = *(const LAS pg8::f32x4*)cbp, c1 = *(const LAS pg8::f32x4*)(cbp + 4);
                        const float cv[8] = {c0[0], c0[1], c0[2], c0[3], c1[0], c1[1], c1[2], c1[3]};
                        float lv[8];
#pragma unroll
                        for (int jj = 0; jj < 8; ++jj) { const int j = j0 + jj;
                            const float tf = j <= i ? __expf(afi - afj[jj]) * dfj[jj] : 0.f;
                            const float tb = j >= i ? __expf(abi - abj[jj]) * dbj[jj] : 0.f;
                            lv[jj] = cv[jj] * (tf + tb); }
                        const s16x8 lf = __builtin_bit_cast(s16x8, (u32x4){pg8::cvt_pk_bf16(lv[0], lv[1]), pg8::cvt_pk_bf16(lv[2], lv[3]), pg8::cvt_pk_bf16(lv[4], lv[5]), pg8::cvt_pk_bf16(lv[6], lv[7])});
#pragma unroll
                        for (int pt = 0; pt < 4; ++pt) acc[it][pt] = __builtin_amdgcn_mfma_f32_16x16x32_bf16(xf[pt], lf, acc[it][pt], 0, 0, 0);
                    }
                }
#pragma unroll 1
                for (int dir = 0; dir < 2; ++dir) {
                    const int dh = dir * 8 + head;
                    const bf16* hp = S + ((size_t)q * 16 + dh) * 8192 + (size_t)l15 * 128 + 8 * l4;
                    float sc_[4];
#pragma unroll
                    for (int it = 0; it < 4; ++it) sc_[it] = __expf(vec[dir * 128 + i0 + 16 * it + l15]);
#pragma unroll 2
                    for (int ks = 0; ks < 4; ++ks) {
                        s16x8 hf[4];
#pragma unroll
                        for (int pt = 0; pt < 4; ++pt) hf[pt] = *(const s16x8*)(hp + (size_t)pt * 16 * 128 + 32 * ks);
#pragma unroll
                        for (int it = 0; it < 4; ++it) {
                            const u32x4 raw = *(const u32x4*)(U + (size_t)(r0 + i0 + 16 * it + l15) * 1024 + 768 + g * 128 + 32 * ks + 8 * l4);
                            const float s_ = sc_[it];
                            const s16x8 cf = __builtin_bit_cast(s16x8, (u32x4){pg8::cvt_pk_bf16(bflo(raw.x) * s_, bfhi(raw.x) * s_), pg8::cvt_pk_bf16(bflo(raw.y) * s_, bfhi(raw.y) * s_),
                                                                              pg8::cvt_pk_bf16(bflo(raw.z) * s_, bfhi(raw.z) * s_), pg8::cvt_pk_bf16(bflo(raw.w) * s_, bfhi(raw.w) * s_)});
#pragma unroll
                            for (int pt = 0; pt < 4; ++pt) acc[it][pt] = __builtin_amdgcn_mfma_f32_16x16x32_bf16(hf[pt], cf, acc[it][pt], 0, 0, 0);
                        }
                    }
                }
                const float dsk = P.d_skip[head];
                float ssq[4];
#pragma unroll
                for (int it = 0; it < 4; ++it) {
                    const int row = r0 + i0 + 16 * it + l15;
                    float s_ = 0.f;
#pragma unroll
                    for (int pt = 0; pt < 4; ++pt) {
                        const int ch0 = head * 64 + 16 * pt + 4 * l4;
                        const u32x2 xv = *(const u32x2*)(U + (size_t)row * 1024 + ch0), zv = *(const u32x2*)(PR + (size_t)row * PC + C_Z + ch0);
                        const float xs[4] = {bflo(xv.x), bfhi(xv.x), bflo(xv.y), bfhi(xv.y)}, zs[4] = {bflo(zv.x), bfhi(zv.x), bflo(zv.y), bfhi(zv.y)};
#pragma unroll
                        for (int rg = 0; rg < 4; ++rg) { float y = acc[it][pt][rg] + dsk * xs[rg]; y *= silu_fast(zs[rg]); acc[it][pt][rg] = y; s_ += y * y; }
                    }
                    s_ += __shfl_xor(s_, 16); s_ += __shfl_xor(s_, 32);
                    ssq[it] = s_;
                }
                if (l4 == 0) {
#pragma unroll
                    for (int it = 0; it < 4; ++it) red[wave * 64 + 16 * it + l15] = ssq[it];
                }
                __syncthreads();
#pragma unroll
                for (int it = 0; it < 4; ++it) {
                    const int il = 16 * it + l15, row = r0 + i0 + il;
                    float tot = 0.f;
#pragma unroll
                    for (int w = 0; w < 8; ++w) tot += red[w * 64 + il];
                    const float rstd = rsqrtf(tot * (1.f / 512.f) + EPS);
#pragma unroll
                    for (int pt = 0; pt < 4; ++pt) { const int ch0 = head * 64 + 16 * pt + 4 * l4; const f32x4 gn = *(const f32x4*)(P.ssd_norm + ch0);
                        u32x2 o; o.x = pg8::cvt_pk_bf16(acc[it][pt][0] * rstd * gn.x, acc[it][pt][1] * rstd * gn.y); o.y = pg8::cvt_pk_bf16(acc[it][pt][2] * rstd * gn.z, acc[it][pt][3] * rstd * gn.w);
                        *(u32x2*)(MIX + (size_t)row * 1024 + ch0) = o; }
                }
            }
            __syncthreads();
        }
        {
            typedef float f32x16 __attribute__((ext_vector_type(16)));
            typedef short s16x8 __attribute__((ext_vector_type(8)));
            typedef short s16x4 __attribute__((ext_vector_type(4)));
            const int r32 = lane & 31, hi_ = lane >> 5;
            LAS unsigned char* KV = lds;
            LAS float* wsf = (LAS float*)(lds + 32768) + wave * 64;
            const float C2 = 0.125f * 1.4426950408889634f;
            const int vboff = ((lane >> 4) & 1) * 32 + (lane & 3) * 8 + (4 * hi_ + ((lane & 15) >> 2)) * 64;
            for (int L = bid; L < 512; L += G) {
                const int pair = L & 1, kvh = (L >> 1) & 1, nb = (L >> 2) & 63, b = L >> 8;
                const int hq = kvh * 4 + pair * 2 + (wave >> 2), qq = (wave & 3) * 32 + r32;
                const int qrow = b * SEQ + nb * 128 + qq, pos = nb * 128 + qq;
                s16x8 qr[4];
                {
                    const bf16* qp = PR + (size_t)qrow * PC + C_Q + hq * 64 + 8 * hi_;
                    u32x4 raw[4];
#pragma unroll
                    for (int d0 = 0; d0 < 4; ++d0) raw[d0] = *(const u32x4*)(qp + 16 * d0);
#pragma unroll
                    for (int dd = 0; dd < 2; ++dd) {
                        const float* cp = ROPEC + pos * 32 + 16 * dd + 8 * hi_; const float* sp = ROPES + pos * 32 + 16 * dd + 8 * hi_;
                        const f32x4 c0 = *(const f32x4*)cp, c1 = *(const f32x4*)(cp + 4), s0_ = *(const f32x4*)sp, s1_ = *(const f32x4*)(sp + 4);
                        const float cs[8] = {c0.x, c0.y, c0.z, c0.w, c1.x, c1.y, c1.z, c1.w}, sn[8] = {s0_.x, s0_.y, s0_.z, s0_.w, s1_.x, s1_.y, s1_.z, s1_.w};
                        const unsigned aw[4] = {raw[dd].x, raw[dd].y, raw[dd].z, raw[dd].w}, bw[4] = {raw[dd + 2].x, raw[dd + 2].y, raw[dd + 2].z, raw[dd + 2].w};
                        unsigned oa[4], ob[4];
#pragma unroll
                        for (int i = 0; i < 4; ++i) {
                            const float a0 = bflo(aw[i]), a1 = bfhi(aw[i]), b0 = bflo(bw[i]), b1 = bfhi(bw[i]);
                            oa[i] = pk2((a0 * cs[2 * i] - b0 * sn[2 * i]) * C2, (a1 * cs[2 * i + 1] - b1 * sn[2 * i + 1]) * C2);
                            ob[i] = pk2((b0 * cs[2 * i] + a0 * sn[2 * i]) * C2, (b1 * cs[2 * i + 1] + a1 * sn[2 * i + 1]) * C2);
                        }
                        qr[dd] = __builtin_bit_cast(s16x8, (u32x4){oa[0], oa[1], oa[2], oa[3]});
                        qr[dd + 2] = __builtin_bit_cast(s16x8, (u32x4){ob[0], ob[1], ob[2], ob[3]});
                    }
                }
                f32x16 o0 = {0.f}, o1 = {0.f};
#pragma unroll
                for (int r = 0; r < 16; ++r) { o0[r] = 0.f; o1[r] = 0.f; }
                float m_run = -INFINITY, l_run = 0.f;
                const int tfirst = 0;
                auto tile_row0 = [&](int t) -> int { return t < 4 ? ML + b * CTXL + 64 * t : b * SEQ + (nb - 1) * 128 + 64 * (t - 4); };
                auto tile_ok = [&](int t) -> bool { return !((nb == 0 && (t == 4 || t == 5)) || (nb == 63 && (t == 8 || t == 9))); };
                u32x4 kreg, vreg;
                {
                    const int row0 = tile_row0(tfirst);
                    kreg = *(const u32x4*)(KR + (size_t)(row0 + lane) * 128 + kvh * 64 + wave * 8);
                    vreg = *(const u32x4*)(PR + (size_t)(row0 + 16 * (wave & 3) + (lane >> 2)) * PC + C_V + kvh * 64 + (wave >> 2) * 32 + (lane & 3) * 8);
                }
                auto tile_next = [&](int t) -> int { int tn = t + 1; while (tn < 10 && !tile_ok(tn)) ++tn; return tn; };
                auto tile_load = [&](int t) { const int row0 = tile_row0(t);
                    kreg = *(const u32x4*)(KR + (size_t)(row0 + lane) * 128 + kvh * 64 + wave * 8);
                    vreg = *(const u32x4*)(PR + (size_t)(row0 + 16 * (wave & 3) + (lane >> 2)) * PC + C_V + kvh * 64 + (wave >> 2) * 32 + (lane & 3) * 8); };
                int cur = 0;
                __syncthreads();
                *(LAS u32x4*)(KV + wave * 1024 + lane * 16) = kreg; *(LAS u32x4*)(KV + 8192 + wave * 1024 + lane * 16) = vreg;
                { const int t1 = tile_next(0); if (t1 < 10) tile_load(t1); }
                __syncthreads();
                for (int t = 0; t < 10; t = tile_next(t)) {
                    LAS unsigned char* Kb = KV + cur * 16384; LAS unsigned char* Vb = Kb + 8192;
                    const int tn = tile_next(t);
                    f32x16 p0, p1;
#pragma unroll
                    for (int r = 0; r < 16; ++r) { p0[r] = 0.f; p1[r] = 0.f; }
#pragma unroll
                    for (int d0 = 0; d0 < 4; ++d0) {
                        const s16x8 b0 = *(const LAS s16x8*)(Kb + d0 * 2048 + hi_ * 1024 + r32 * 16);
                        const s16x8 b1 = *(const LAS s16x8*)(Kb + d0 * 2048 + hi_ * 1024 + r32 * 16 + 512);
                        p0 = __builtin_amdgcn_mfma_f32_32x32x16_bf16(b0, qr[d0], p0, 0, 0, 0);
                        p1 = __builtin_amdgcn_mfma_f32_32x32x16_bf16(b1, qr[d0], p1, 0, 0, 0);
                    }
                    if (t == 4 || t == 5) {
                        const int kb0 = 64 * (t - 4) + 4 * hi_;
#pragma unroll
                        for (int r = 0; r < 16; ++r) { const int kk = kb0 + (r & 3) + 8 * (r >> 2); if (kk < qq) p0[r] = -INFINITY; if (kk + 32 < qq) p1[r] = -INFINITY; }
                    } else if (t >= 8) {
                        const int kb0 = 64 * (t - 8) + 4 * hi_;
#pragma unroll
                        for (int r = 0; r < 16; ++r) { const int kk = kb0 + (r & 3) + 8 * (r >> 2); if (kk > qq) p0[r] = -INFINITY; if (kk + 32 > qq) p1[r] = -INFINITY; }
                    }
                    float mx = fmaxf(p0[0], p1[0]);
#pragma unroll
                    for (int r = 1; r < 16; ++r) mx = fmaxf(mx, fmaxf(p0[r], p1[r]));
                    mx = fmaxf(mx, __shfl_xor(mx, 32));
                    const float m_new = fmaxf(m_run, mx);
                    const float alpha = __builtin_amdgcn_exp2f(m_run - m_new);
                    m_run = m_new;
                    float rs = 0.f;
#pragma unroll
                    for (int r = 0; r < 16; ++r) { p0[r] = __builtin_amdgcn_exp2f(p0[r] - m_new); p1[r] = __builtin_amdgcn_exp2f(p1[r] - m_new); rs += p0[r] + p1[r]; }
                    l_run = l_run * alpha + rs;
                    if (__any(alpha != 1.0f)) {
                        if (hi_ == 0) wsf[r32] = alpha;
                        __builtin_amdgcn_wave_barrier();
#pragma unroll
                        for (int r = 0; r < 16; ++r) { const float a = wsf[(r & 3) + 8 * (r >> 2) + 4 * hi_]; o0[r] *= a; o1[r] *= a; }
                        __builtin_amdgcn_wave_barrier();
                    }
                    s16x8 pa[4];
                    pa[0] = __builtin_bit_cast(s16x8, (u32x4){pg8::cvt_pk_bf16(p0[0], p0[1]), pg8::cvt_pk_bf16(p0[2], p0[3]), pg8::cvt_pk_bf16(p0[4], p0[5]), pg8::cvt_pk_bf16(p0[6], p0[7])});
                    pa[1] = __builtin_bit_cast(s16x8, (u32x4){pg8::cvt_pk_bf16(p0[8], p0[9]), pg8::cvt_pk_bf16(p0[10], p0[11]), pg8::cvt_pk_bf16(p0[12], p0[13]), pg8::cvt_pk_bf16(p0[14], p0[15])});
                    pa[2] = __builtin_bit_cast(s16x8, (u32x4){pg8::cvt_pk_bf16(p1[0], p1[1]), pg8::cvt_pk_bf16(p1[2], p1[3]), pg8::cvt_pk_bf16(p1[4], p1[5]), pg8::cvt_pk_bf16(p1[6], p1[7])});
                    pa[3] = __builtin_bit_cast(s16x8, (u32x4){pg8::cvt_pk_bf16(p1[8], p1[9]), pg8::cvt_pk_bf16(p1[10], p1[11]), pg8::cvt_pk_bf16(p1[12], p1[13]), pg8::cvt_pk_bf16(p1[14], p1[15])});
#pragma unroll
                    for (int ks = 0; ks < 4; ++ks) {
                        typedef short v4i16_t __attribute__((ext_vector_type(4)));
                        const s16x4 l0 = __builtin_bit_cast(s16x4, __builtin_amdgcn_ds_read_tr16_b64_v4i16((LAS v4i16_t*)(Vb + vboff + ks * 1024)));
                        const s16x4 h0 = __builtin_bit_cast(s16x4, __builtin_amdgcn_ds_read_tr16_b64_v4i16((LAS v4i16_t*)(Vb + vboff + ks * 1024 + 512)));
                        const s16x4 l1 = __builtin_bit_cast(s16x4, __builtin_amdgcn_ds_read_tr16_b64_v4i16((LAS v4i16_t*)(Vb + vboff + 4096 + ks * 1024)));
                        const s16x4 h1 = __builtin_bit_cast(s16x4, __builtin_amdgcn_ds_read_tr16_b64_v4i16((LAS v4i16_t*)(Vb + vboff + 4096 + ks * 1024 + 512)));
                        const s16x8 v0 = (s16x8){l0[0], l0[1], l0[2], l0[3], h0[0], h0[1], h0[2], h0[3]}, v1 = (s16x8){l1[0], l1[1], l1[2], l1[3], h1[0], h1[1], h1[2], h1[3]};
                        o0 = __builtin_amdgcn_mfma_f32_32x32x16_bf16(pa[ks], v0, o0, 0, 0, 0);
                        o1 = __builtin_amdgcn_mfma_f32_32x32x16_bf16(pa[ks], v1, o1, 0, 0, 0);
                    }
                    if (tn < 10) {
                        LAS unsigned char* Kn = KV + (cur ^ 1) * 16384;
                        *(LAS u32x4*)(Kn + wave * 1024 + lane * 16) = kreg; *(LAS u32x4*)(Kn + 8192 + wave * 1024 + lane * 16) = vreg;
                        const int t2 = tile_next(tn); if (t2 < 10) tile_load(t2);
                    }
                    __syncthreads();
                    cur ^= 1;
                }
                float l_tot = l_run + __shfl_xor(l_run, 32);
                l_tot += __builtin_amdgcn_exp2f(P.sinks[hq] * 1.4426950408889634f - m_run);
                if (hi_ == 0) wsf[r32] = 1.0f / l_tot;
                __builtin_amdgcn_wave_barrier();
                bf16* orow = MIX + (size_t)(b * SEQ + nb * 128 + (wave & 3) * 32) * 1024 + 512 + hq * 64 + r32;
#pragma unroll
                for (int r = 0; r < 16; ++r) { const int qi = (r & 3) + 8 * (r >> 2) + 4 * hi_; const float inv = wsf[qi];
                    orow[(size_t)qi * 1024] = (bf16)f2bf(o0[r] * inv); orow[(size_t)qi * 1024 + 32] = (bf16)f2bf(o1[r] * inv); }
                __builtin_amdgcn_wave_barrier();
            }
        }
    }
    SEAM(7);
    if (IN(8)) {
        pg8::Gemm g{MIX, WOUT, ML, DM, DM}; pg8::StaticOrder S_; S_.init(ML, DM, G, bid);
        EpiOutProj E{P.x, MOD, X1, SSQP};
        pg8::gemm_phase<EpiOutProj, pg8::StaticOrder, false, true>(lds, g, S_, E);
    }
    SEAM(8);
    if (IN(9)) {
        typedef short s16x8 __attribute__((ext_vector_type(8)));
        const int l15 = lane & 15, c4 = lane >> 4, sl = wave & 3, kh = wave >> 2;
        LAS float* lgs = (LAS float*)lds + (sl * 2 + kh) * 832;
        for (int tb = bid; tb * 4 < ML / 16; tb += G) {
            const int task = tb * 4 + sl, r0 = task * 16, b = r0 / SEQ;
            float rstd;
            {   const float* sp = SSQP + (size_t)(r0 + l15) * 16; const f32x4 a0 = *(const f32x4*)sp, a1 = *(const f32x4*)(sp + 4), a2 = *(const f32x4*)(sp + 8), a3 = *(const f32x4*)(sp + 12);
                const float t = (((a0.x + a0.y) + (a0.z + a0.w)) + ((a1.x + a1.y) + (a1.z + a1.w))) + (((a2.x + a2.y) + (a2.z + a2.w)) + ((a3.x + a3.y) + (a3.z + a3.w)));
                rstd = rsqrtf(t * (1.f / DM) + EPS); }
            const int k0 = kh * 512 + 8 * c4;
            const float* xr = X1 + (size_t)(r0 + l15) * DM + k0;
            bf16* ho = H2 + (size_t)(r0 + l15) * DM + k0;
            const float* fv = FV + b * 1024 + k0; const float* shv = MOD + b * 6144 + 3072 + k0;
            const bf16* wh = WRH + (size_t)l15 * 1024 + k0; const bf16* wl = WRL + (size_t)l15 * 1024 + k0;
            pg8::f32x4 acc[3];
#pragma unroll
            for (int a = 0; a < 3; ++a) acc[a] = (pg8::f32x4){0.f, 0.f, 0.f, 0.f};
#pragma unroll 4
            for (int s = 0; s < 16; ++s) {
                const f32x4 xa = *(const f32x4*)(xr + 32 * s), xb = *(const f32x4*)(xr + 32 * s + 4);
                const f32x4 fa = *(const f32x4*)(fv + 32 * s), fb = *(const f32x4*)(fv + 32 * s + 4), sa = *(const f32x4*)(shv + 32 * s), sb = *(const f32x4*)(shv + 32 * s + 4);
                const float h0 = xa.x * rstd * fa.x + sa.x, h1 = xa.y * rstd * fa.y + sa.y, h2_ = xa.z * rstd * fa.z + sa.z, h3 = xa.w * rstd * fa.w + sa.w;
                const float h4 = xb.x * rstd * fb.x + sb.x, h5 = xb.y * rstd * fb.y + sb.y, h6 = xb.z * rstd * fb.z + sb.z, h7 = xb.w * rstd * fb.w + sb.w;
                const u32x4 hw = {pg8::cvt_pk_bf16(h0, h1), pg8::cvt_pk_bf16(h2_, h3), pg8::cvt_pk_bf16(h4, h5), pg8::cvt_pk_bf16(h6, h7)};
                *(u32x4*)(ho + 32 * s) = hw;
                const u32x4 lw = {pg8::cvt_pk_bf16(h0 - bflo(hw.x), h1 - bfhi(hw.x)), pg8::cvt_pk_bf16(h2_ - bflo(hw.y), h3 - bfhi(hw.y)),
                                  pg8::cvt_pk_bf16(h4 - bflo(hw.z), h5 - bfhi(hw.z)), pg8::cvt_pk_bf16(h6 - bflo(hw.w), h7 - bfhi(hw.w))};
                const s16x8 ah = __builtin_bit_cast(s16x8, hw), alo = __builtin_bit_cast(s16x8, lw);
#pragma unroll
                for (int nt = 0; nt < 3; ++nt) {
                    const s16x8 bh = *(const s16x8*)(wh + (size_t)nt * 16 * 1024 + 32 * s), bl = *(const s16x8*)(wl + (size_t)nt * 16 * 1024 + 32 * s);
                    acc[nt] = __builtin_amdgcn_mfma_f32_16x16x32_bf16(ah, bh, acc[nt], 0, 0, 0);
                    acc[nt] = __builtin_amdgcn_mfma_f32_16x16x32_bf16(ah, bl, acc[nt], 0, 0, 0);
                    acc[nt] = __builtin_amdgcn_mfma_f32_16x16x32_bf16(alo, bh, acc[nt], 0, 0, 0);
                }
            }
            __syncthreads();
#pragma unroll
            for (int nt = 0; nt < 3; ++nt)
#pragma unroll
                for (int rg = 0; rg < 4; ++rg) lgs[(4 * c4 + rg) * 52 + 16 * nt + l15] = acc[nt][rg];
            __syncthreads();
            if (kh == 0 && lane < 16) {
                const int r = r0 + lane;
                const LAS float* lp = lgs + lane * 52; const LAS float* lq = lp + 832;
                float gl[4]; float gm = -INFINITY; int gi = 0;
#pragma unroll
                for (int e = 0; e < 4; ++e) { gl[e] = (lp[e] + lq[e]) + P.b_group[e]; if (gl[e] > gm) { gm = gl[e]; gi = e; } }
                float gs = 0.f;
#pragma unroll
                for (int e = 0; e < 4; ++e) gs += expf(gl[e] - gm);
                const float gwt = 1.f / gs;
                float el[8]; float em = -INFINITY; int e1 = 0;
#pragma unroll
                for (int e = 0; e < 8; ++e) { el[e] = (lp[4 + gi * 8 + e] + lq[4 + gi * 8 + e]) + P.b_expert[gi * 8 + e]; if (el[e] > em) { em = el[e]; e1 = e; } }
                float em2 = -INFINITY; int e2 = 0;
#pragma unroll
                for (int e = 0; e < 8; ++e) if (e != e1 && el[e] > em2) { em2 = el[e]; e2 = e; }
                const float p2 = expf(em2 - em);
                const float w1 = gwt / (1.f + p2), w2 = gwt * p2 / (1.f + p2);
                const int ex1 = gi * 8 + e1, ex2 = gi * 8 + e2;
                const unsigned pos1 = atomicAdd(&CNT[ex1 * 64], 1u), pos2 = atomicAdd(&CNT[ex2 * 64], 1u);
                LIST[ex1 * ML + pos1] = r * 2; EW[r * 2] = w1;
                LIST[ex2 * ML + pos2] = r * 2 + 1; EW[r * 2 + 1] = w2;
            }
        }
    }
    SEAM(9);
    LAS int* tab = (LAS int*)(lds + LDS_TAB);
    if (hi > 10 && lo <= 11) {
        __syncthreads();
        if (tid == 0) { int acc_ = 0; for (int e = 0; e < NE; ++e) { tab[e] = acc_; const int cnt = (int)CNT[e * 64]; tab[64 + e] = cnt; const int np = (cnt + 255) >> 8; for (int k = 0; k < np; ++k) tab[128 + acc_ + k] = e; acc_ += np; } tab[32] = acc_; }
        __syncthreads();
    }
    if (IN(10)) {
        pg8::Gemm g{H2, WGU, ML, NE * 1024, DM}; MoeOrder<true> S_{tab, LIST, G, bid};
        EpiGateUp E{ACT};
        pg8::gemm_phase<EpiGateUp, MoeOrder<true>, true, true>(lds, g, S_, E);
    }
    SEAM(10);
    if (IN(11)) {
        pg8::Gemm g{ACT, WD, MAXSLOT, NE * 1024, EDIM}; MoeOrder<false> S_{tab, LIST, G, bid};
        EpiDown E{Y, LIST, tab};
        pg8::gemm_phase<EpiDown, MoeOrder<false>, true, true>(lds, g, S_, E);
    }
    SEAM(11);
    if (IN(12)) {
        const int half = lane >> 5, l32 = lane & 31;
        for (int rp = gw; rp < ML / 2; rp += NGW) {
            const int r = rp * 2 + half;
            const float* g2 = MOD + (r / SEQ) * 6144 + 5120;
            const float w0 = EW[r * 2], w1 = EW[r * 2 + 1];
            f32x4 v[8]; float s = 0.f;
#pragma unroll
            for (int j = 0; j < 8; ++j) {
                const int c0 = j * 128 + l32 * 4;
                const f32x4 xv = *(const f32x4*)(X1 + (size_t)r * DM + c0);
                const u32x2 y0 = *(const u32x2*)(Y + (size_t)(r * 2) * DM + c0), y1 = *(const u32x2*)(Y + (size_t)(r * 2 + 1) * DM + c0);
                const f32x4 gg = *(const f32x4*)(g2 + c0);
                v[j].x = xv.x + gg.x * (w0 * bflo(y0.x) + w1 * bflo(y1.x)); v[j].y = xv.y + gg.y * (w0 * bfhi(y0.x) + w1 * bfhi(y1.x));
                v[j].z = xv.z + gg.z * (w0 * bflo(y0.y) + w1 * bflo(y1.y)); v[j].w = xv.w + gg.w * (w0 * bfhi(y0.y) + w1 * bfhi(y1.y));
                s += v[j].x * v[j].x + v[j].y * v[j].y + v[j].z * v[j].z + v[j].w * v[j].w;
            }
            s += __shfl_xor(s, 1); s += __shfl_xor(s, 2); s += __shfl_xor(s, 4); s += __shfl_xor(s, 8); s += __shfl_xor(s, 16);
            const float rstd = rsqrtf(s * (1.f / DM) + EPS);
#pragma unroll
            for (int j = 0; j < 8; ++j) {
                const int c0 = j * 128 + l32 * 4;
                const f32x4 nf = *(const f32x4*)(P.norm_final + c0);
                f32x4 o; o.x = v[j].x * rstd * nf.x; o.y = v[j].y * rstd * nf.y; o.z = v[j].z * rstd * nf.z; o.w = v[j].w * rstd * nf.w;
                *(f32x4*)(P.out + (size_t)r * DM + c0) = o;
            }
        }
    }
#undef IN
#undef SEAM
}

#ifndef N_LAUNCHES
#define N_LAUNCHES 1
#endif
constexpr int N_PHASES = 13;

extern "C" void kernel_launch(void* const* d_in, const int* in_sizes, int n_in, void* d_out, int out_size, void* d_ws, size_t ws_size, hipStream_t stream) {
    static int grid = 0;
    if (grid == 0) {
        if (n_in != 25 || out_size != ML * DM || ws_size < WS_NEED) { fprintf(stderr, "kernel_launch: unexpected problem (n_in %d out %d ws %zu need %zu)\n", n_in, out_size, ws_size, (size_t)WS_NEED); grid = -1; return; }
        int dev = 0, cus = 0, per_cu = 0;
        (void)hipGetDevice(&dev);
        (void)hipDeviceGetAttribute(&cus, hipDeviceAttributeMultiprocessorCount, dev);
        (void)hipFuncSetAttribute((const void*)fwd_kernel, hipFuncAttributeMaxDynamicSharedMemorySize, LDS_BYTES);
        (void)hipOccupancyMaxActiveBlocksPerMultiprocessor(&per_cu, (const void*)fwd_kernel, NTHREADS, LDS_BYTES);
        (void)hipGetLastError();
        if (per_cu < 1) { fprintf(stderr, "kernel_launch: occupancy query says %d\n", per_cu); }
        grid = cus;
    }
    if (grid < 0) return;
    (void)hipMemsetAsync((char*)d_ws + WS_CTL, 0, CTL_ZERO_BYTES, stream);
    Args a{};
    const float** pp = (const float**)&a.p;
    for (int i = 0; i < 25; ++i) pp[i] = (const float*)d_in[i];
    a.p.out = (float*)d_out; a.p.ws = (unsigned char*)d_ws;
    if (N_LAUNCHES == 1) {
        a.ph_lo = 0; a.ph_hi = N_PHASES;
        hipLaunchKernelGGL(fwd_kernel, dim3(grid), dim3(NTHREADS), LDS_BYTES, stream, a);
    } else {
        for (int ph = 0; ph < N_PHASES; ++ph) { a.ph_lo = ph; a.ph_hi = ph + 1; hipLaunchKernelGGL(fwd_kernel, dim3(grid), dim3(NTHREADS), LDS_BYTES, stream, a); }
    }
}
```

```cpp
#include <hip/hip_runtime.h>
#include <cstdio>
#include <cstdint>

constexpr int DM = 1024, SEQ = 8192, NB = 2, CTXL = 256;
constexpr int ML = NB * SEQ;
constexpr int MC = NB * CTXL;
constexpr int MT = ML + MC;
constexpr int INC = 2320;
constexpr int PC = 2304;
constexpr int C_Z = 0, C_XBC = 512, C_Q = 1536, C_K = 2048, C_V = 2176;
constexpr int NCH = 132;
constexpr int NE = 32, EDIM = 512;
constexpr int MAXSLOT = 40960;
constexpr float EPS = 1e-6f;

constexpr size_t MiB = 1u << 20;
constexpr size_t WS_CTL = 0, CTL_ZERO_BYTES = 64 * 1024;
constexpr size_t WS_MODP = 1 * MiB;
constexpr size_t WS_MOD = WS_MODP + 16 * 3 * 6144 * 4;
constexpr size_t WS_ROPE = 3 * MiB;
constexpr size_t WS_DT = 5 * MiB;
constexpr size_t WS_ACS = 6 * MiB + 512 * 1024;
constexpr size_t WS_AL = 8 * MiB;
constexpr size_t WS_EW = 8 * MiB + 64 * 1024;
constexpr size_t WS_RSTD = 8 * MiB + 256 * 1024;
constexpr size_t WS_EID = 8 * MiB + 512 * 1024;
constexpr size_t WS_POS = 9 * MiB;
constexpr size_t WS_LIST = 10 * MiB;
constexpr size_t WS_FV = 8 * MiB + 16 * 1024;
constexpr size_t WS_RB = 8 * MiB + 32 * 1024;
constexpr size_t WS_F1 = 8 * MiB + 40 * 1024;
constexpr size_t WS_DB = 8 * MiB + 56 * 1024;
constexpr size_t WS_WDT = 9 * MiB + 256 * 1024;
constexpr size_t WS_WR = 9 * MiB + 512 * 1024;
constexpr size_t WS_WIN = 12 * MiB;
constexpr size_t WS_WOUT = 17 * MiB;
constexpr size_t WS_WGU = 20 * MiB;
constexpr size_t WS_WD = 84 * MiB;
constexpr size_t WS_HX = 116 * MiB;
constexpr size_t WS_XST = 116 * MiB;
constexpr size_t WS_BT = WS_XST + (size_t)NCH * 512 * 128 * 2;
constexpr size_t WS_P = 149 * MiB;
constexpr size_t WS_X1 = 149 * MiB;
constexpr size_t WS_U = WS_P + (size_t)MT * PC * 2;
constexpr size_t WS_S = WS_U + 33 * MiB;
constexpr size_t WS_KR = 289 * MiB + 512 * 1024;
constexpr size_t WS_HS = 213 * MiB;
constexpr size_t WS_NEED = 294 * MiB;
static_assert(WS_BT + (size_t)NCH * 256 * 128 * 2 <= WS_P, "XST/BT fit in the HX slot");
static_assert(WS_S + 33 * MiB <= WS_KR && WS_KR + (size_t)(MT + 128) * 128 * 2 <= WS_NEED, "ws budget");
static_assert(WS_X1 + (size_t)ML * 1024 * 4 <= WS_HS && WS_HS + (size_t)MAXSLOT * 1024 * 2 <= WS_NEED, "X1 | HS");
constexpr int CW_CNT = 8192;
constexpr int CW_BAR = 1024;

constexpr int LDS_BYTES = 147456;
constexpr int LDS_TAB = 139264;
constexpr int NTHREADS = 512;

#define LAS __attribute__((address_space(3)))
typedef unsigned short bf16;

#define XB_TMO      128
#define XB_XCNT(j)  (256  + 64 * (j))
#define XB_XSUB(j)  (1280 + 64 * (j))
#define XB_XGEN(j)  (2304 + 64 * (j))
#define XB_TOP      3328
#define XB_TOPGEN   3392
#define XCD_BAR_WORDS 3456
#define XB_SPIN_CAP (1u << 18)
__device__ __forceinline__ unsigned xb_ld(unsigned* p)              { return __hip_atomic_load(p, __ATOMIC_RELAXED, __HIP_MEMORY_SCOPE_AGENT); }
__device__ __forceinline__ unsigned xb_add(unsigned* p, unsigned v) { return __hip_atomic_fetch_add(p, v, __ATOMIC_RELAXED, __HIP_MEMORY_SCOPE_AGENT); }
__device__ __forceinline__ unsigned xb_xcc_id() { return (unsigned)__builtin_amdgcn_s_getreg((3 << 11) | 20) & 0xFu; }
#define XB_SPIN(cond, bar) do { unsigned _sp = 0; while (cond) { __builtin_amdgcn_s_sleep(1); \
    if ((++_sp & 255u) == 0u) { if (xb_ld(&(bar)[XB_TMO])) break; if (_sp > XB_SPIN_CAP) { atomicAdd(&(bar)[XB_TMO], 1u); break; } } } } while (0)
struct XcdBarrier { unsigned* bar; unsigned x; volatile LAS unsigned* st; };
__device__ __forceinline__ XcdBarrier xcd_barrier_post(unsigned* bar, volatile LAS unsigned* st) {
    XcdBarrier b; b.bar = bar; b.x = xb_xcc_id(); b.st = st;
    if (threadIdx.x == 0) (void)xb_add(&bar[XB_XCNT(b.x)], 1u);
    return b;
}
__device__ __forceinline__ void xcd_barrier_complete(unsigned* bar, unsigned x, unsigned& nloc, unsigned& nx) {
    const unsigned G = gridDim.x * gridDim.y * gridDim.z;
    unsigned sum, cnt, mine, sp = 0u;
    for (;;) {
        sum = 0u; cnt = 0u; mine = 0u;
#pragma unroll
        for (unsigned j = 0; j < 16; ++j) { const unsigned c = xb_ld(&bar[XB_XCNT(j)]); sum += c; cnt += (c > 0u) ? 1u : 0u; mine = (j == x) ? c : mine; }
        if (sum == G) break;
        __builtin_amdgcn_s_sleep(1);
        if ((++sp & 255u) == 0u) { if (xb_ld(&bar[XB_TMO])) break; if (sp > XB_SPIN_CAP) { atomicAdd(&bar[XB_TMO], 1u); break; } }
    }
    nloc = mine > 0u ? mine : 1u; nx = cnt > 0u ? cnt : 1u;
}
__device__ __forceinline__ void xcd_barrier(const XcdBarrier& b) {
    asm volatile("s_waitcnt vmcnt(0)" ::: "memory");
    __syncthreads();
    if (threadIdx.x == 0) {
        unsigned* bar = b.bar;
        __builtin_amdgcn_s_waitcnt(0);
        unsigned nloc = b.st[0], nx = b.st[1];
        if (nloc == 0u) { xcd_barrier_complete(bar, b.x, nloc, nx); b.st[0] = nloc; b.st[1] = nx; }
        const unsigned old = xb_add(&bar[XB_XSUB(b.x)], 1u);
        const unsigned gen = old / nloc;
        if (old + 1u == (gen + 1u) * nloc) {
            __builtin_amdgcn_fence(__ATOMIC_RELEASE, "agent");
            asm volatile("s_waitcnt vmcnt(0)" ::: "memory");
            const unsigned og = xb_add(&bar[XB_TOP], 1u);
            const unsigned tg = og / nx;
            if (og + 1u == (tg + 1u) * nx) xb_add(&bar[XB_TOPGEN], 1u);
            else XB_SPIN(xb_ld(&bar[XB_TOPGEN]) == tg, bar);
            __builtin_amdgcn_fence(__ATOMIC_ACQUIRE, "agent");
            xb_add(&bar[XB_XGEN(b.x)], 1u);
            asm volatile("s_waitcnt vmcnt(0)" ::: "memory");
        } else {
            XB_SPIN(xb_ld(&bar[XB_XGEN(b.x)]) == gen, bar);
            __builtin_amdgcn_fence(__ATOMIC_ACQUIRE, "agent");
            asm volatile("s_waitcnt vmcnt(0)" ::: "memory");
        }
    }
    __syncthreads();
}


namespace pg8 {
#define PG8_LAS __attribute__((address_space(3)))
typedef unsigned short bf16_t;
typedef short bf16x8 __attribute__((ext_vector_type(8)));
typedef float f32x4 __attribute__((ext_vector_type(4)));
typedef unsigned u32x4 __attribute__((ext_vector_type(4)));
constexpr int BM = 256, BK = 64, HALF = 128, HTB = HALF * BK * 2  , STAGE_BYTES = 8 * HTB, NXCD = 8, WGM = 8;

__host__ __device__ __forceinline__ int lds_byte(int r, int c) { const int st = (r >> 4) * 2 + (c >> 5), rr = r & 15, cc = c & 31, ob = rr * 64 + cc * 2; return st * 1024 + (ob ^ (((ob >> 9) & 1) << 5)); }
__host__ __device__ __forceinline__ void stage_rc(int b, int& R, int& C) { const int st = b / 1024, sb = b % 1024, swz = sb ^ (((sb >> 9) & 1) << 5); R = (st >> 1) * 16 + swz / 64; C = (st & 1) * 32 + (swz % 64) / 2; }
__host__ __device__ __forceinline__ int perm32(int rho) { const int n = rho >> 4, i = rho & 15; return 8 * (i >> 2) + 4 * n + (i & 3); }

struct Unit { int pm, pn; };
struct Gemm { const bf16_t* A; const bf16_t* Bt; int M, N, K; };

struct StaticOrder {
    static constexpr bool GATHER = false;
    int nM, nN, nwg, G, c;
    __host__ __device__ void init(int M, int N, int G_, int c_) { nM = M / BM; nN = N / BM; nwg = nM * nN; G = G_; c = c_; }
    __host__ __device__ bool next(int i, Unit& u) const {
        const long L = (long)i * G + c; if (L >= nwg) return false;
        int wgid = (int)L; { const int q = nwg / NXCD, r = nwg % NXCD, xcd = wgid % NXCD, off = wgid / NXCD; wgid = (xcd < r ? xcd * (q + 1) : r * (q + 1) + (xcd - r) * q) + off; }
        const int nig = WGM * nN, gid = wgid / nig, fm = gid * WGM, gsz = (nM - fm) < WGM ? (nM - fm) : WGM;
        u.pm = fm + ((wgid % nig) % gsz); u.pn = (wgid % nig) / gsz; return true;
    }
    __device__ __forceinline__ void a_ready(const Unit&) const {}
    __device__ __forceinline__ void done(const Unit&) const {}
};

__device__ __forceinline__ unsigned cvt_pk_bf16(float lo, float hi) { unsigned r; asm volatile("v_cvt_pk_bf16_f32 %0, %1, %2" : "=v"(r) : "v"(lo), "v"(hi)); return r; }
typedef float f32x2 __attribute__((ext_vector_type(2)));
template <class Epi, class Sched, bool ALIGN_EPI = false, bool SP2 = false>
__device__ __forceinline__ void gemm_phase(PG8_LAS unsigned char* lds, const Gemm g, const Sched& S, const Epi& E) {
    const int tid = threadIdx.x, wid = __builtin_amdgcn_readfirstlane(tid >> 6), lane = tid & 63, wr = wid >> 2, wc = wid & 3, fr = lane & 15, fq = lane >> 4;
    const int K = g.K, nt = K / BK;
    unsigned voffA[2], voffB[2]; int gR[2], gC[2]; unsigned gvc[2][2] = {{0u, 0u}, {0u, 0u}}, gvn[2][2] = {{0u, 0u}, {0u, 0u}};
#pragma unroll
    for (int i = 0; i < 2; ++i) { int R, C; stage_rc(tid * 16 + i * 8192, R, C); const int Rb = Epi::PERM ? ((R & ~31) + perm32(R & 31)) : R;
        voffA[i] = (unsigned)(R * K + C) * 2u; gR[i] = R; gC[i] = C; voffB[i] = (unsigned)(Rb * K + C) * 2u; }
    const size_t kstep = (size_t)(BK * 2);
    const size_t hstep = (size_t)HALF * K * 2;
    const size_t tstep = 2 * hstep;
    const unsigned ldsw = (unsigned)wid * 1024u;
    const int aoff = lds_byte(wr * 64 + fr, fq * 8), boff = lds_byte(wc * 32 + fr, fq * 8);
#define PG8_SA(b, h) (((b) * 2 + (h)) * HTB)
#define PG8_SB(b, h) ((4 + (b) * 2 + (h)) * HTB)
#define PG8_STAGE(bufoff, gbase, voff) do { _Pragma("unroll") for (int _i = 0; _i < 2; ++_i) \
        __builtin_amdgcn_global_load_lds((const unsigned*)((const char*)(gbase) + (voff)[_i]), (PG8_LAS unsigned*)(lds + (bufoff) + ldsw + _i * 8192), 16, 0, 0); } while (0)
#define PG8_STAGE_A(bufoff, ptr, h, nx) do { if constexpr (Sched::GATHER) { _Pragma("unroll") for (int _i = 0; _i < 2; ++_i) { const unsigned _o = (nx) ? gvn[h][_i] : gvc[h][_i]; \
        __builtin_amdgcn_global_load_lds((const unsigned*)((const char*)(ptr) + _o), (PG8_LAS unsigned*)(lds + (bufoff) + ldsw + _i * 8192), 16, 0, 0); } } \
        else { PG8_STAGE(bufoff, (ptr) + (h) * hstep, voffA); } } while (0)
#define PG8_LDA(dst, b, h) do { _Pragma("unroll") for (int m = 0; m < 4; ++m) _Pragma("unroll") for (int k = 0; k < 2; ++k) dst[m][k] = *(const PG8_LAS bf16x8*)(lds + PG8_SA(b, h) + aoff + m * 2048 + k * 1024); } while (0)
#define PG8_LDB(dst, b, h) do { _Pragma("unroll") for (int n = 0; n < 2; ++n) _Pragma("unroll") for (int k = 0; k < 2; ++k) dst[n][k] = *(const PG8_LAS bf16x8*)(lds + PG8_SB(b, h) + boff + n * 2048 + k * 1024); } while (0)
#define PG8_MMA(ai, bj, At, Bt) do { __builtin_amdgcn_s_setprio(1); _Pragma("unroll") for (int m = 0; m < 4; ++m) _Pragma("unroll") for (int n = 0; n < 2; ++n) _Pragma("unroll") for (int k = 0; k < 2; ++k) \
        acc[ai][bj][m][n] = __builtin_amdgcn_mfma_f32_16x16x32_bf16(Bt[n][k], At[m][k], acc[ai][bj][m][n], 0, 0, 0); __builtin_amdgcn_s_setprio(0); } while (0)
#define PG8_WAIT_V(n) asm volatile("s_waitcnt vmcnt(" #n ")" ::: "memory")
#define PG8_WAIT_L(n) asm volatile("s_waitcnt lgkmcnt(" #n ")" ::: "memory")
#define PG8_BAR __builtin_amdgcn_s_barrier()
#define PG8_SCHED __builtin_amdgcn_sched_barrier(0)
    Unit cur, nxt; int ui = 0;
    if (!S.next(0, cur)) return;
    f32x4 acc[2][2][4][2];
#pragma unroll
    for (int a = 0; a < 2; ++a)
#pragma unroll
        for (int b = 0; b < 2; ++b)
#pragma unroll
            for (int m = 0; m < 4; ++m)
#pragma unroll
                for (int n = 0; n < 2; ++n) acc[a][b][m][n] = (f32x4){0.f, 0.f, 0.f, 0.f};
    bf16x8 At[4][2], B0[2][2], B1[2][2];
    const char* cA = (const char*)g.A + (Sched::GATHER ? (size_t)0 : (size_t)cur.pm * tstep);
    if constexpr (Sched::GATHER) { _Pragma("unroll") for (int h = 0; h < 2; ++h) _Pragma("unroll") for (int i = 0; i < 2; ++i) gvc[h][i] = (unsigned)S.arow(cur, h * HALF + gR[i]) * (unsigned)(K * 2) + (unsigned)(gC[i] * 2); }
    const char* cB = (const char*)g.Bt + (size_t)cur.pn * tstep;
    S.a_ready(cur);
    if constexpr (SP2) {
        PG8_STAGE(PG8_SB(0, 0), cB, voffB); PG8_STAGE(PG8_SB(0, 1), cB + hstep, voffB); PG8_STAGE_A(PG8_SA(0, 0), cA, 0, false); PG8_STAGE_A(PG8_SA(0, 1), cA, 1, false);
        if (wr == 1) PG8_BAR;
        PG8_WAIT_V(2); PG8_BAR;
        PG8_STAGE(PG8_SB(1, 0), cB + kstep, voffB); PG8_STAGE_A(PG8_SA(1, 0), cA + kstep, 0, false); PG8_STAGE(PG8_SB(1, 1), cB + hstep + kstep, voffB);
        PG8_WAIT_V(6); PG8_BAR;
    } else {
        PG8_STAGE(PG8_SB(0, 0), cB, voffB); PG8_STAGE_A(PG8_SA(0, 0), cA, 0, false); PG8_STAGE(PG8_SB(0, 1), cB + hstep, voffB); PG8_STAGE_A(PG8_SA(0, 1), cA, 1, false);
        if (wr == 1) PG8_BAR;
        PG8_WAIT_V(4); PG8_BAR;
        PG8_STAGE(PG8_SB(1, 0), cB + kstep, voffB); PG8_STAGE_A(PG8_SA(1, 0), cA + kstep, 0, false); PG8_STAGE(PG8_SB(1, 1), cB + hstep + kstep, voffB);
        PG8_WAIT_V(6); PG8_BAR;
    }
    for (;;) {
        const bool has_next = S.next(ui + 1, nxt);
        const char* nA = has_next ? (const char*)g.A + (Sched::GATHER ? (size_t)0 : (size_t)nxt.pm * tstep) : cA;
        if constexpr (Sched::GATHER) { _Pragma("unroll") for (int h = 0; h < 2; ++h) _Pragma("unroll") for (int i = 0; i < 2; ++i) gvn[h][i] = has_next ? (unsigned)S.arow(nxt, h * HALF + gR[i]) * (unsigned)(K * 2) + (unsigned)(gC[i] * 2) : gvc[h][i]; }
        const char* nB = has_next ? (const char*)g.Bt + (size_t)nxt.pn * tstep : cB;
        for (int t = 0; t < nt; t += 2) {
            const bool last = (t == nt - 2);
            const char* a1 = cA + (size_t)(t + 1) * kstep;
            const char* a2 = last ? nA : cA + (size_t)(t + 2) * kstep; const char* b2 = last ? nB : cB + (size_t)(t + 2) * kstep;
            const char* a3 = a2 + kstep; const char* b3 = b2 + kstep;
            if (last && has_next) S.a_ready(nxt);
            if constexpr (SP2) {
            PG8_LDB(B0, 0, 0); PG8_LDB(B1, 0, 1); PG8_SCHED; PG8_LDA(At, 0, 0); PG8_STAGE_A(PG8_SA(1, 1), a1, 1, false);
            PG8_WAIT_V(8); PG8_WAIT_L(0); PG8_BAR; PG8_MMA(0, 0, At, B0); PG8_MMA(0, 1, At, B1); PG8_BAR; PG8_SCHED;
            PG8_LDA(At, 0, 1); PG8_STAGE(PG8_SB(0, 0), b2, voffB); PG8_STAGE(PG8_SB(0, 1), b2 + hstep, voffB); PG8_STAGE_A(PG8_SA(0, 0), a2, 0, last);
            PG8_WAIT_V(8); PG8_WAIT_L(0); PG8_BAR; PG8_MMA(1, 0, At, B0); PG8_MMA(1, 1, At, B1); PG8_BAR; PG8_SCHED;
            PG8_LDB(B0, 1, 0); PG8_LDB(B1, 1, 1); PG8_SCHED; PG8_LDA(At, 1, 0); PG8_STAGE_A(PG8_SA(0, 1), a2, 1, last);
            PG8_WAIT_V(8); PG8_WAIT_L(0); PG8_BAR; PG8_MMA(0, 0, At, B0); PG8_MMA(0, 1, At, B1); PG8_BAR; PG8_SCHED;
            PG8_LDA(At, 1, 1); PG8_STAGE(PG8_SB(1, 0), b3, voffB); PG8_STAGE(PG8_SB(1, 1), b3 + hstep, voffB); PG8_STAGE_A(PG8_SA(1, 0), a3, 0, last);
            PG8_WAIT_V(8); PG8_WAIT_L(0); PG8_BAR; PG8_MMA(1, 0, At, B0); PG8_MMA(1, 1, At, B1); PG8_BAR; PG8_SCHED;
            } else {
            PG8_LDB(B0, 0, 0); PG8_SCHED; PG8_LDA(At, 0, 0); PG8_STAGE_A(PG8_SA(1, 1), a1, 1, false);
            PG8_WAIT_L(8); PG8_BAR; PG8_WAIT_L(0); PG8_MMA(0, 0, At, B0); PG8_BAR; PG8_SCHED;
            PG8_LDB(B1, 0, 1); PG8_STAGE(PG8_SB(0, 0), b2, voffB);
            PG8_BAR; PG8_WAIT_L(0); PG8_MMA(0, 1, At, B1); PG8_BAR;
            PG8_LDA(At, 0, 1); PG8_STAGE_A(PG8_SA(0, 0), a2, 0, last);
            PG8_BAR; PG8_WAIT_L(0); PG8_MMA(1, 0, At, B0); PG8_BAR; PG8_SCHED;
            PG8_STAGE(PG8_SB(0, 1), b2 + hstep, voffB);
            PG8_WAIT_V(6); PG8_BAR; PG8_MMA(1, 1, At, B1); PG8_BAR;
            PG8_LDB(B0, 1, 0); PG8_SCHED; PG8_LDA(At, 1, 0); PG8_STAGE_A(PG8_SA(0, 1), a2, 1, last);
            PG8_WAIT_L(8); PG8_BAR; PG8_WAIT_L(0); PG8_MMA(0, 0, At, B0); PG8_BAR; PG8_SCHED;
            PG8_LDB(B1, 1, 1); PG8_STAGE(PG8_SB(1, 0), b3, voffB);
            PG8_BAR; PG8_WAIT_L(0); PG8_MMA(0, 1, At, B1); PG8_BAR;
            PG8_LDA(At, 1, 1); PG8_STAGE_A(PG8_SA(1, 0), a3, 0, last);
            PG8_BAR; PG8_WAIT_L(0); PG8_MMA(1, 0, At, B0); PG8_BAR; PG8_SCHED;
            PG8_STAGE(PG8_SB(1, 1), b3 + hstep, voffB);
            PG8_WAIT_V(6); PG8_BAR; PG8_MMA(1, 1, At, B1); PG8_BAR;
            }
        }
        if constexpr (ALIGN_EPI) { if (wr == 0) PG8_BAR; }
        if constexpr (!Epi::AFTER_DRAIN) { E(acc, cur, wr, wc, fr, fq); S.done(cur); }
        if (!has_next) break;
#pragma unroll
        for (int a = 0; a < 2; ++a)
#pragma unroll
            for (int b = 0; b < 2; ++b)
#pragma unroll
                for (int m = 0; m < 4; ++m)
#pragma unroll
                    for (int n = 0; n < 2; ++n) acc[a][b][m][n] = (f32x4){0.f, 0.f, 0.f, 0.f};
        cur = nxt; cA = nA; cB = nB; ++ui;
        if constexpr (Sched::GATHER) { _Pragma("unroll") for (int h = 0; h < 2; ++h) _Pragma("unroll") for (int i = 0; i < 2; ++i) gvc[h][i] = gvn[h][i]; }
        if constexpr (ALIGN_EPI) { if (wr == 1) PG8_BAR; }
    }
    PG8_WAIT_V(0);
    if constexpr (!ALIGN_EPI) { if (wr == 0) PG8_BAR; }
    PG8_BAR;
    if constexpr (Epi::AFTER_DRAIN) { E.fused(acc, cur, wr, wc, fr, fq, lds, wid, lane); S.done(cur); }
#undef PG8_SA
#undef PG8_SB
#undef PG8_STAGE
#undef PG8_STAGE_A
#undef PG8_LDA
#undef PG8_LDB
#undef PG8_MMA
#undef PG8_WAIT_V
#undef PG8_WAIT_L
#undef PG8_BAR
#undef PG8_SCHED
}
}

typedef float f32x4 __attribute__((ext_vector_type(4)));
typedef unsigned u32x4 __attribute__((ext_vector_type(4)));
typedef unsigned u32x2 __attribute__((ext_vector_type(2)));
__device__ __forceinline__ float silu_acc(float x) { return x / (1.f + expf(-x)); }
__device__ __forceinline__ float silu_fast(float x) { return x * __builtin_amdgcn_rcpf(1.f + __expf(-x)); }
__device__ __forceinline__ float softplus_f(float x) { return fmaxf(x, 0.f) + log1pf(expf(-fabsf(x))); }
__device__ __forceinline__ float wave_sum(float v) {
#pragma unroll
    for (int o = 1; o < 64; o <<= 1) v += __shfl_xor(v, o);
    return v;
}
__device__ __forceinline__ float wave_max(float v) {
#pragma unroll
    for (int o = 1; o < 64; o <<= 1) v = fmaxf(v, __shfl_xor(v, o));
    return v;
}
__device__ __forceinline__ float bf2f(bf16 v) { return __uint_as_float((unsigned)v << 16); }
__device__ __forceinline__ float bflo(unsigned w) { return __uint_as_float(w << 16); }
__device__ __forceinline__ float bfhi(unsigned w) { return __uint_as_float(w & 0xffff0000u); }
__device__ __forceinline__ unsigned f2bf(float f) { unsigned u = __float_as_uint(f); return (u + 0x7fffu + ((u >> 16) & 1u)) >> 16; }
__device__ __forceinline__ unsigned pk2(float lo, float hi) { return f2bf(lo) | (f2bf(hi) << 16); }

struct Ptrs {
    const float *x, *c, *ctx, *c_ctx, *w_ada, *b_ada, *norm1, *w_in, *conv_w, *conv_b, *dt_bias, *a_log, *d_skip, *ssd_norm, *sinks,
                *w_out, *norm2, *w_group, *b_group, *w_expert, *b_expert, *w_gate, *w_up, *w_down, *norm_final;
    float* out; unsigned char* ws;
};

__device__ __forceinline__ void transpose_item(const float* W, int ldn, int sn0, int k0, bf16* WT, int Kp, int drow0, LAS float* scr, int lane) {
    f32x4 v[16];
#pragma unroll
    for (int i = 0; i < 16; ++i) v[i] = *(const f32x4*)(W + (size_t)(k0 + 4 * i + (lane >> 4)) * ldn + sn0 + (lane & 15) * 4);
#pragma unroll
    for (int i = 0; i < 16; ++i) { LAS float* d = scr + (4 * i + (lane >> 4)) * 65 + (lane & 15) * 4; d[0] = v[i].x; d[1] = v[i].y; d[2] = v[i].z; d[3] = v[i].w; }
    asm volatile("s_waitcnt lgkmcnt(0)" ::: "memory");
    const int c = lane & 7;
#pragma unroll
    for (int j = 0; j < 8; ++j) { const int n = (lane >> 3) + 8 * j; const LAS float* s = scr + (8 * c) * 65 + n;
        u32x4 o; o.x = pg8::cvt_pk_bf16(s[0 * 65], s[1 * 65]); o.y = pg8::cvt_pk_bf16(s[2 * 65], s[3 * 65]); o.z = pg8::cvt_pk_bf16(s[4 * 65], s[5 * 65]); o.w = pg8::cvt_pk_bf16(s[6 * 65], s[7 * 65]);
        *(u32x4*)(WT + (size_t)(drow0 + n) * Kp + k0 + 8 * c) = o; }
    asm volatile("s_waitcnt lgkmcnt(0)" ::: "memory");
}

constexpr int CONV_IN = 36 * 16, CONV_OUT = 16 * 16, CONV_GU = 32 * 8 * 16, CONV_D = 32 * 16 * 8, CONV_ITEMS = CONV_IN + CONV_OUT + 2 * CONV_GU + CONV_D;
constexpr int CONV_N0 = CONV_IN + CONV_OUT + 4096;
constexpr int CONV_N1 = CONV_IN + CONV_OUT + 2 * CONV_GU;
__device__ __forceinline__ void conv_item(const Ptrs& P, int it, bf16* WIN, bf16* WOUT, bf16* WGU, bf16* WD, LAS float* scr, int lane) {
    int r = it;
    if (r < CONV_IN) { const int g = r % 36, kb = r / 36, d0 = g * 64; transpose_item(P.w_in, INC, d0 + (d0 >= 1536 ? 16 : 0), kb * 64, WIN, 1024, d0, scr, lane); return; } r -= CONV_IN;
    if (r < CONV_OUT) { const int g = r % 16, kb = r / 16; transpose_item(P.w_out, 1024, g * 64, kb * 64, WOUT, 1024, g * 64, scr, lane); return; } r -= CONV_OUT;
    if (r < 2 * CONV_GU) { const int up = r >= CONV_GU; if (up) r -= CONV_GU; const int e = r >> 7, q = r & 127, g = q & 7, kb = q >> 3, c0 = g * 64;
        transpose_item((up ? P.w_up : P.w_gate) + (size_t)e * 1024 * 512, 512, c0, kb * 64, WGU, 1024, e * 1024 + (c0 >> 7) * 256 + (up ? 128 : 0) + (c0 & 127), scr, lane); return; } r -= 2 * CONV_GU;
    { const int e = r >> 7, q = r & 127, g = q & 15, kb = q >> 4; transpose_item(P.w_down + (size_t)e * 512 * 1024, 1024, g * 64, kb * 64, WD, 512, e * 1024 + g * 64, scr, lane); }
}
__device__ __forceinline__ int chunk_row0(int q) { return q < 128 ? q * 128 : ML + (q - 128) * 128; }

struct EpiStoreBf16 {
    static constexpr bool PERM = true, AFTER_DRAIN = false;
    bf16* O; int ldc;
    __device__ __forceinline__ void operator()(const pg8::f32x4 (&acc)[2][2][4][2], const pg8::Unit& u, int wr, int wc, int fr, int fq) const {
        const int row0 = u.pm * 256 + wr * 64 + fr, col0 = u.pn * 256 + wc * 32 + 8 * fq;
#pragma unroll
        for (int ai = 0; ai < 2; ++ai)
#pragma unroll
            for (int m = 0; m < 4; ++m) { bf16* rowp = O + (size_t)(row0 + ai * 128 + m * 16) * ldc + col0;
#pragma unroll
                for (int bj = 0; bj < 2; ++bj) { const pg8::f32x4 v0 = acc[ai][bj][m][0], v1 = acc[ai][bj][m][1];
                    u32x4 w; w.x = pg8::cvt_pk_bf16(v0[0], v0[1]); w.y = pg8::cvt_pk_bf16(v0[2], v0[3]); w.z = pg8::cvt_pk_bf16(v1[0], v1[1]); w.w = pg8::cvt_pk_bf16(v1[2], v1[3]);
                    *(u32x4*)(rowp + bj * 128) = w; } }
    }
};
struct EpiOutProj {
    static constexpr bool PERM = true, AFTER_DRAIN = false;
    const float* x; const float* mod; bf16* X1; float* SSQP;
    __device__ __forceinline__ void operator()(const pg8::f32x4 (&acc)[2][2][4][2], const pg8::Unit& u, int wr, int wc, int fr, int fq) const {
        const int row0 = u.pm * 256 + wr * 64 + fr, col0 = u.pn * 256 + wc * 32 + 8 * fq;
        const float* g1 = mod + (u.pm * 256 / SEQ) * 6144 + 2048;
        f32x4 gv[2][2];
#pragma unroll
        for (int bj = 0; bj < 2; ++bj)
#pragma unroll
            for (int n = 0; n < 2; ++n) gv[bj][n] = *(const f32x4*)(g1 + col0 + bj * 128 + n * 4);
#pragma unroll
        for (int ai = 0; ai < 2; ++ai)
#pragma unroll
            for (int m = 0; m < 4; ++m) { const size_t off = (size_t)(row0 + ai * 128 + m * 16) * DM + col0;
                float s_ = 0.f;
#pragma unroll
                for (int bj = 0; bj < 2; ++bj) {
                    f32x4 o[2];
#pragma unroll
                    for (int n = 0; n < 2; ++n) { const f32x4 xv = *(const f32x4*)(x + off + bj * 128 + n * 4); const pg8::f32x4 a = acc[ai][bj][m][n];
                        o[n].x = xv.x + gv[bj][n].x * a[0]; o[n].y = xv.y + gv[bj][n].y * a[1]; o[n].z = xv.z + gv[bj][n].z * a[2]; o[n].w = xv.w + gv[bj][n].w * a[3];
                        s_ += o[n].x * o[n].x + o[n].y * o[n].y + o[n].z * o[n].z + o[n].w * o[n].w; }
                    u32x4 w; w.x = pg8::cvt_pk_bf16(o[0].x, o[0].y); w.y = pg8::cvt_pk_bf16(o[0].z, o[0].w); w.z = pg8::cvt_pk_bf16(o[1].x, o[1].y); w.w = pg8::cvt_pk_bf16(o[1].z, o[1].w);
                    *(u32x4*)(X1 + off + bj * 128) = w; }
                s_ += __shfl_xor(s_, 16); s_ += __shfl_xor(s_, 32);
                if (fq == 0) SSQP[(size_t)(row0 + ai * 128 + m * 16) * 16 + u.pn * 4 + wc] = s_; }
    }
};
struct EpiGateUp {
    static constexpr bool PERM = true, AFTER_DRAIN = false;
    bf16* ACT;
    __device__ __forceinline__ void operator()(const pg8::f32x4 (&acc)[2][2][4][2], const pg8::Unit& u, int wr, int wc, int fr, int fq) const {
        const int row0 = u.pm * 256 + wr * 64 + fr, col0 = (u.pn & 3) * 128 + wc * 32 + 8 * fq;
#pragma unroll
        for (int ai = 0; ai < 2; ++ai)
#pragma unroll
            for (int m = 0; m < 4; ++m) {
                float r[8];
#pragma unroll
                for (int n = 0; n < 2; ++n)
#pragma unroll
                    for (int i = 0; i < 4; ++i) { const float g = acc[ai][0][m][n][i], up = acc[ai][1][m][n][i]; r[n * 4 + i] = silu_fast(g) * up; }
                u32x4 w; w.x = pg8::cvt_pk_bf16(r[0], r[1]); w.y = pg8::cvt_pk_bf16(r[2], r[3]); w.z = pg8::cvt_pk_bf16(r[4], r[5]); w.w = pg8::cvt_pk_bf16(r[6], r[7]);
                *(u32x4*)(ACT + (size_t)(row0 + ai * 128 + m * 16) * EDIM + col0) = w; }
    }
};
struct EpiDown {
    static constexpr bool PERM = true, AFTER_DRAIN = false;
    bf16* Y; const int* LIST; const LAS int* tab;
    __device__ __forceinline__ void operator()(const pg8::f32x4 (&acc)[2][2][4][2], const pg8::Unit& u, int wr, int wc, int fr, int fq) const {
        const int e = u.pn >> 2, pos0 = (u.pm - tab[e]) * 256 + wr * 64 + fr, cnt = tab[64 + e], col0 = (u.pn & 3) * 256 + wc * 32 + 8 * fq;
#pragma unroll
        for (int ai = 0; ai < 2; ++ai)
#pragma unroll
            for (int m = 0; m < 4; ++m) { const int pos = pos0 + ai * 128 + m * 16;
                if (pos < cnt) { const int aid = LIST[e * ML + pos]; bf16* rowp = Y + (size_t)aid * DM + col0;
#pragma unroll
                    for (int bj = 0; bj < 2; ++bj) { const pg8::f32x4 v0 = acc[ai][bj][m][0], v1 = acc[ai][bj][m][1];
                        u32x4 w; w.x = pg8::cvt_pk_bf16(v0[0], v0[1]); w.y = pg8::cvt_pk_bf16(v0[2], v0[3]); w.z = pg8::cvt_pk_bf16(v1[0], v1[1]); w.w = pg8::cvt_pk_bf16(v1[2], v1[3]);
                        *(u32x4*)(rowp + bj * 128) = w; } } }
    }
};
template <bool G_> struct MoeOrder {
    static constexpr bool GATHER = G_;
    const LAS int* tab; const int* LIST; int G, c;
    __device__ __forceinline__ bool next(int i, pg8::Unit& u) const {
        if (G == 256) { const int x = c & 7, j = i * 32 + (c >> 3), p0 = tab[4 * x], p1 = tab[4 * x + 4]; if (j >= (p1 - p0) * 4) return false;
            const int p = p0 + (j >> 2); u.pm = p; u.pn = tab[128 + p] * 4 + (j & 3); return true; }
        const int L = i * G + c; if (L >= tab[32] * 4) return false;
        const int p = L >> 2; u.pm = p; u.pn = tab[128 + p] * 4 + (L & 3); return true;
    }
    __device__ __forceinline__ int arow(const pg8::Unit& u, int r) const {
        const int e = u.pn >> 2, pos = (u.pm - tab[e]) * 256 + r;
        return pos < tab[64 + e] ? (LIST[e * ML + pos] >> 1) : 0;
    }
    __device__ __forceinline__ void a_ready(const pg8::Unit&) const {}
    __device__ __forceinline__ void done(const pg8::Unit&) const {}
};

struct Args { Ptrs p; int ph_lo, ph_hi; };

__global__ void __launch_bounds__(NTHREADS, 2) fwd_kernel(Args args) {
    extern __shared__ __attribute__((aligned(16))) unsigned char lds_raw[];
    LAS unsigned char* lds = (LAS unsigned char*)lds_raw;
    const Ptrs& P = args.p;
    const int tid = threadIdx.x, lane = tid & 63, wave = __builtin_amdgcn_readfirstlane(tid >> 6);
    const int G = gridDim.x, bid = blockIdx.x;
    const int gtid = bid * NTHREADS + tid, NT = G * NTHREADS;
    const int gw = bid * 8 + wave, NGW = G * 8;
    unsigned char* ws = P.ws;
    unsigned* ctl = (unsigned*)(ws + WS_CTL);
    float* MODP = (float*)(ws + WS_MODP);
    float* MOD = (float*)(ws + WS_MOD);
    float* ROPEC = (float*)(ws + WS_ROPE);
    float* ROPES = ROPEC + 8192 * 32;
    float* DT = (float*)(ws + WS_DT);
    float* ACS = (float*)(ws + WS_ACS);
    float* SSQP = (float*)(ws + WS_ACS);
    float* AL = (float*)(ws + WS_AL);
    float* EW = (float*)(ws + WS_EW);
    int* LIST = (int*)(ws + WS_LIST);
    float* FV = (float*)(ws + WS_FV);
    bf16* WRH = (bf16*)(ws + WS_WR);
    bf16* WRL = WRH + 48 * 1024;
    float* F1V = (float*)(ws + WS_F1);
    float* DBV = (float*)(ws + WS_DB);
    bf16* WDH = (bf16*)(ws + WS_WDT);
    bf16* WDL = WDH + 16 * 1024;
    bf16* WIN = (bf16*)(ws + WS_WIN);
    bf16* WOUT = (bf16*)(ws + WS_WOUT);
    bf16* WGU = (bf16*)(ws + WS_WGU);
    bf16* WD = (bf16*)(ws + WS_WD);
    bf16* HX = (bf16*)(ws + WS_HX);
    bf16* MIX = (bf16*)P.out;
    bf16* XST = (bf16*)(ws + WS_XST);
    bf16* BT = (bf16*)(ws + WS_BT);
    bf16* PR = (bf16*)(ws + WS_P);
    bf16* H2 = (bf16*)(ws + WS_HS);
    bf16* Y = (bf16*)(ws + WS_HS);
    bf16* U = (bf16*)(ws + WS_U);
    bf16* ACT = (bf16*)P.out;
    bf16* S = (bf16*)(ws + WS_S);
    bf16* KR = (bf16*)(ws + WS_KR);
    bf16* X1 = (bf16*)(ws + WS_X1);
    unsigned* CNT = ctl + CW_CNT;

    volatile LAS unsigned* MISC = (volatile LAS unsigned*)(lds + LDS_BYTES - 64);
    if (tid < 16) MISC[tid] = 0u;
    __syncthreads();
    XcdBarrier bar = xcd_barrier_post(ctl + CW_BAR, MISC);
    const int lo = args.ph_lo, hi = args.ph_hi;
#define IN(k) (lo <= (k) && (k) < hi)
#define SEAM(k) do { if (IN(k) && IN((k) + 1)) xcd_barrier(bar); } while (0)

    if (IN(0)) {
        LAS float* sc3 = (LAS float*)lds;
        LAS float* mred = sc3 + 3072;
        LAS float* modl = mred + 64 * 72;
        for (int i = tid; i < 3072; i += NTHREADS) sc3[i] = silu_acc(i < 2048 ? P.c[i] : P.c_ctx[i - 2048]);
        __syncthreads();
        for (int cb = bid; cb < 256; cb += G) {
            const int c8 = tid & 7, kq = tid >> 3, col = cb * 24 + c8 * 3;
            float a[3][3];
#pragma unroll
            for (int r = 0; r < 3; ++r)
#pragma unroll
                for (int c = 0; c < 3; ++c) a[r][c] = 0.f;
#pragma unroll 4
            for (int k = kq * 16; k < kq * 16 + 16; ++k) {
                const float* wp = P.w_ada + (size_t)k * 6144 + col;
                const float w0 = wp[0], w1 = wp[1], w2 = wp[2], s0 = sc3[k], s1 = sc3[1024 + k], s2 = sc3[2048 + k];
                a[0][0] += s0 * w0; a[0][1] += s0 * w1; a[0][2] += s0 * w2; a[1][0] += s1 * w0; a[1][1] += s1 * w1; a[1][2] += s1 * w2; a[2][0] += s2 * w0; a[2][1] += s2 * w1; a[2][2] += s2 * w2;
            }
#pragma unroll
            for (int r = 0; r < 3; ++r)
#pragma unroll
                for (int c = 0; c < 3; ++c) mred[kq * 72 + r * 24 + c8 * 3 + c] = a[r][c];
            __syncthreads();
            if (tid < 72) {
                const int r = tid / 24, cc = cb * 24 + tid % 24;
                float s = P.b_ada[cc];
                for (int g = 0; g < 64; ++g) s += mred[g * 72 + tid];
                MOD[r * 6144 + cc] = s; modl[tid] = s;
                if (cc >= 1024 && cc < 2048) F1V[r * 1024 + cc - 1024] = P.norm1[cc - 1024] * (1.f + s);
                if (cc >= 4096 && cc < 5120 && r < 2) FV[r * 1024 + cc - 4096] = P.norm2[cc - 4096] * (1.f + s);
            }
            __syncthreads();
        }
        for (int idx = gtid; idx < 64 * 1024; idx += NT) {
            const int k = idx & 1023, n = idx >> 10;
            const float v = n < 16 ? P.w_in[(size_t)k * INC + 1536 + n] : (n < 20 ? P.w_group[k * 4 + n - 16] : (n < 52 ? P.w_expert[k * 32 + n - 20] : 0.f));
            const unsigned h = f2bf(v); const bf16 lo = (bf16)f2bf(v - __uint_as_float(h << 16));
            if (n < 16) { WDH[idx] = (bf16)h; WDL[idx] = lo; } else { WRH[idx - 16 * 1024] = (bf16)h; WRL[idx - 16 * 1024] = lo; }
        }
        __syncthreads();
        for (int idx = gtid; idx < 8192 * 32; idx += NT) {
            const int pos = idx >> 5, f = idx & 31;
            const float inv = powf(10000.0f, -(float)(f & 15) / 16.0f);
            const float ang = (float)((f < 16) ? (pos >> 6) : (pos & 63)) * inv;
            ROPEC[idx] = cosf(ang); ROPES[idx] = sinf(ang);
        }
        LAS float* scr = (LAS float*)(lds + wave * 16640);
        for (int it = wave * G + bid; it < CONV_N0; it += NGW) conv_item(P, it, WIN, WOUT, WGU, WD, scr, lane);
    }
    SEAM(0);
    if (IN(2)) {
        typedef short s16x8 __attribute__((ext_vector_type(8)));
        const int l15 = lane & 15, c4 = lane >> 4;
        for (int task = wave * G + bid; task < MT / 16; task += NGW) {
            const int r0 = task * 16, m = r0 < ML ? r0 / SEQ : 2, rr = r0 + l15, k0 = 8 * c4;
            const float* xr = (rr < ML ? P.x + (size_t)rr * DM : P.ctx + (size_t)(rr - ML) * DM) + k0;
            float ssq = 0.f;
#pragma unroll 8
            for (int s = 0; s < 32; ++s) { const f32x4 xa = *(const f32x4*)(xr + 32 * s), xb = *(const f32x4*)(xr + 32 * s + 4);
                ssq += xa.x * xa.x + xa.y * xa.y + xa.z * xa.z + xa.w * xa.w + xb.x * xb.x + xb.y * xb.y + xb.z * xb.z + xb.w * xb.w; }
            ssq += __shfl_xor(ssq, 16); ssq += __shfl_xor(ssq, 32);
            const float rstd = rsqrtf(ssq * (1.f / DM) + EPS);
            bf16* ho = HX + (size_t)rr * DM + k0;
            const float* fv = F1V + m * 1024 + k0; const float* shv = MOD + m * 6144 + k0;
            const bf16* wh = WDH + (size_t)l15 * 1024 + k0; const bf16* wl = WDL + (size_t)l15 * 1024 + k0;
            pg8::f32x4 acc = {0.f, 0.f, 0.f, 0.f};
#pragma unroll 4
            for (int s = 0; s < 32; ++s) {
                const f32x4 xa = *(const f32x4*)(xr + 32 * s), xb = *(const f32x4*)(xr + 32 * s + 4);
                const f32x4 fa = *(const f32x4*)(fv + 32 * s), fb = *(const f32x4*)(fv + 32 * s + 4), sa = *(const f32x4*)(shv + 32 * s), sb = *(const f32x4*)(shv + 32 * s + 4);
                const float h0 = xa.x * rstd * fa.x + sa.x, h1 = xa.y * rstd * fa.y + sa.y, h2_ = xa.z * rstd * fa.z + sa.z, h3 = xa.w * rstd * fa.w + sa.w;
                const float h4 = xb.x * rstd * fb.x + sb.x, h5 = xb.y * rstd * fb.y + sb.y, h6 = xb.z * rstd * fb.z + sb.z, h7 = xb.w * rstd * fb.w + sb.w;
                const u32x4 hw = {pg8::cvt_pk_bf16(h0, h1), pg8::cvt_pk_bf16(h2_, h3), pg8::cvt_pk_bf16(h4, h5), pg8::cvt_pk_bf16(h6, h7)};
                *(u32x4*)(ho + 32 * s) = hw;
                const u32x4 lw = {pg8::cvt_pk_bf16(h0 - bflo(hw.x), h1 - bfhi(hw.x)), pg8::cvt_pk_bf16(h2_ - bflo(hw.y), h3 - bfhi(hw.y)),
                                  pg8::cvt_pk_bf16(h4 - bflo(hw.z), h5 - bfhi(hw.z)), pg8::cvt_pk_bf16(h6 - bflo(hw.w), h7 - bfhi(hw.w))};
                const s16x8 ah = __builtin_bit_cast(s16x8, hw), alo = __builtin_bit_cast(s16x8, lw);
                const s16x8 bh = *(const s16x8*)(wh + 32 * s), bl = *(const s16x8*)(wl + 32 * s);
                acc = __builtin_amdgcn_mfma_f32_16x16x32_bf16(ah, bh, acc, 0, 0, 0);
                acc = __builtin_amdgcn_mfma_f32_16x16x32_bf16(ah, bl, acc, 0, 0, 0);
                acc = __builtin_amdgcn_mfma_f32_16x16x32_bf16(alo, bh, acc, 0, 0, 0);
            }
            const float db = P.dt_bias[l15];
#pragma unroll
            for (int rg = 0; rg < 4; ++rg) DT[(r0 + 4 * c4 + rg) * 16 + l15] = softplus_f(acc[rg] + db);
        }
    }
    SEAM(2);
    if (IN(3)) {
        pg8::Gemm g{HX, WIN, MT, PC, DM}; pg8::StaticOrder S_; S_.init(MT, PC, G, bid);
        EpiStoreBf16 E{PR, PC};
        pg8::gemm_phase<EpiStoreBf16, pg8::StaticOrder, true, true>(lds, g, S_, E);
        const int nwg = (MT / 256) * (PC / 256), extra = nwg % G;
        if (extra == 0 || bid >= extra) {
            const int nfill = extra == 0 ? G : G - extra, rank = extra == 0 ? bid : bid - extra;
            LAS float* scr = (LAS float*)(lds + wave * 16640);
            for (int it = CONV_N0 + wave * nfill + rank; it < CONV_N1; it += nfill * 8) conv_item(P, it, WIN, WOUT, WGU, WD, scr, lane);
        }
    }
    SEAM(3);
    if (IN(4)) {
        {
            const int sub = tid >> 8, t8 = tid & 255, cg8 = t8 & 7, jq = t8 >> 3;
            LAS unsigned char* T = lds + sub * 17408;
            for (int ip = bid; ip < NCH * 8; ip += G) {
                const int q = ip >> 3, cg = (ip & 7) * 2 + sub, r0 = chunk_row0(q), c0 = cg * 64 + cg8 * 8;
                int s0, sl;
                if (q < 128) { s0 = (q >> 6) * SEQ; sl = SEQ; } else { s0 = ML + ((q - 128) >> 1) * CTXL; sl = CTXL; }
                u32x4 xin[8];
#pragma unroll
                for (int w = 0; w < 8; ++w) { const int rr = r0 + 4 * jq + w - 2; xin[w] = (u32x4){0u, 0u, 0u, 0u};
                    if (rr >= s0 && rr < s0 + sl) xin[w] = *(const u32x4*)(PR + (size_t)rr * PC + C_XBC + c0); }
                f32x4 wlo[5], whi[5];
#pragma unroll
                for (int w = 0; w < 5; ++w) { wlo[w] = *(const f32x4*)(P.conv_w + w * 1024 + c0); whi[w] = *(const f32x4*)(P.conv_w + w * 1024 + c0 + 4); }
                const f32x4 b0 = *(const f32x4*)(P.conv_b + c0), b1 = *(const f32x4*)(P.conv_b + c0 + 4);
                __syncthreads();
                unsigned ow[4][4];
#pragma unroll
                for (int jr = 0; jr < 4; ++jr) {
                    float a[8] = {b0.x, b0.y, b0.z, b0.w, b1.x, b1.y, b1.z, b1.w};
#pragma unroll
                    for (int w = 0; w < 5; ++w) { const u32x4 xv = xin[jr + w];
                        a[0] += wlo[w].x * bflo(xv.x); a[1] += wlo[w].y * bfhi(xv.x); a[2] += wlo[w].z * bflo(xv.y); a[3] += wlo[w].w * bfhi(xv.y);
                        a[4] += whi[w].x * bflo(xv.z); a[5] += whi[w].y * bfhi(xv.z); a[6] += whi[w].z * bflo(xv.w); a[7] += whi[w].w * bfhi(xv.w); }
#pragma unroll
                    for (int i = 0; i < 4; ++i) ow[jr][i] = pg8::cvt_pk_bf16(silu_fast(a[2 * i]), silu_fast(a[2 * i + 1]));
                    *(u32x4*)(U + (size_t)(r0 + 4 * jq + jr) * 1024 + c0) = (u32x4){ow[jr][0], ow[jr][1], ow[jr][2], ow[jr][3]};
                }
                if (cg < 12) {
#pragma unroll
                    for (int i = 0; i < 8; ++i) {
                        const unsigned e0 = (i & 1) ? (ow[0][i >> 1] >> 16) : (ow[0][i >> 1] & 0xffffu), e1 = (i & 1) ? (ow[1][i >> 1] >> 16) : (ow[1][i >> 1] & 0xffffu);
                        const unsigned e2 = (i & 1) ? (ow[2][i >> 1] >> 16) : (ow[2][i >> 1] & 0xffffu), e3 = (i & 1) ? (ow[3][i >> 1] >> 16) : (ow[3][i >> 1] & 0xffffu);
                        *(LAS u32x2*)(T + (cg8 * 8 + i) * 272 + jq * 8) = (u32x2){e0 | (e1 << 16), e2 | (e3 << 16)};
                    }
                }
                __syncthreads();
                if (cg < 12) {
                    bf16* dst = cg < 8 ? XST + ((size_t)q * 512 + cg * 64) * 128 : BT + ((size_t)q * 256 + (cg - 8) * 64) * 128;
#pragma unroll
                    for (int hh = 0; hh < 4; ++hh) { const int pc = t8 + 256 * hh, row = pc >> 4, ch = pc & 15; const u32x4 v = *(const LAS u32x4*)(T + row * 272 + ch * 16); *(u32x4*)(dst + (size_t)row * 128 + ch * 8) = v; }
                }
            }
            __syncthreads();
        }
        for (int idx = gtid; idx < MT * 8; idx += NT) {
            const int r = idx >> 3, kvh = (idx >> 2) & 1, d0 = (idx & 3) * 8;
            const u32x4 ka = *(const u32x4*)(PR + (size_t)r * PC + C_K + kvh * 64 + d0), kb = *(const u32x4*)(PR + (size_t)r * PC + C_K + kvh * 64 + 32 + d0);
            u32x4 oa = ka, ob = kb;
            if (r < ML) {
                const int pos = r % SEQ;
                const f32x4 c0 = *(const f32x4*)(ROPEC + pos * 32 + d0), c1 = *(const f32x4*)(ROPEC + pos * 32 + d0 + 4), s0_ = *(const f32x4*)(ROPES + pos * 32 + d0), s1_ = *(const f32x4*)(ROPES + pos * 32 + d0 + 4);
                const float cs[8] = {c0.x, c0.y, c0.z, c0.w, c1.x, c1.y, c1.z, c1.w}, sn[8] = {s0_.x, s0_.y, s0_.z, s0_.w, s1_.x, s1_.y, s1_.z, s1_.w};
                const unsigned kaw[4] = {ka.x, ka.y, ka.z, ka.w}, kbw[4] = {kb.x, kb.y, kb.z, kb.w};
                unsigned oaw[4], obw[4];
#pragma unroll
                for (int i = 0; i < 4; ++i) {
                    const float a0 = bflo(kaw[i]), a1 = bfhi(kaw[i]), b0 = bflo(kbw[i]), b1 = bfhi(kbw[i]);
                    oaw[i] = pk2(a0 * cs[2 * i] - b0 * sn[2 * i], a1 * cs[2 * i + 1] - b1 * sn[2 * i + 1]);
                    obw[i] = pk2(b0 * cs[2 * i] + a0 * sn[2 * i], b1 * cs[2 * i + 1] + a1 * sn[2 * i + 1]);
                }
                oa = (u32x4){oaw[0], oaw[1], oaw[2], oaw[3]}; ob = (u32x4){obw[0], obw[1], obw[2], obw[3]};
            }
            *(u32x4*)(KR + (size_t)r * 128 + kvh * 64 + d0) = oa; *(u32x4*)(KR + (size_t)r * 128 + kvh * 64 + 32 + d0) = ob;
        }
        for (int sidx = wave * G + bid; sidx < NCH * 16; sidx += NGW) {
            const int q = sidx >> 4, dh = sidx & 15, dir = dh >> 3;
            const int r0 = chunk_row0(q);
            const float A = -expf(P.a_log[dh]);
            const int i0 = dir == 0 ? 2 * lane : 127 - 2 * lane, i1 = dir == 0 ? 2 * lane + 1 : 126 - 2 * lane;
            const float v0 = DT[(r0 + i0) * 16 + dh] * A, v1 = DT[(r0 + i1) * 16 + dh] * A;
            float incl = v0 + v1;
#pragma unroll
            for (int o = 1; o < 64; o <<= 1) { const float t = __shfl_up(incl, o); if (lane >= o) incl += t; }
            const float excl = incl - (v0 + v1);
            ACS[(q * 16 + dh) * 128 + i0] = excl + v0; ACS[(q * 16 + dh) * 128 + i1] = incl;
            if (lane == 63) AL[q * 16 + dh] = incl;
        }
    }
    SEAM(4);
    if (IN(5)) {
        typedef short s16x8 __attribute__((ext_vector_type(8)));
        const int l15 = lane & 15, l4 = lane >> 4;
        LAS float* wv = (LAS float*)lds + wave * 128;
        for (int un_ = bid; un_ < NCH * 4; un_ += G) {
            const int un = (G == 256) ? (((((un_ & 7) | (((un_ & 255) >> 4) << 3)) + 128 * (un_ >> 8)) << 1) | ((un_ >> 3) & 1)) : un_;
            if (un >= NCH * 4) continue;
            const int q = un >> 2, g = (un >> 1) & 1, nh = un & 1, head = g * 4 + (wave & 3), dh = (wave >> 2) * 8 + head, r0 = chunk_row0(q);
            const bf16* bt = BT + ((size_t)q * 256 + g * 128 + nh * 64 + l15) * 128 + 8 * l4;
            const bf16* xt = XST + ((size_t)q * 512 + head * 64 + l15) * 128 + 8 * l4;
            {   const float al = AL[q * 16 + dh];
#pragma unroll
                for (int hh = 0; hh < 2; ++hh) { const int j = lane + 64 * hh; wv[j] = __expf(al - ACS[(q * 16 + dh) * 128 + j]) * DT[(r0 + j) * 16 + dh]; } }
            pg8::f32x4 acc[4][4];
#pragma unroll
            for (int a = 0; a < 4; ++a)
#pragma unroll
                for (int b_ = 0; b_ < 4; ++b_) acc[a][b_] = (pg8::f32x4){0.f, 0.f, 0.f, 0.f};
            __builtin_amdgcn_wave_barrier();
#pragma unroll 1
            for (int kp = 0; kp < 2; ++kp) {
                s16x8 bfr[2][4]; u32x4 xraw[2][4];
#pragma unroll
                for (int k2 = 0; k2 < 2; ++k2)
#pragma unroll
                    for (int t4 = 0; t4 < 4; ++t4) { bfr[k2][t4] = *(const s16x8*)(bt + (size_t)t4 * 16 * 128 + 32 * (2 * kp + k2)); xraw[k2][t4] = *(const u32x4*)(xt + (size_t)t4 * 16 * 128 + 32 * (2 * kp + k2)); }
#pragma unroll
                for (int k2 = 0; k2 < 2; ++k2) {
                    const int ks = 2 * kp + k2;
                    const pg8::f32x4 w0 = *(const LAS pg8::f32x4*)(wv + 32 * ks + 8 * l4), w1 = *(const LAS pg8::f32x4*)(wv + 32 * ks + 8 * l4 + 4);
#pragma unroll
                    for (int pt = 0; pt < 4; ++pt) {
                        const u32x4 raw = xraw[k2][pt];
                        u32x4 o; o.x = pg8::cvt_pk_bf16(bflo(raw.x) * w0[0], bfhi(raw.x) * w0[1]); o.y = pg8::cvt_pk_bf16(bflo(raw.y) * w0[2], bfhi(raw.y) * w0[3]);
                        o.z = pg8::cvt_pk_bf16(bflo(raw.z) * w1[0], bfhi(raw.z) * w1[1]); o.w = pg8::cvt_pk_bf16(bflo(raw.w) * w1[2], bfhi(raw.w) * w1[3]);
                        const s16x8 xf = __builtin_bit_cast(s16x8, o);
#pragma unroll
                        for (int nt = 0; nt < 4; ++nt) acc[nt][pt] = __builtin_amdgcn_mfma_f32_16x16x32_bf16(bfr[k2][nt], xf, acc[nt][pt], 0, 0, 0);
                    }
                }
            }
            __builtin_amdgcn_wave_barrier();
            bf16* so = S + ((size_t)q * 16 + dh) * 8192 + nh * 64;
#pragma unroll
            for (int nt = 0; nt < 4; ++nt)
#pragma unroll
                for (int pt = 0; pt < 4; ++pt) { u32x2 w; w.x = pg8::cvt_pk_bf16(acc[nt][pt][0], acc[nt][pt][1]); w.y = pg8::cvt_pk_bf16(acc[nt][pt][2], acc[nt][pt][3]);
                    *(u32x2*)(so + (size_t)(16 * pt + l15) * 128 + 16 * nt + 4 * l4) = w; }
        }
    }
    SEAM(5);
    if (IN(6)) {
        for (int idx = gtid; idx < NB * 16 * 2048; idx += NT) {
            const int pn = (idx & 2047) * 4, dh = (idx >> 11) & 15, b = idx >> 15, dir = dh >> 3;
            const int qa = dir == 0 ? 128 + 2 * b : 129 + 2 * b, qb = dir == 0 ? 129 + 2 * b : 128 + 2 * b;
            float h[4];
            {   const u32x2 sa = *(const u32x2*)(S + ((size_t)qa * 16 + dh) * 8192 + pn), sb = *(const u32x2*)(S + ((size_t)qb * 16 + dh) * 8192 + pn);
                const float e = __expf(AL[qb * 16 + dh]);
                h[0] = e * bflo(sa.x) + bflo(sb.x); h[1] = e * bfhi(sa.x) + bfhi(sb.x); h[2] = e * bflo(sa.y) + bflo(sb.y); h[3] = e * bfhi(sa.y) + bfhi(sb.y); }
            for (int c8 = 0; c8 < 64; c8 += 8) {
                u32x2 t[8]; float e[8];
#pragma unroll
                for (int k = 0; k < 8; ++k) { const int q = 64 * b + (dir == 0 ? c8 + k : 63 - c8 - k); t[k] = *(const u32x2*)(S + ((size_t)q * 16 + dh) * 8192 + pn); e[k] = __expf(AL[q * 16 + dh]); }
#pragma unroll
                for (int k = 0; k < 8; ++k) { const int q = 64 * b + (dir == 0 ? c8 + k : 63 - c8 - k);
                    u32x2 o; o.x = pk2(h[0], h[1]); o.y = pk2(h[2], h[3]);
                    *(u32x2*)(S + ((size_t)q * 16 + dh) * 8192 + pn) = o;
                    h[0] = e[k] * h[0] + bflo(t[k].x); h[1] = e[k] * h[1] + bfhi(t[k].x); h[2] = e[k] * h[2] + bflo(t[k].y); h[3] = e[k] * h[3] + bfhi(t[k].y); }
            }
        }
    }
    SEAM(6);
    if (IN(7)) {
        {
            typedef short s16x8 __attribute__((ext_vector_type(8)));
            constexpr int CBP = 132;
            LAS float* CBs = (LAS float*)lds;
            LAS float* vec = (LAS float*)(lds + 69632) + wave * 512;
            LAS float* red = (LAS float*)(lds + 86016);
            const int l15 = lane & 15, l4 = lane >> 4;
            for (int un_ = bid; un_ < 256; un_ += G) {
                const int un = (G == 256) ? ((((un_ & 7) | ((un_ >> 4) << 3)) << 1) | ((un_ >> 3) & 1)) : un_;
                const int q = un >> 1, i0 = (un & 1) * 64, r0 = q * 128;
                __syncthreads();
                {
                    const int g = wave >> 2, it = wave & 3;
                    pg8::f32x4 cacc[8];
#pragma unroll
                    for (int a = 0; a < 8; ++a) cacc[a] = (pg8::f32x4){0.f, 0.f, 0.f, 0.f};
                    const bf16* cp = U + (size_t)(r0 + i0 + 16 * it + l15) * 1024 + 768 + g * 128 + 8 * l4;
                    const bf16* bp = U + (size_t)(r0 + l15) * 1024 + 512 + g * 128 + 8 * l4;
#pragma unroll
                    for (int ks = 0; ks < 4; ++ks) {
                        const s16x8 af = *(const s16x8*)(cp + 32 * ks);
#pragma unroll
                        for (int jt = 0; jt < 8; ++jt) { const s16x8 bf = *(const s16x8*)(bp + (size_t)jt * 16 * 1024 + 32 * ks); cacc[jt] = __builtin_amdgcn_mfma_f32_16x16x32_bf16(af, bf, cacc[jt], 0, 0, 0); }
                    }
#pragma unroll
                    for (int jt = 0; jt < 8; ++jt)
#pragma unroll
                        for (int rg = 0; rg < 4; ++rg) CBs[(g * 64 + 16 * it + 4 * l4 + rg) * CBP + 16 * jt + l15] = cacc[jt][rg];
                }
                const int head = wave, g = head >> 2;
                {
#pragma unroll
                    for (int hh = 0; hh < 2; ++hh) { const int j = lane + 64 * hh;
                        vec[j] = ACS[(q * 16 + head) * 128 + j]; vec[128 + j] = ACS[(q * 16 + 8 + head) * 128 + j];
                        vec[256 + j] = DT[(r0 + j) * 16 + head]; vec[384 + j] = DT[(r0 + j) * 16 + 8 + head]; }
                }
                __builtin_amdgcn_wave_barrier();
                pg8::f32x4 acc[4][4];
#pragma unroll
                for (int a = 0; a < 4; ++a)
#pragma unroll
                    for (int b_ = 0; b_ < 4; ++b_) acc[a][b_] = (pg8::f32x4){0.f, 0.f, 0.f, 0.f};
                const bf16* xt = XST + ((size_t)q * 512 + head * 64 + l15) * 128 + 8 * l4;
#pragma unroll 1
                for (int dir = 0; dir < 2; ++dir) {
                    const int dh = dir * 8 + head;
                    const bf16* hp = S + ((size_t)q * 16 + dh) * 8192 + (size_t)l15 * 128 + 8 * l4;
                    float sc_[4];
#pragma unroll
                    for (int it = 0; it < 4; ++it) sc_[it] = __expf(vec[dir * 128 + i0 + 16 * it + l15]);
#pragma unroll 1
                    for (int kp = 0; kp < 2; ++kp) {
                        s16x8 hf[2][4]; u32x4 craw[2][4];
#pragma unroll
                        for (int k2 = 0; k2 < 2; ++k2)
#pragma unroll
                            for (int t4 = 0; t4 < 4; ++t4) { hf[k2][t4] = *(const s16x8*)(hp + (size_t)t4 * 16 * 128 + 32 * (2 * kp + k2));
                                craw[k2][t4] = *(const u32x4*)(U + (size_t)(r0 + i0 + 16 * t4 + l15) * 1024 + 768 + g * 128 + 32 * (2 * kp + k2) + 8 * l4); }
#pragma unroll
                        for (int k2 = 0; k2 < 2; ++k2)
#pragma unroll
                            for (int it = 0; it < 4; ++it) {
                                const u32x4 raw = craw[k2][it]; const float s_ = sc_[it];
                                const s16x8 cf = __builtin_bit_cast(s16x8, (u32x4){pg8::cvt_pk_bf16(bflo(raw.x) * s_, bfhi(raw.x) * s_), pg8::cvt_pk_bf16(bflo(raw.y) * s_, bfhi(raw.y) * s_),
                                                                                  pg8::cvt_pk_bf16(bflo(raw.z) * s_, bfhi(raw.z) * s_), pg8::cvt_pk_bf16(bflo(raw.w) * s_, bfhi(raw.w) * s_)});
#pragma unroll
                                for (int pt = 0; pt < 4; ++pt) acc[it][pt] = __builtin_amdgcn_mfma_f32_16x16x32_bf16(hf[k2][pt], cf, acc[it][pt], 0, 0, 0);
                            }
                    }
                }
                __syncthreads();
                const float dsk = P.d_skip[head];
                u32x2 exv[4][4], ezv[4][4];
#pragma unroll
                for (int it = 0; it < 4; ++it)
#pragma unroll
                    for (int pt = 0; pt < 4; ++pt) { const int row = r0 + i0 + 16 * it + l15, ch0 = head * 64 + 16 * pt + 4 * l4;
                        exv[it][pt] = *(const u32x2*)(U + (size_t)row * 1024 + ch0); ezv[it][pt] = *(const u32x2*)(PR + (size_t)row * PC + C_Z + ch0); }
#pragma unroll 2
                for (int ks = 0; ks < 4; ++ks) {
                    s16x8 xf[4];
#pragma unroll
                    for (int pt = 0; pt < 4; ++pt) xf[pt] = *(const s16x8*)(xt + (size_t)pt * 16 * 128 + 32 * ks);
                    const int j0 = 32 * ks + 8 * l4;
                    float afj[8], abj[8], dfj[8], dbj[8];
#pragma unroll
                    for (int i = 0; i < 8; ++i) { afj[i] = vec[j0 + i]; abj[i] = vec[128 + j0 + i]; dfj[i] = vec[256 + j0 + i]; dbj[i] = vec[384 + j0 + i]; }
#pragma unroll
                    for (int it = 0; it < 4; ++it) {
                        const int i = i0 + 16 * it + l15;
                        const float afi = vec[i], abi = vec[128 + i];
                        const LAS float* cbp = CBs + (g * 64 + 16 * it + l15) * CBP + j0;
                        const pg8::f32x4 c0 = *(const LAS pg8::f32x4*)cbp, c1 = *(const LAS pg8::f32x4*)(cbp + 4);
                        const float cv[8] = {c0[0], c0[1], c0[2], c0[3], c1[0], c1[1], c1[2], c1[3]};
                        float lv[8];
#pragma unroll
                        for (int jj = 0; jj < 8; ++jj) { const int j = j0 + jj;
                            const float tf = j <= i ? __expf(afi - afj[jj]) * dfj[jj] : 0.f;
                            const float tb = j >= i ? __expf(abi - abj[jj]) * dbj[jj] : 0.f;
                            lv[jj] = cv[jj] * (tf + tb); }
                        const s16x8 lf = __builtin_bit_cast(s16x8, (u32x4){pg8::cvt_pk_bf16(lv[0], lv[1]), pg8::cvt_pk_bf16(lv[2], lv[3]), pg8::cvt_pk_bf16(lv[4], lv[5]), pg8::cvt_pk_bf16(lv[6], lv[7])});
#pragma unroll
                        for (int pt = 0; pt < 4; ++pt) acc[it][pt] = __builtin_amdgcn_mfma_f32_16x16x32_bf16(xf[pt], lf, acc[it][pt], 0, 0, 0);
                    }
                }
                float ssq[4];
#pragma unroll
                for (int it = 0; it < 4; ++it) {
                    const int row = r0 + i0 + 16 * it + l15;
                    float s_ = 0.f;
#pragma unroll
                    for (int pt = 0; pt < 4; ++pt) {
                        const int ch0 = head * 64 + 16 * pt + 4 * l4;
                        const u32x2 xv = exv[it][pt], zv = ezv[it][pt];
                        const float xs[4] = {bflo(xv.x), bfhi(xv.x), bflo(xv.y), bfhi(xv.y)}, zs[4] = {bflo(zv.x), bfhi(zv.x), bflo(zv.y), bfhi(zv.y)};
#pragma unroll
                        for (int rg = 0; rg < 4; ++rg) { float y = acc[it][pt][rg] + dsk * xs[rg]; y *= silu_fast(zs[rg]); acc[it][pt][rg] = y; s_ += y * y; }
                    }
                    s_ += __shfl_xor(s_, 16); s_ += __shfl_xor(s_, 32);
                    ssq[it] = s_;
                }
                if (l4 == 0) {
#pragma unroll
                    for (int it = 0; it < 4; ++it) red[wave * 64 + 16 * it + l15] = ssq[it];
                }
                __syncthreads();
#pragma unroll
                for (int it = 0; it < 4; ++it) {
                    const int il = 16 * it + l15, row = r0 + i0 + il;
                    float tot = 0.f;
#pragma unroll
                    for (int w = 0; w < 8; ++w) tot += red[w * 64 + il];
                    const float rstd = rsqrtf(tot * (1.f / 512.f) + EPS);
#pragma unroll
                    for (int pt = 0; pt < 4; ++pt) { const int ch0 = head * 64 + 16 * pt + 4 * l4; const f32x4 gn = *(const f32x4*)(P.ssd_norm + ch0);
                        u32x2 o; o.x = pg8::cvt_pk_bf16(acc[it][pt][0] * rstd * gn.x, acc[it][pt][1] * rstd * gn.y); o.y = pg8::cvt_pk_bf16(acc[it][pt][2] * rstd * gn.z, acc[it][pt][3] * rstd * gn.w);
                        *(u32x2*)(MIX + (size_t)row * 1024 + ch0) = o; }
                }
            }
            __syncthreads();
        }
        {
            typedef float f32x16 __attribute__((ext_vector_type(16)));
            typedef short s16x8 __attribute__((ext_vector_type(8)));
            typedef short s16x4 __attribute__((ext_vector_type(4)));
            const int r32 = lane & 31, hi_ = lane >> 5;
            LAS unsigned char* KV = lds;
            LAS float* wsf = (LAS float*)(lds + 32768) + wave * 64;
            const float C2 = 0.125f * 1.4426950408889634f;
            const int vboff = ((lane >> 4) & 1) * 32 + (lane & 3) * 8 + (4 * hi_ + ((lane & 15) >> 2)) * 64;
            for (int L_ = bid; L_ < 512; L_ += G) {
                int pair = L_ & 1, kvh = (L_ >> 1) & 1, nb = (L_ >> 2) & 63, b = L_ >> 8;
                if (G == 256) { const int r_ = (L_ & 255) >> 3, pg_ = (((L_ >> 8) * 8 + (L_ & 7)) * 16) + (r_ >> 1); pair = r_ & 1; nb = pg_ & 63; kvh = (pg_ >> 6) & 1; b = pg_ >> 7; }
                const int hq = kvh * 4 + pair * 2 + (wave >> 2), qq = (wave & 3) * 32 + r32;
                const int qrow = b * SEQ + nb * 128 + qq, pos = nb * 128 + qq;
                s16x8 qr[4];
                {
                    const bf16* qp = PR + (size_t)qrow * PC + C_Q + hq * 64 + 8 * hi_;
                    u32x4 raw[4];
#pragma unroll
                    for (int d0 = 0; d0 < 4; ++d0) raw[d0] = *(const u32x4*)(qp + 16 * d0);
#pragma unroll
                    for (int dd = 0; dd < 2; ++dd) {
                        const float* cp = ROPEC + pos * 32 + 16 * dd + 8 * hi_; const float* sp = ROPES + pos * 32 + 16 * dd + 8 * hi_;
                        const f32x4 c0 = *(const f32x4*)cp, c1 = *(const f32x4*)(cp + 4), s0_ = *(const f32x4*)sp, s1_ = *(const f32x4*)(sp + 4);
                        const float cs[8] = {c0.x, c0.y, c0.z, c0.w, c1.x, c1.y, c1.z, c1.w}, sn[8] = {s0_.x, s0_.y, s0_.z, s0_.w, s1_.x, s1_.y, s1_.z, s1_.w};
                        const unsigned aw[4] = {raw[dd].x, raw[dd].y, raw[dd].z, raw[dd].w}, bw[4] = {raw[dd + 2].x, raw[dd + 2].y, raw[dd + 2].z, raw[dd + 2].w};
                        unsigned oa[4], ob[4];
#pragma unroll
                        for (int i = 0; i < 4; ++i) {
                            const float a0 = bflo(aw[i]), a1 = bfhi(aw[i]), b0 = bflo(bw[i]), b1 = bfhi(bw[i]);
                            oa[i] = pk2((a0 * cs[2 * i] - b0 * sn[2 * i]) * C2, (a1 * cs[2 * i + 1] - b1 * sn[2 * i + 1]) * C2);
                            ob[i] = pk2((b0 * cs[2 * i] + a0 * sn[2 * i]) * C2, (b1 * cs[2 * i + 1] + a1 * sn[2 * i + 1]) * C2);
                        }
                        qr[dd] = __builtin_bit_cast(s16x8, (u32x4){oa[0], oa[1], oa[2], oa[3]});
                        qr[dd + 2] = __builtin_bit_cast(s16x8, (u32x4){ob[0], ob[1], ob[2], ob[3]});
                    }
                }
                f32x16 o0 = {0.f}, o1 = {0.f};
#pragma unroll
                for (int r = 0; r < 16; ++r) { o0[r] = 0.f; o1[r] = 0.f; }
                float m_run = 0.f, l_run = 0.f; bool first = true;
                f32x16 negm;
#pragma unroll
                for (int r = 0; r < 16; ++r) negm[r] = 0.f;
                const int tfirst = 0;
                auto tile_row0 = [&](int t) -> int { return t < 4 ? ML + b * CTXL + 64 * t : b * SEQ + (nb - 1) * 128 + 64 * (t - 4); };
                auto tile_ok = [&](int t) -> bool { return !((nb == 0 && (t == 4 || t == 5)) || (nb == 63 && (t == 8 || t == 9))); };
                u32x4 kreg, vreg;
                {
                    const int row0 = tile_row0(tfirst);
                    kreg = *(const u32x4*)(KR + (size_t)(row0 + lane) * 128 + kvh * 64 + wave * 8);
                    vreg = *(const u32x4*)(PR + (size_t)(row0 + 16 * (wave & 3) + (lane >> 2)) * PC + C_V + kvh * 64 + (wave >> 2) * 32 + (lane & 3) * 8);
                }
                auto tile_next = [&](int t) -> int { int tn = t + 1; while (tn < 10 && !tile_ok(tn)) ++tn; return tn; };
                auto tile_load = [&](int t) { const int row0 = tile_row0(t);
                    kreg = *(const u32x4*)(KR + (size_t)(row0 + lane) * 128 + kvh * 64 + wave * 8);
                    vreg = *(const u32x4*)(PR + (size_t)(row0 + 16 * (wave & 3) + (lane >> 2)) * PC + C_V + kvh * 64 + (wave >> 2) * 32 + (lane & 3) * 8); };
                int cur = 0;
                __syncthreads();
                *(LAS u32x4*)(KV + wave * 1024 + lane * 16) = kreg; *(LAS u32x4*)(KV + 8192 + wave * 1024 + lane * 16) = vreg;
                { const int t1 = tile_next(0); if (t1 < 10) tile_load(t1); }
                __syncthreads();
                for (int t = 0; t < 10; t = tile_next(t)) {
                    LAS unsigned char* Kb = KV + cur * 16384; LAS unsigned char* Vb = Kb + 8192;
                    const int tn = tile_next(t);
                    if (tn < 10) {
                        LAS unsigned char* Kn = KV + (cur ^ 1) * 16384;
                        *(LAS u32x4*)(Kn + wave * 1024 + lane * 16) = kreg; *(LAS u32x4*)(Kn + 8192 + wave * 1024 + lane * 16) = vreg;
                        const int t2 = tile_next(tn); if (t2 < 10) tile_load(t2);
                    }
                    f32x16 p0, p1;
                    {   const s16x8 b0 = *(const LAS s16x8*)(Kb + hi_ * 1024 + r32 * 16), b1 = *(const LAS s16x8*)(Kb + hi_ * 1024 + r32 * 16 + 512);
                        p0 = __builtin_amdgcn_mfma_f32_32x32x16_bf16(b0, qr[0], negm, 0, 0, 0);
                        p1 = __builtin_amdgcn_mfma_f32_32x32x16_bf16(b1, qr[0], negm, 0, 0, 0); }
#pragma unroll
                    for (int d0 = 1; d0 < 4; ++d0) {
                        const s16x8 b0 = *(const LAS s16x8*)(Kb + d0 * 2048 + hi_ * 1024 + r32 * 16);
                        const s16x8 b1 = *(const LAS s16x8*)(Kb + d0 * 2048 + hi_ * 1024 + r32 * 16 + 512);
                        p0 = __builtin_amdgcn_mfma_f32_32x32x16_bf16(b0, qr[d0], p0, 0, 0, 0);
                        p1 = __builtin_amdgcn_mfma_f32_32x32x16_bf16(b1, qr[d0], p1, 0, 0, 0);
                    }
                    if (__builtin_amdgcn_readfirstlane(t) == 4 || __builtin_amdgcn_readfirstlane(t) == 5) {
                        asm volatile("" ::: "memory");
                        const int kb0 = 64 * (t - 4) + 4 * hi_;
#pragma unroll
                        for (int r = 0; r < 16; ++r) { const int kk = kb0 + (r & 3) + 8 * (r >> 2); if (kk < qq) p0[r] = -INFINITY; if (kk + 32 < qq) p1[r] = -INFINITY; }
                    } else if (__builtin_amdgcn_readfirstlane(t) >= 8) {
                        asm volatile("" ::: "memory");
                        const int kb0 = 64 * (t - 8) + 4 * hi_;
#pragma unroll
                        for (int r = 0; r < 16; ++r) { const int kk = kb0 + (r & 3) + 8 * (r >> 2); if (kk > qq) p0[r] = -INFINITY; if (kk + 32 > qq) p1[r] = -INFINITY; }
                    }
                    float mx = fmaxf(p0[0], p1[0]);
#pragma unroll
                    for (int r = 1; r < 16; ++r) mx = fmaxf(mx, fmaxf(p0[r], p1[r]));
                    mx = fmaxf(mx, __shfl_xor(mx, 32));
                    if (__any(mx > (first ? -INFINITY : 8.0f))) {
                        asm volatile("" ::: "memory");
                        const float dl = first ? mx : fmaxf(mx, 0.f);
                        m_run += dl;
#pragma unroll
                        for (int r = 0; r < 16; ++r) { p0[r] -= dl; p1[r] -= dl; negm[r] = -m_run; }
                        const float f = __builtin_amdgcn_exp2f(-dl);
                        l_run *= f;
                        if (!first) {
                            if (hi_ == 0) wsf[r32] = f;
                            __builtin_amdgcn_wave_barrier();
#pragma unroll
                            for (int r = 0; r < 16; ++r) { const float a = wsf[(r & 3) + 8 * (r >> 2) + 4 * hi_]; o0[r] *= a; o1[r] *= a; }
                            __builtin_amdgcn_wave_barrier();
                        }
                        first = false;
                    }
                    float rs = 0.f;
#pragma unroll
                    for (int r = 0; r < 16; ++r) { p0[r] = __builtin_amdgcn_exp2f(p0[r]); p1[r] = __builtin_amdgcn_exp2f(p1[r]); rs += p0[r] + p1[r]; }
                    l_run += rs;
                    s16x8 pa[4];
                    pa[0] = __builtin_bit_cast(s16x8, (u32x4){pg8::cvt_pk_bf16(p0[0], p0[1]), pg8::cvt_pk_bf16(p0[2], p0[3]), pg8::cvt_pk_bf16(p0[4], p0[5]), pg8::cvt_pk_bf16(p0[6], p0[7])});
                    pa[1] = __builtin_bit_cast(s16x8, (u32x4){pg8::cvt_pk_bf16(p0[8], p0[9]), pg8::cvt_pk_bf16(p0[10], p0[11]), pg8::cvt_pk_bf16(p0[12], p0[13]), pg8::cvt_pk_bf16(p0[14], p0[15])});
                    pa[2] = __builtin_bit_cast(s16x8, (u32x4){pg8::cvt_pk_bf16(p1[0], p1[1]), pg8::cvt_pk_bf16(p1[2], p1[3]), pg8::cvt_pk_bf16(p1[4], p1[5]), pg8::cvt_pk_bf16(p1[6], p1[7])});
                    pa[3] = __builtin_bit_cast(s16x8, (u32x4){pg8::cvt_pk_bf16(p1[8], p1[9]), pg8::cvt_pk_bf16(p1[10], p1[11]), pg8::cvt_pk_bf16(p1[12], p1[13]), pg8::cvt_pk_bf16(p1[14], p1[15])});
#pragma unroll
                    for (int ks = 0; ks < 4; ++ks) {
                        typedef short v4i16_t __attribute__((ext_vector_type(4)));
                        const s16x4 l0 = __builtin_bit_cast(s16x4, __builtin_amdgcn_ds_read_tr16_b64_v4i16((LAS v4i16_t*)(Vb + vboff + ks * 1024)));
                        const s16x4 h0 = __builtin_bit_cast(s16x4, __builtin_amdgcn_ds_read_tr16_b64_v4i16((LAS v4i16_t*)(Vb + vboff + ks * 1024 + 512)));
                        const s16x4 l1 = __builtin_bit_cast(s16x4, __builtin_amdgcn_ds_read_tr16_b64_v4i16((LAS v4i16_t*)(Vb + vboff + 4096 + ks * 1024)));
                        const s16x4 h1 = __builtin_bit_cast(s16x4, __builtin_amdgcn_ds_read_tr16_b64_v4i16((LAS v4i16_t*)(Vb + vboff + 4096 + ks * 1024 + 512)));
                        const s16x8 v0 = (s16x8){l0[0], l0[1], l0[2], l0[3], h0[0], h0[1], h0[2], h0[3]}, v1 = (s16x8){l1[0], l1[1], l1[2], l1[3], h1[0], h1[1], h1[2], h1[3]};
                        o0 = __builtin_amdgcn_mfma_f32_32x32x16_bf16(pa[ks], v0, o0, 0, 0, 0);
                        o1 = __builtin_amdgcn_mfma_f32_32x32x16_bf16(pa[ks], v1, o1, 0, 0, 0);
                    }
                    __syncthreads();
                    cur ^= 1;
                }
                float l_tot = l_run + __shfl_xor(l_run, 32);
                l_tot += __builtin_amdgcn_exp2f(P.sinks[hq] * 1.4426950408889634f - m_run);
                if (hi_ == 0) wsf[r32] = 1.0f / l_tot;
                __builtin_amdgcn_wave_barrier();
                bf16* orow = MIX + (size_t)(b * SEQ + nb * 128 + (wave & 3) * 32) * 1024 + 512 + hq * 64 + r32;
#pragma unroll
                for (int r = 0; r < 16; ++r) { const int qi = (r & 3) + 8 * (r >> 2) + 4 * hi_; const float inv = wsf[qi];
                    orow[(size_t)qi * 1024] = (bf16)f2bf(o0[r] * inv); orow[(size_t)qi * 1024 + 32] = (bf16)f2bf(o1[r] * inv); }
                __builtin_amdgcn_wave_barrier();
            }
        }
    }
    SEAM(7);
    if (IN(8)) {
        pg8::Gemm g{MIX, WOUT, ML, DM, DM}; pg8::StaticOrder S_; S_.init(ML, DM, G, bid);
        EpiOutProj E{P.x, MOD, X1, SSQP};
        pg8::gemm_phase<EpiOutProj, pg8::StaticOrder, false, true>(lds, g, S_, E);
    }
    SEAM(8);
    if (IN(9)) {
        typedef short s16x8 __attribute__((ext_vector_type(8)));
        const int l15 = lane & 15, c4 = lane >> 4, sl = wave & 3, kh = wave >> 2;
        LAS float* lgs = (LAS float*)lds + (sl * 2 + kh) * 832;
        for (int tb = bid; tb * 4 < ML / 16; tb += G) {
            const int task = tb * 4 + sl, r0 = task * 16, b = r0 / SEQ;
            float rstd;
            {   const float* sp = SSQP + (size_t)(r0 + l15) * 16; const f32x4 a0 = *(const f32x4*)sp, a1 = *(const f32x4*)(sp + 4), a2 = *(const f32x4*)(sp + 8), a3 = *(const f32x4*)(sp + 12);
                const float t = (((a0.x + a0.y) + (a0.z + a0.w)) + ((a1.x + a1.y) + (a1.z + a1.w))) + (((a2.x + a2.y) + (a2.z + a2.w)) + ((a3.x + a3.y) + (a3.z + a3.w)));
                rstd = rsqrtf(t * (1.f / DM) + EPS); }
            const int k0 = kh * 512 + 8 * c4;
            const bf16* xr = X1 + (size_t)(r0 + l15) * DM + k0;
            bf16* ho = H2 + (size_t)(r0 + l15) * DM + k0;
            const float* fv = FV + b * 1024 + k0; const float* shv = MOD + b * 6144 + 3072 + k0;
            const bf16* wh = WRH + (size_t)l15 * 1024 + k0; const bf16* wl = WRL + (size_t)l15 * 1024 + k0;
            pg8::f32x4 acc[3];
#pragma unroll
            for (int a = 0; a < 3; ++a) acc[a] = (pg8::f32x4){0.f, 0.f, 0.f, 0.f};
#pragma unroll 4
            for (int s = 0; s < 16; ++s) {
                const u32x4 xw = *(const u32x4*)(xr + 32 * s);
                const f32x4 xa = {bflo(xw.x), bfhi(xw.x), bflo(xw.y), bfhi(xw.y)}, xb = {bflo(xw.z), bfhi(xw.z), bflo(xw.w), bfhi(xw.w)};
                const f32x4 fa = *(const f32x4*)(fv + 32 * s), fb = *(const f32x4*)(fv + 32 * s + 4), sa = *(const f32x4*)(shv + 32 * s), sb = *(const f32x4*)(shv + 32 * s + 4);
                const float h0 = xa.x * rstd * fa.x + sa.x, h1 = xa.y * rstd * fa.y + sa.y, h2_ = xa.z * rstd * fa.z + sa.z, h3 = xa.w * rstd * fa.w + sa.w;
                const float h4 = xb.x * rstd * fb.x + sb.x, h5 = xb.y * rstd * fb.y + sb.y, h6 = xb.z * rstd * fb.z + sb.z, h7 = xb.w * rstd * fb.w + sb.w;
                const u32x4 hw = {pg8::cvt_pk_bf16(h0, h1), pg8::cvt_pk_bf16(h2_, h3), pg8::cvt_pk_bf16(h4, h5), pg8::cvt_pk_bf16(h6, h7)};
                *(u32x4*)(ho + 32 * s) = hw;
                const u32x4 lw = {pg8::cvt_pk_bf16(h0 - bflo(hw.x), h1 - bfhi(hw.x)), pg8::cvt_pk_bf16(h2_ - bflo(hw.y), h3 - bfhi(hw.y)),
                                  pg8::cvt_pk_bf16(h4 - bflo(hw.z), h5 - bfhi(hw.z)), pg8::cvt_pk_bf16(h6 - bflo(hw.w), h7 - bfhi(hw.w))};
                const s16x8 ah = __builtin_bit_cast(s16x8, hw), alo = __builtin_bit_cast(s16x8, lw);
#pragma unroll
                for (int nt = 0; nt < 3; ++nt) {
                    const s16x8 bh = *(const s16x8*)(wh + (size_t)nt * 16 * 1024 + 32 * s), bl = *(const s16x8*)(wl + (size_t)nt * 16 * 1024 + 32 * s);
                    acc[nt] = __builtin_amdgcn_mfma_f32_16x16x32_bf16(ah, bh, acc[nt], 0, 0, 0);
                    acc[nt] = __builtin_amdgcn_mfma_f32_16x16x32_bf16(ah, bl, acc[nt], 0, 0, 0);
                    acc[nt] = __builtin_amdgcn_mfma_f32_16x16x32_bf16(alo, bh, acc[nt], 0, 0, 0);
                }
            }
            __syncthreads();
#pragma unroll
            for (int nt = 0; nt < 3; ++nt)
#pragma unroll
                for (int rg = 0; rg < 4; ++rg) lgs[(4 * c4 + rg) * 52 + 16 * nt + l15] = acc[nt][rg];
            __syncthreads();
            if (kh == 0 && lane < 16) {
                const int r = r0 + lane;
                const LAS float* lp = lgs + lane * 52; const LAS float* lq = lp + 832;
                float gl[4]; float gm = -INFINITY; int gi = 0;
#pragma unroll
                for (int e = 0; e < 4; ++e) { gl[e] = (lp[e] + lq[e]) + P.b_group[e]; if (gl[e] > gm) { gm = gl[e]; gi = e; } }
                float gs = 0.f;
#pragma unroll
                for (int e = 0; e < 4; ++e) gs += expf(gl[e] - gm);
                const float gwt = 1.f / gs;
                float el[8]; float em = -INFINITY; int e1 = 0;
#pragma unroll
                for (int e = 0; e < 8; ++e) { el[e] = (lp[4 + gi * 8 + e] + lq[4 + gi * 8 + e]) + P.b_expert[gi * 8 + e]; if (el[e] > em) { em = el[e]; e1 = e; } }
                float em2 = -INFINITY; int e2 = 0;
#pragma unroll
                for (int e = 0; e < 8; ++e) if (e != e1 && el[e] > em2) { em2 = el[e]; e2 = e; }
                const float p2 = expf(em2 - em);
                const float w1 = gwt / (1.f + p2), w2 = gwt * p2 / (1.f + p2);
                const int ex1 = gi * 8 + e1, ex2 = gi * 8 + e2;
                const unsigned pos1 = atomicAdd(&CNT[ex1 * 64], 1u), pos2 = atomicAdd(&CNT[ex2 * 64], 1u);
                LIST[ex1 * ML + pos1] = r * 2; EW[r * 2] = w1;
                LIST[ex2 * ML + pos2] = r * 2 + 1; EW[r * 2 + 1] = w2;
            }
        }
    }
    SEAM(9);
    LAS int* tab = (LAS int*)(lds + LDS_TAB);
    if (hi > 10 && lo <= 11) {
        __syncthreads();
        if (wave == 0) {
            const int cnt = lane < NE ? (int)CNT[lane * 64] : 0, np = (cnt + 255) >> 8;
            int incl = np;
#pragma unroll
            for (int o_ = 1; o_ < 32; o_ <<= 1) { const int t_ = __shfl_up(incl, o_); if (lane >= o_) incl += t_; }
            const int first = incl - np;
            if (lane < NE) { tab[lane] = first; tab[64 + lane] = cnt; for (int k = 0; k < np; ++k) tab[128 + first + k] = lane; }
            if (lane == NE - 1) tab[32] = incl;
            if (lane == 0) { tab[33] = 0; tab[34] = 0; tab[36] = 0; tab[37] = 0; tab[38] = 0; tab[39] = 0; }
        }
        __syncthreads();
        {
            const int c_ = tid;
            const int nu = c_ < G ? ((G == 256) ? (((tab[4 * (c_ & 7) + 4] - tab[4 * (c_ & 7)]) * 4 - (c_ >> 3) + 31) >> 5) : ((tab[32] * 4 - c_ + G - 1) / G)) : 0;
            { int m_ = nu;
#pragma unroll
              for (int o_ = 1; o_ < 64; o_ <<= 1) { const int t_ = __shfl_xor(m_, o_); m_ = t_ > m_ ? t_ : m_; }
              if (lane == 0) tab[40 + wave] = m_; }
            __syncthreads();
            int numax_ = tab[40];
#pragma unroll
            for (int w_ = 1; w_ < 8; ++w_) numax_ = tab[40 + w_] > numax_ ? tab[40 + w_] : numax_;
            const bool isf = c_ < G && nu < numax_;
            const unsigned long long bal = __ballot(isf);
            if (lane == 0 && wave < 4) tab[36 + wave] = __popcll(bal);
            __syncthreads();
            int base_ = 0; for (int w_ = 0; w_ < wave && w_ < 4; ++w_) base_ += tab[36 + w_];
            const int tot_ = tab[36] + tab[37] + tab[38] + tab[39];
            if (c_ < G && c_ < 256) tab[320 + c_] = tot_ == 0 ? c_ : (isf ? base_ + __popcll(bal & ((1ull << lane) - 1ull)) : -1);
            if (tid == 0) tab[33] = tot_ == 0 ? G : tot_;
        }
        __syncthreads();
    }
    if (IN(10)) {
        pg8::Gemm g{H2, WGU, ML, NE * 1024, DM}; MoeOrder<true> S_{tab, LIST, G, bid};
        EpiGateUp E{ACT};
        pg8::gemm_phase<EpiGateUp, MoeOrder<true>, true, true>(lds, g, S_, E);
        const int nfill = tab[33], rank = tab[320 + bid];
        if (rank >= 0) {
            LAS float* scr = (LAS float*)(lds + wave * 16640);
            for (int it = CONV_N1 + wave * nfill + rank; it < CONV_ITEMS; it += nfill * 8) conv_item(P, it, WIN, WOUT, WGU, WD, scr, lane);
        }
    }
    SEAM(10);
    if (IN(11)) {
        pg8::Gemm g{ACT, WD, MAXSLOT, NE * 1024, EDIM}; MoeOrder<false> S_{tab, LIST, G, bid};
        EpiDown E{Y, LIST, tab};
        pg8::gemm_phase<EpiDown, MoeOrder<false>, true, true>(lds, g, S_, E);
    }
    SEAM(11);
    if (IN(12)) {
        const int half = lane >> 5, l32 = lane & 31;
        for (int rp = gw; rp < ML / 2; rp += NGW) {
            const int r = rp * 2 + half;
            const float* g2 = MOD + (r / SEQ) * 6144 + 5120;
            const float w0 = EW[r * 2], w1 = EW[r * 2 + 1];
            f32x4 v[8]; float s = 0.f;
#pragma unroll
            for (int j = 0; j < 8; ++j) {
                const int c0 = j * 128 + l32 * 4;
                const u32x2 xw = *(const u32x2*)(X1 + (size_t)r * DM + c0); const f32x4 xv = {bflo(xw.x), bfhi(xw.x), bflo(xw.y), bfhi(xw.y)};
                const u32x2 y0 = *(const u32x2*)(Y + (size_t)(r * 2) * DM + c0), y1 = *(const u32x2*)(Y + (size_t)(r * 2 + 1) * DM + c0);
                const f32x4 gg = *(const f32x4*)(g2 + c0);
                v[j].x = xv.x + gg.x * (w0 * bflo(y0.x) + w1 * bflo(y1.x)); v[j].y = xv.y + gg.y * (w0 * bfhi(y0.x) + w1 * bfhi(y1.x));
                v[j].z = xv.z + gg.z * (w0 * bflo(y0.y) + w1 * bflo(y1.y)); v[j].w = xv.w + gg.w * (w0 * bfhi(y0.y) + w1 * bfhi(y1.y));
                s += v[j].x * v[j].x + v[j].y * v[j].y + v[j].z * v[j].z + v[j].w * v[j].w;
            }
            s += __shfl_xor(s, 1); s += __shfl_xor(s, 2); s += __shfl_xor(s, 4); s += __shfl_xor(s, 8); s += __shfl_xor(s, 16);
            const float rstd = rsqrtf(s * (1.f / DM) + EPS);
#pragma unroll
            for (int j = 0; j < 8; ++j) {
                const int c0 = j * 128 + l32 * 4;
                const f32x4 nf = *(const f32x4*)(P.norm_final + c0);
                f32x4 o; o.x = v[j].x * rstd * nf.x; o.y = v[j].y * rstd * nf.y; o.z = v[j].z * rstd * nf.z; o.w = v[j].w * rstd * nf.w;
                *(f32x4*)(P.out + (size_t)r * DM + c0) = o;
            }
        }
    }
#undef IN
#undef SEAM
}

#ifndef N_LAUNCHES
#define N_LAUNCHES 1
#endif
constexpr int N_PHASES = 13;

extern "C" void kernel_launch(void* const* d_in, const int* in_sizes, int n_in, void* d_out, int out_size, void* d_ws, size_t ws_size, hipStream_t stream) {
    static int grid = 0;
    if (grid == 0) {
        if (n_in != 25 || out_size != ML * DM || ws_size < WS_NEED) { fprintf(stderr, "kernel_launch: unexpected problem (n_in %d out %d ws %zu need %zu)\n", n_in, out_size, ws_size, (size_t)WS_NEED); grid = -1; return; }
        int dev = 0, cus = 0, per_cu = 0;
        (void)hipGetDevice(&dev);
        (void)hipDeviceGetAttribute(&cus, hipDeviceAttributeMultiprocessorCount, dev);
        (void)hipFuncSetAttribute((const void*)fwd_kernel, hipFuncAttributeMaxDynamicSharedMemorySize, LDS_BYTES);
        (void)hipOccupancyMaxActiveBlocksPerMultiprocessor(&per_cu, (const void*)fwd_kernel, NTHREADS, LDS_BYTES);
        (void)hipGetLastError();
        if (per_cu < 1) { fprintf(stderr, "kernel_launch: occupancy query says %d\n", per_cu); }
        grid = cus;
    }
    if (grid < 0) return;
    (void)hipMemsetAsync((char*)d_ws + WS_CTL, 0, CTL_ZERO_BYTES, stream);
    Args a{};
    const float** pp = (const float**)&a.p;
    for (int i = 0; i < 25; ++i) pp[i] = (const float*)d_in[i];
    a.p.out = (float*)d_out; a.p.ws = (unsigned char*)d_ws;
    if (N_LAUNCHES == 1) {
        a.ph_lo = 0; a.ph_hi = N_PHASES;
        hipLaunchKernelGGL(fwd_kernel, dim3(grid), dim3(NTHREADS), LDS_BYTES, stream, a);
    } else {
        for (int ph = 0; ph < N_PHASES; ++ph) { a.ph_lo = ph; a.ph_hi = ph + 1; hipLaunchKernelGGL(fwd_kernel, dim3(grid), dim3(NTHREADS), LDS_BYTES, stream, a); }
    }
}
```

```cpp
#include <hip/hip_runtime.h>
#include <cstdio>
#include <cstdint>

constexpr int DM = 1024, SEQ = 8192, NB = 2, CTXL = 256;
constexpr int ML = NB * SEQ;
constexpr int MC = NB * CTXL;
constexpr int MT = ML + MC;
constexpr int INC = 2320;
constexpr int PC = 2304;
constexpr int C_Z = 0, C_XBC = 512, C_Q = 1536, C_K = 2048, C_V = 2176;
constexpr int NCH = 132;
constexpr int NE = 32, EDIM = 512;
constexpr int MAXSLOT = 40960;
constexpr float EPS = 1e-6f;

constexpr size_t MiB = 1u << 20;
constexpr size_t WS_CTL = 0, CTL_ZERO_BYTES = 64 * 1024;
constexpr size_t WS_MODP = 1 * MiB;
constexpr size_t WS_MOD = WS_MODP + 16 * 3 * 6144 * 4;
constexpr size_t WS_ROPE = 3 * MiB;
constexpr size_t WS_DT = 5 * MiB;
constexpr size_t WS_ACS = 6 * MiB + 512 * 1024;
constexpr size_t WS_AL = 8 * MiB;
constexpr size_t WS_EW = 8 * MiB + 64 * 1024;
constexpr size_t WS_RSTD = 8 * MiB + 256 * 1024;
constexpr size_t WS_EID = 8 * MiB + 512 * 1024;
constexpr size_t WS_POS = 9 * MiB;
constexpr size_t WS_LIST = 10 * MiB;
constexpr size_t WS_FV = 8 * MiB + 16 * 1024;
constexpr size_t WS_RB = 8 * MiB + 32 * 1024;
constexpr size_t WS_F1 = 8 * MiB + 40 * 1024;
constexpr size_t WS_DB = 8 * MiB + 56 * 1024;
constexpr size_t WS_WDT = 9 * MiB + 256 * 1024;
constexpr size_t WS_WR = 9 * MiB + 512 * 1024;
constexpr size_t WS_WIN = 12 * MiB;
constexpr size_t WS_WOUT = 17 * MiB;
constexpr size_t WS_WGU = 20 * MiB;
constexpr size_t WS_WD = 84 * MiB;
constexpr size_t WS_HX = 116 * MiB;
constexpr size_t WS_XST = 116 * MiB;
constexpr size_t WS_BT = WS_XST + (size_t)NCH * 512 * 128 * 2;
constexpr size_t WS_P = 149 * MiB;
constexpr size_t WS_X1 = 149 * MiB;
constexpr size_t WS_U = WS_P + (size_t)MT * PC * 2;
constexpr size_t WS_S = WS_U + 33 * MiB;
constexpr size_t WS_KR = 289 * MiB + 512 * 1024;
constexpr size_t WS_HS = 213 * MiB;
constexpr size_t WS_NEED = 294 * MiB;
static_assert(WS_BT + (size_t)NCH * 256 * 128 * 2 <= WS_P, "XST/BT fit in the HX slot");
static_assert(WS_S + 33 * MiB <= WS_KR && WS_KR + (size_t)(MT + 128) * 128 * 2 <= WS_NEED, "ws budget");
static_assert(WS_X1 + (size_t)ML * 1024 * 4 <= WS_HS && WS_HS + (size_t)MAXSLOT * 1024 * 2 <= WS_NEED, "X1 | HS");
constexpr int CW_CNT = 8192;
constexpr int CW_BAR = 1024;

constexpr int LDS_BYTES = 147456;
constexpr int LDS_TAB = 139264;
constexpr int NTHREADS = 512;

#define LAS __attribute__((address_space(3)))
typedef unsigned short bf16;

#define XB_TMO      128
#define XB_XCNT(j)  (256  + 64 * (j))
#define XB_XSUB(j)  (1280 + 64 * (j))
#define XB_XGEN(j)  (2304 + 64 * (j))
#define XB_TOP      3328
#define XB_TOPGEN   3392
#define XCD_BAR_WORDS 3456
#define XB_SPIN_CAP (1u << 18)
__device__ __forceinline__ unsigned xb_ld(unsigned* p)              { return __hip_atomic_load(p, __ATOMIC_RELAXED, __HIP_MEMORY_SCOPE_AGENT); }
__device__ __forceinline__ unsigned xb_add(unsigned* p, unsigned v) { return __hip_atomic_fetch_add(p, v, __ATOMIC_RELAXED, __HIP_MEMORY_SCOPE_AGENT); }
__device__ __forceinline__ unsigned xb_xcc_id() { return (unsigned)__builtin_amdgcn_s_getreg((3 << 11) | 20) & 0xFu; }
#define XB_SPIN(cond, bar) do { unsigned _sp = 0; while (cond) { __builtin_amdgcn_s_sleep(1); \
    if ((++_sp & 255u) == 0u) { if (xb_ld(&(bar)[XB_TMO])) break; if (_sp > XB_SPIN_CAP) { atomicAdd(&(bar)[XB_TMO], 1u); break; } } } } while (0)
struct XcdBarrier { unsigned* bar; unsigned x; volatile LAS unsigned* st; };
__device__ __forceinline__ XcdBarrier xcd_barrier_post(unsigned* bar, volatile LAS unsigned* st) {
    XcdBarrier b; b.bar = bar; b.x = xb_xcc_id(); b.st = st;
    if (threadIdx.x == 0) (void)xb_add(&bar[XB_XCNT(b.x)], 1u);
    return b;
}
__device__ __forceinline__ void xcd_barrier_complete(unsigned* bar, unsigned x, unsigned& nloc, unsigned& nx) {
    const unsigned G = gridDim.x * gridDim.y * gridDim.z;
    unsigned sum, cnt, mine, sp = 0u;
    for (;;) {
        sum = 0u; cnt = 0u; mine = 0u;
#pragma unroll
        for (unsigned j = 0; j < 16; ++j) { const unsigned c = xb_ld(&bar[XB_XCNT(j)]); sum += c; cnt += (c > 0u) ? 1u : 0u; mine = (j == x) ? c : mine; }
        if (sum == G) break;
        __builtin_amdgcn_s_sleep(1);
        if ((++sp & 255u) == 0u) { if (xb_ld(&bar[XB_TMO])) break; if (sp > XB_SPIN_CAP) { atomicAdd(&bar[XB_TMO], 1u); break; } }
    }
    nloc = mine > 0u ? mine : 1u; nx = cnt > 0u ? cnt : 1u;
}
__device__ __forceinline__ void xcd_barrier(const XcdBarrier& b) {
    asm volatile("s_waitcnt vmcnt(0)" ::: "memory");
    __syncthreads();
    if (threadIdx.x == 0) {
        unsigned* bar = b.bar;
        __builtin_amdgcn_s_waitcnt(0);
        unsigned nloc = b.st[0], nx = b.st[1];
        if (nloc == 0u) { xcd_barrier_complete(bar, b.x, nloc, nx); b.st[0] = nloc; b.st[1] = nx; }
        const unsigned old = xb_add(&bar[XB_XSUB(b.x)], 1u);
        const unsigned gen = old / nloc;
        if (old + 1u == (gen + 1u) * nloc) {
            __builtin_amdgcn_fence(__ATOMIC_RELEASE, "agent");
            asm volatile("s_waitcnt vmcnt(0)" ::: "memory");
            const unsigned og = xb_add(&bar[XB_TOP], 1u);
            const unsigned tg = og / nx;
            if (og + 1u == (tg + 1u) * nx) xb_add(&bar[XB_TOPGEN], 1u);
            else XB_SPIN(xb_ld(&bar[XB_TOPGEN]) == tg, bar);
            __builtin_amdgcn_fence(__ATOMIC_ACQUIRE, "agent");
            xb_add(&bar[XB_XGEN(b.x)], 1u);
            asm volatile("s_waitcnt vmcnt(0)" ::: "memory");
        } else {
            XB_SPIN(xb_ld(&bar[XB_XGEN(b.x)]) == gen, bar);
            __builtin_amdgcn_fence(__ATOMIC_ACQUIRE, "agent");
            asm volatile("s_waitcnt vmcnt(0)" ::: "memory");
        }
    }
    __syncthreads();
}


namespace pg8 {
#define PG8_LAS __attribute__((address_space(3)))
typedef unsigned short bf16_t;
typedef short bf16x8 __attribute__((ext_vector_type(8)));
typedef float f32x4 __attribute__((ext_vector_type(4)));
typedef unsigned u32x4 __attribute__((ext_vector_type(4)));
constexpr int BM = 256, BK = 64, HALF = 128, HTB = HALF * BK * 2  , STAGE_BYTES = 8 * HTB, NXCD = 8, WGM = 8;

__host__ __device__ __forceinline__ int lds_byte(int r, int c) { const int st = (r >> 4) * 2 + (c >> 5), rr = r & 15, cc = c & 31, ob = rr * 64 + cc * 2; return st * 1024 + (ob ^ (((ob >> 9) & 1) << 5)); }
__host__ __device__ __forceinline__ void stage_rc(int b, int& R, int& C) { const int st = b / 1024, sb = b % 1024, swz = sb ^ (((sb >> 9) & 1) << 5); R = (st >> 1) * 16 + swz / 64; C = (st & 1) * 32 + (swz % 64) / 2; }
__host__ __device__ __forceinline__ int perm32(int rho) { const int n = rho >> 4, i = rho & 15; return 8 * (i >> 2) + 4 * n + (i & 3); }

struct Unit { int pm, pn; };
struct Gemm { const bf16_t* A; const bf16_t* Bt; int M, N, K; };

struct StaticOrder {
    static constexpr bool GATHER = false;
    int nM, nN, nwg, G, c;
    __host__ __device__ void init(int M, int N, int G_, int c_) { nM = M / BM; nN = N / BM; nwg = nM * nN; G = G_; c = c_; }
    __host__ __device__ bool next(int i, Unit& u) const {
        const long L = (long)i * G + c; if (L >= nwg) return false;
        int wgid = (int)L; { const int q = nwg / NXCD, r = nwg % NXCD, xcd = wgid % NXCD, off = wgid / NXCD; wgid = (xcd < r ? xcd * (q + 1) : r * (q + 1) + (xcd - r) * q) + off; }
        const int nig = WGM * nN, gid = wgid / nig, fm = gid * WGM, gsz = (nM - fm) < WGM ? (nM - fm) : WGM;
        u.pm = fm + ((wgid % nig) % gsz); u.pn = (wgid % nig) / gsz; return true;
    }
    __device__ __forceinline__ void a_ready(const Unit&) const {}
    __device__ __forceinline__ void done(const Unit&) const {}
};

__device__ __forceinline__ unsigned cvt_pk_bf16(float lo, float hi) { unsigned r; asm volatile("v_cvt_pk_bf16_f32 %0, %1, %2" : "=v"(r) : "v"(lo), "v"(hi)); return r; }
typedef float f32x2 __attribute__((ext_vector_type(2)));
template <class Epi, class Sched, bool ALIGN_EPI = false, bool SP2 = false>
__device__ __forceinline__ void gemm_phase(PG8_LAS unsigned char* lds, const Gemm g, const Sched& S, const Epi& E) {
    const int tid = threadIdx.x, wid = __builtin_amdgcn_readfirstlane(tid >> 6), lane = tid & 63, wr = wid >> 2, wc = wid & 3, fr = lane & 15, fq = lane >> 4;
    const int K = g.K, nt = K / BK;
    unsigned voffA[2], voffB[2]; int gR[2], gC[2]; unsigned gvc[2][2] = {{0u, 0u}, {0u, 0u}}, gvn[2][2] = {{0u, 0u}, {0u, 0u}};
#pragma unroll
    for (int i = 0; i < 2; ++i) { int R, C; stage_rc(tid * 16 + i * 8192, R, C); const int Rb = Epi::PERM ? ((R & ~31) + perm32(R & 31)) : R;
        voffA[i] = (unsigned)(R * K + C) * 2u; gR[i] = R; gC[i] = C; voffB[i] = (unsigned)(Rb * K + C) * 2u; }
    const size_t kstep = (size_t)(BK * 2);
    const size_t hstep = (size_t)HALF * K * 2;
    const size_t tstep = 2 * hstep;
    const unsigned ldsw = (unsigned)wid * 1024u;
    const int aoff = lds_byte(wr * 64 + fr, fq * 8), boff = lds_byte(wc * 32 + fr, fq * 8);
#define PG8_SA(b, h) (((b) * 2 + (h)) * HTB)
#define PG8_SB(b, h) ((4 + (b) * 2 + (h)) * HTB)
#define PG8_STAGE(bufoff, gbase, voff) do { _Pragma("unroll") for (int _i = 0; _i < 2; ++_i) \
        __builtin_amdgcn_global_load_lds((const unsigned*)((const char*)(gbase) + (voff)[_i]), (PG8_LAS unsigned*)(lds + (bufoff) + ldsw + _i * 8192), 16, 0, 0); } while (0)
#define PG8_STAGE_A(bufoff, ptr, h, nx) do { if constexpr (Sched::GATHER) { _Pragma("unroll") for (int _i = 0; _i < 2; ++_i) { const unsigned _o = (nx) ? gvn[h][_i] : gvc[h][_i]; \
        __builtin_amdgcn_global_load_lds((const unsigned*)((const char*)(ptr) + _o), (PG8_LAS unsigned*)(lds + (bufoff) + ldsw + _i * 8192), 16, 0, 0); } } \
        else { PG8_STAGE(bufoff, (ptr) + (h) * hstep, voffA); } } while (0)
#define PG8_LDA(dst, b, h) do { _Pragma("unroll") for (int m = 0; m < 4; ++m) _Pragma("unroll") for (int k = 0; k < 2; ++k) dst[m][k] = *(const PG8_LAS bf16x8*)(lds + PG8_SA(b, h) + aoff + m * 2048 + k * 1024); } while (0)
#define PG8_LDB(dst, b, h) do { _Pragma("unroll") for (int n = 0; n < 2; ++n) _Pragma("unroll") for (int k = 0; k < 2; ++k) dst[n][k] = *(const PG8_LAS bf16x8*)(lds + PG8_SB(b, h) + boff + n * 2048 + k * 1024); } while (0)
#define PG8_MMA(ai, bj, At, Bt) do { __builtin_amdgcn_s_setprio(1); _Pragma("unroll") for (int m = 0; m < 4; ++m) _Pragma("unroll") for (int n = 0; n < 2; ++n) _Pragma("unroll") for (int k = 0; k < 2; ++k) \
        acc[ai][bj][m][n] = __builtin_amdgcn_mfma_f32_16x16x32_bf16(Bt[n][k], At[m][k], acc[ai][bj][m][n], 0, 0, 0); __builtin_amdgcn_s_setprio(0); } while (0)
#define PG8_WAIT_V(n) asm volatile("s_waitcnt vmcnt(" #n ")" ::: "memory")
#define PG8_WAIT_L(n) asm volatile("s_waitcnt lgkmcnt(" #n ")" ::: "memory")
#define PG8_BAR __builtin_amdgcn_s_barrier()
#define PG8_SCHED __builtin_amdgcn_sched_barrier(0)
    Unit cur, nxt; int ui = 0;
    if (!S.next(0, cur)) return;
    f32x4 acc[2][2][4][2];
#pragma unroll
    for (int a = 0; a < 2; ++a)
#pragma unroll
        for (int b = 0; b < 2; ++b)
#pragma unroll
            for (int m = 0; m < 4; ++m)
#pragma unroll
                for (int n = 0; n < 2; ++n) acc[a][b][m][n] = (f32x4){0.f, 0.f, 0.f, 0.f};
    bf16x8 At[4][2], B0[2][2], B1[2][2];
    const char* cA = (const char*)g.A + (Sched::GATHER ? (size_t)0 : (size_t)cur.pm * tstep);
    if constexpr (Sched::GATHER) { _Pragma("unroll") for (int h = 0; h < 2; ++h) _Pragma("unroll") for (int i = 0; i < 2; ++i) gvc[h][i] = (unsigned)S.arow(cur, h * HALF + gR[i]) * (unsigned)(K * 2) + (unsigned)(gC[i] * 2); }
    const char* cB = (const char*)g.Bt + (size_t)cur.pn * tstep;
    S.a_ready(cur);
    if constexpr (SP2) {
        PG8_STAGE(PG8_SB(0, 0), cB, voffB); PG8_STAGE(PG8_SB(0, 1), cB + hstep, voffB); PG8_STAGE_A(PG8_SA(0, 0), cA, 0, false); PG8_STAGE_A(PG8_SA(0, 1), cA, 1, false);
        if (wr == 1) PG8_BAR;
        PG8_WAIT_V(2); PG8_BAR;
        PG8_STAGE(PG8_SB(1, 0), cB + kstep, voffB); PG8_STAGE_A(PG8_SA(1, 0), cA + kstep, 0, false); PG8_STAGE(PG8_SB(1, 1), cB + hstep + kstep, voffB);
        PG8_WAIT_V(6); PG8_BAR;
    } else {
        PG8_STAGE(PG8_SB(0, 0), cB, voffB); PG8_STAGE_A(PG8_SA(0, 0), cA, 0, false); PG8_STAGE(PG8_SB(0, 1), cB + hstep, voffB); PG8_STAGE_A(PG8_SA(0, 1), cA, 1, false);
        if (wr == 1) PG8_BAR;
        PG8_WAIT_V(4); PG8_BAR;
        PG8_STAGE(PG8_SB(1, 0), cB + kstep, voffB); PG8_STAGE_A(PG8_SA(1, 0), cA + kstep, 0, false); PG8_STAGE(PG8_SB(1, 1), cB + hstep + kstep, voffB);
        PG8_WAIT_V(6); PG8_BAR;
    }
    for (;;) {
        const bool has_next = S.next(ui + 1, nxt);
        const char* nA = has_next ? (const char*)g.A + (Sched::GATHER ? (size_t)0 : (size_t)nxt.pm * tstep) : cA;
        if constexpr (Sched::GATHER) { _Pragma("unroll") for (int h = 0; h < 2; ++h) _Pragma("unroll") for (int i = 0; i < 2; ++i) gvn[h][i] = has_next ? (unsigned)S.arow(nxt, h * HALF + gR[i]) * (unsigned)(K * 2) + (unsigned)(gC[i] * 2) : gvc[h][i]; }
        const char* nB = has_next ? (const char*)g.Bt + (size_t)nxt.pn * tstep : cB;
        for (int t = 0; t < nt; t += 2) {
            const bool last = (t == nt - 2);
            const char* a1 = cA + (size_t)(t + 1) * kstep;
            const char* a2 = last ? nA : cA + (size_t)(t + 2) * kstep; const char* b2 = last ? nB : cB + (size_t)(t + 2) * kstep;
            const char* a3 = a2 + kstep; const char* b3 = b2 + kstep;
            if (last && has_next) S.a_ready(nxt);
            if constexpr (SP2) {
            PG8_LDB(B0, 0, 0); PG8_LDB(B1, 0, 1); PG8_SCHED; PG8_LDA(At, 0, 0); PG8_STAGE_A(PG8_SA(1, 1), a1, 1, false);
            PG8_WAIT_V(8); PG8_WAIT_L(0); PG8_BAR; PG8_MMA(0, 0, At, B0); PG8_MMA(0, 1, At, B1); PG8_BAR; PG8_SCHED;
            PG8_LDA(At, 0, 1); PG8_STAGE(PG8_SB(0, 0), b2, voffB); PG8_STAGE(PG8_SB(0, 1), b2 + hstep, voffB); PG8_STAGE_A(PG8_SA(0, 0), a2, 0, last);
            PG8_WAIT_V(8); PG8_WAIT_L(0); PG8_BAR; PG8_MMA(1, 0, At, B0); PG8_MMA(1, 1, At, B1); PG8_BAR; PG8_SCHED;
            PG8_LDB(B0, 1, 0); PG8_LDB(B1, 1, 1); PG8_SCHED; PG8_LDA(At, 1, 0); PG8_STAGE_A(PG8_SA(0, 1), a2, 1, last);
            PG8_WAIT_V(8); PG8_WAIT_L(0); PG8_BAR; PG8_MMA(0, 0, At, B0); PG8_MMA(0, 1, At, B1); PG8_BAR; PG8_SCHED;
            PG8_LDA(At, 1, 1); PG8_STAGE(PG8_SB(1, 0), b3, voffB); PG8_STAGE(PG8_SB(1, 1), b3 + hstep, voffB); PG8_STAGE_A(PG8_SA(1, 0), a3, 0, last);
            PG8_WAIT_V(8); PG8_WAIT_L(0); PG8_BAR; PG8_MMA(1, 0, At, B0); PG8_MMA(1, 1, At, B1); PG8_BAR; PG8_SCHED;
            } else {
            PG8_LDB(B0, 0, 0); PG8_SCHED; PG8_LDA(At, 0, 0); PG8_STAGE_A(PG8_SA(1, 1), a1, 1, false);
            PG8_WAIT_L(8); PG8_BAR; PG8_WAIT_L(0); PG8_MMA(0, 0, At, B0); PG8_BAR; PG8_SCHED;
            PG8_LDB(B1, 0, 1); PG8_STAGE(PG8_SB(0, 0), b2, voffB);
            PG8_BAR; PG8_WAIT_L(0); PG8_MMA(0, 1, At, B1); PG8_BAR;
            PG8_LDA(At, 0, 1); PG8_STAGE_A(PG8_SA(0, 0), a2, 0, last);
            PG8_BAR; PG8_WAIT_L(0); PG8_MMA(1, 0, At, B0); PG8_BAR; PG8_SCHED;
            PG8_STAGE(PG8_SB(0, 1), b2 + hstep, voffB);
            PG8_WAIT_V(6); PG8_BAR; PG8_MMA(1, 1, At, B1); PG8_BAR;
            PG8_LDB(B0, 1, 0); PG8_SCHED; PG8_LDA(At, 1, 0); PG8_STAGE_A(PG8_SA(0, 1), a2, 1, last);
            PG8_WAIT_L(8); PG8_BAR; PG8_WAIT_L(0); PG8_MMA(0, 0, At, B0); PG8_BAR; PG8_SCHED;
            PG8_LDB(B1, 1, 1); PG8_STAGE(PG8_SB(1, 0), b3, voffB);
            PG8_BAR; PG8_WAIT_L(0); PG8_MMA(0, 1, At, B1); PG8_BAR;
            PG8_LDA(At, 1, 1); PG8_STAGE_A(PG8_SA(1, 0), a3, 0, last);
            PG8_BAR; PG8_WAIT_L(0); PG8_MMA(1, 0, At, B0); PG8_BAR; PG8_SCHED;
            PG8_STAGE(PG8_SB(1, 1), b3 + hstep, voffB);
            PG8_WAIT_V(6); PG8_BAR; PG8_MMA(1, 1, At, B1); PG8_BAR;
            }
        }
        if constexpr (ALIGN_EPI) { if (wr == 0) PG8_BAR; }
        if constexpr (!Epi::AFTER_DRAIN) { E(acc, cur, wr, wc, fr, fq); S.done(cur); }
        if (!has_next) break;
#pragma unroll
        for (int a = 0; a < 2; ++a)
#pragma unroll
            for (int b = 0; b < 2; ++b)
#pragma unroll
                for (int m = 0; m < 4; ++m)
#pragma unroll
                    for (int n = 0; n < 2; ++n) acc[a][b][m][n] = (f32x4){0.f, 0.f, 0.f, 0.f};
        cur = nxt; cA = nA; cB = nB; ++ui;
        if constexpr (Sched::GATHER) { _Pragma("unroll") for (int h = 0; h < 2; ++h) _Pragma("unroll") for (int i = 0; i < 2; ++i) gvc[h][i] = gvn[h][i]; }
        if constexpr (ALIGN_EPI) { if (wr == 1) PG8_BAR; }
    }
    PG8_WAIT_V(0);
    if constexpr (!ALIGN_EPI) { if (wr == 0) PG8_BAR; }
    PG8_BAR;
    if constexpr (Epi::AFTER_DRAIN) { E.fused(acc, cur, wr, wc, fr, fq, lds, wid, lane); S.done(cur); }
#undef PG8_SA
#undef PG8_SB
#undef PG8_STAGE
#undef PG8_STAGE_A
#undef PG8_LDA
#undef PG8_LDB
#undef PG8_MMA
#undef PG8_WAIT_V
#undef PG8_WAIT_L
#undef PG8_BAR
#undef PG8_SCHED
}
}

typedef float f32x4 __attribute__((ext_vector_type(4)));
typedef unsigned u32x4 __attribute__((ext_vector_type(4)));
typedef unsigned u32x2 __attribute__((ext_vector_type(2)));
__device__ __forceinline__ float silu_acc(float x) { return x / (1.f + expf(-x)); }
__device__ __forceinline__ float silu_fast(float x) { return x * __builtin_amdgcn_rcpf(1.f + __expf(-x)); }
__device__ __forceinline__ float softplus_f(float x) { return fmaxf(x, 0.f) + log1pf(expf(-fabsf(x))); }
__device__ __forceinline__ float wave_sum(float v) {
#pragma unroll
    for (int o = 1; o < 64; o <<= 1) v += __shfl_xor(v, o);
    return v;
}
__device__ __forceinline__ float wave_max(float v) {
#pragma unroll
    for (int o = 1; o < 64; o <<= 1) v = fmaxf(v, __shfl_xor(v, o));
    return v;
}
__device__ __forceinline__ float bf2f(bf16 v) { return __uint_as_float((unsigned)v << 16); }
__device__ __forceinline__ float bflo(unsigned w) { return __uint_as_float(w << 16); }
__device__ __forceinline__ float bfhi(unsigned w) { return __uint_as_float(w & 0xffff0000u); }
__device__ __forceinline__ unsigned f2bf(float f) { unsigned u = __float_as_uint(f); return (u + 0x7fffu + ((u >> 16) & 1u)) >> 16; }
__device__ __forceinline__ unsigned pk2(float lo, float hi) { return f2bf(lo) | (f2bf(hi) << 16); }

struct Ptrs {
    const float *x, *c, *ctx, *c_ctx, *w_ada, *b_ada, *norm1, *w_in, *conv_w, *conv_b, *dt_bias, *a_log, *d_skip, *ssd_norm, *sinks,
                *w_out, *norm2, *w_group, *b_group, *w_expert, *b_expert, *w_gate, *w_up, *w_down, *norm_final;
    float* out; unsigned char* ws;
};

__device__ __forceinline__ void transpose_item(const float* W, int ldn, int sn0, int k0, bf16* WT, int Kp, int drow0, LAS float* scr, int lane) {
    f32x4 v[16];
#pragma unroll
    for (int i = 0; i < 16; ++i) v[i] = *(const f32x4*)(W + (size_t)(k0 + 4 * i + (lane >> 4)) * ldn + sn0 + (lane & 15) * 4);
#pragma unroll
    for (int i = 0; i < 16; ++i) { LAS float* d = scr + (4 * i + (lane >> 4)) * 65 + (lane & 15) * 4; d[0] = v[i].x; d[1] = v[i].y; d[2] = v[i].z; d[3] = v[i].w; }
    asm volatile("s_waitcnt lgkmcnt(0)" ::: "memory");
    const int c = lane & 7;
#pragma unroll
    for (int j = 0; j < 8; ++j) { const int n = (lane >> 3) + 8 * j; const LAS float* s = scr + (8 * c) * 65 + n;
        u32x4 o; o.x = pg8::cvt_pk_bf16(s[0 * 65], s[1 * 65]); o.y = pg8::cvt_pk_bf16(s[2 * 65], s[3 * 65]); o.z = pg8::cvt_pk_bf16(s[4 * 65], s[5 * 65]); o.w = pg8::cvt_pk_bf16(s[6 * 65], s[7 * 65]);
        *(u32x4*)(WT + (size_t)(drow0 + n) * Kp + k0 + 8 * c) = o; }
    asm volatile("s_waitcnt lgkmcnt(0)" ::: "memory");
}

constexpr int CONV_IN = 36 * 16, CONV_OUT = 16 * 16, CONV_GU = 32 * 8 * 16, CONV_D = 32 * 16 * 8, CONV_ITEMS = CONV_IN + CONV_OUT + 2 * CONV_GU + CONV_D;
constexpr int CONV_N0 = CONV_IN + CONV_OUT + 4096;
constexpr int CONV_N1 = CONV_IN + CONV_OUT + 2 * CONV_GU;
__device__ __forceinline__ void conv_item(const Ptrs& P, int it, bf16* WIN, bf16* WOUT, bf16* WGU, bf16* WD, LAS float* scr, int lane) {
    int r = it;
    if (r < CONV_IN) { const int g = r % 36, kb = r / 36, d0 = g * 64; transpose_item(P.w_in, INC, d0 + (d0 >= 1536 ? 16 : 0), kb * 64, WIN, 1024, d0, scr, lane); return; } r -= CONV_IN;
    if (r < CONV_OUT) { const int g = r % 16, kb = r / 16; transpose_item(P.w_out, 1024, g * 64, kb * 64, WOUT, 1024, g * 64, scr, lane); return; } r -= CONV_OUT;
    if (r < 2 * CONV_GU) { const int up = r >= CONV_GU; if (up) r -= CONV_GU; const int e = r >> 7, q = r & 127, g = q & 7, kb = q >> 3, c0 = g * 64;
        transpose_item((up ? P.w_up : P.w_gate) + (size_t)e * 1024 * 512, 512, c0, kb * 64, WGU, 1024, e * 1024 + (c0 >> 7) * 256 + (up ? 128 : 0) + (c0 & 127), scr, lane); return; } r -= 2 * CONV_GU;
    { const int e = r >> 7, q = r & 127, g = q & 15, kb = q >> 4; transpose_item(P.w_down + (size_t)e * 512 * 1024, 1024, g * 64, kb * 64, WD, 512, e * 1024 + g * 64, scr, lane); }
}
__device__ __forceinline__ int chunk_row0(int q) { return q < 128 ? q * 128 : ML + (q - 128) * 128; }

struct EpiStoreBf16 {
    static constexpr bool PERM = true, AFTER_DRAIN = false;
    bf16* O; int ldc;
    __device__ __forceinline__ void operator()(const pg8::f32x4 (&acc)[2][2][4][2], const pg8::Unit& u, int wr, int wc, int fr, int fq) const {
        const int row0 = u.pm * 256 + wr * 64 + fr, col0 = u.pn * 256 + wc * 32 + 8 * fq;
#pragma unroll
        for (int ai = 0; ai < 2; ++ai)
#pragma unroll
            for (int m = 0; m < 4; ++m) { bf16* rowp = O + (size_t)(row0 + ai * 128 + m * 16) * ldc + col0;
#pragma unroll
                for (int bj = 0; bj < 2; ++bj) { const pg8::f32x4 v0 = acc[ai][bj][m][0], v1 = acc[ai][bj][m][1];
                    u32x4 w; w.x = pg8::cvt_pk_bf16(v0[0], v0[1]); w.y = pg8::cvt_pk_bf16(v0[2], v0[3]); w.z = pg8::cvt_pk_bf16(v1[0], v1[1]); w.w = pg8::cvt_pk_bf16(v1[2], v1[3]);
                    *(u32x4*)(rowp + bj * 128) = w; } }
    }
};
struct EpiOutProj {
    static constexpr bool PERM = true, AFTER_DRAIN = false;
    const float* x; const float* mod; bf16* X1; float* SSQP;
    __device__ __forceinline__ void operator()(const pg8::f32x4 (&acc)[2][2][4][2], const pg8::Unit& u, int wr, int wc, int fr, int fq) const {
        const int row0 = u.pm * 256 + wr * 64 + fr, col0 = u.pn * 256 + wc * 32 + 8 * fq;
        const float* g1 = mod + (u.pm * 256 / SEQ) * 6144 + 2048;
        f32x4 gv[2][2];
#pragma unroll
        for (int bj = 0; bj < 2; ++bj)
#pragma unroll
            for (int n = 0; n < 2; ++n) gv[bj][n] = *(const f32x4*)(g1 + col0 + bj * 128 + n * 4);
#pragma unroll
        for (int ai = 0; ai < 2; ++ai)
#pragma unroll
            for (int m = 0; m < 4; ++m) { const size_t off = (size_t)(row0 + ai * 128 + m * 16) * DM + col0;
                float s_ = 0.f;
#pragma unroll
                for (int bj = 0; bj < 2; ++bj) {
                    f32x4 o[2];
#pragma unroll
                    for (int n = 0; n < 2; ++n) { const f32x4 xv = *(const f32x4*)(x + off + bj * 128 + n * 4); const pg8::f32x4 a = acc[ai][bj][m][n];
                        o[n].x = xv.x + gv[bj][n].x * a[0]; o[n].y = xv.y + gv[bj][n].y * a[1]; o[n].z = xv.z + gv[bj][n].z * a[2]; o[n].w = xv.w + gv[bj][n].w * a[3];
                        s_ += o[n].x * o[n].x + o[n].y * o[n].y + o[n].z * o[n].z + o[n].w * o[n].w; }
                    u32x4 w; w.x = pg8::cvt_pk_bf16(o[0].x, o[0].y); w.y = pg8::cvt_pk_bf16(o[0].z, o[0].w); w.z = pg8::cvt_pk_bf16(o[1].x, o[1].y); w.w = pg8::cvt_pk_bf16(o[1].z, o[1].w);
                    *(u32x4*)(X1 + off + bj * 128) = w; }
                s_ += __shfl_xor(s_, 16); s_ += __shfl_xor(s_, 32);
                if (fq == 0) SSQP[(size_t)(row0 + ai * 128 + m * 16) * 16 + u.pn * 4 + wc] = s_; }
    }
};
struct EpiGateUp {
    static constexpr bool PERM = true, AFTER_DRAIN = false;
    bf16* ACT;
    __device__ __forceinline__ void operator()(const pg8::f32x4 (&acc)[2][2][4][2], const pg8::Unit& u, int wr, int wc, int fr, int fq) const {
        const int row0 = u.pm * 256 + wr * 64 + fr, col0 = (u.pn & 3) * 128 + wc * 32 + 8 * fq;
#pragma unroll
        for (int ai = 0; ai < 2; ++ai)
#pragma unroll
            for (int m = 0; m < 4; ++m) {
                float r[8];
#pragma unroll
                for (int n = 0; n < 2; ++n)
#pragma unroll
                    for (int i = 0; i < 4; ++i) { const float g = acc[ai][0][m][n][i], up = acc[ai][1][m][n][i]; r[n * 4 + i] = silu_fast(g) * up; }
                u32x4 w; w.x = pg8::cvt_pk_bf16(r[0], r[1]); w.y = pg8::cvt_pk_bf16(r[2], r[3]); w.z = pg8::cvt_pk_bf16(r[4], r[5]); w.w = pg8::cvt_pk_bf16(r[6], r[7]);
                *(u32x4*)(ACT + (size_t)(row0 + ai * 128 + m * 16) * EDIM + col0) = w; }
    }
};
struct EpiDown {
    static constexpr bool PERM = true, AFTER_DRAIN = false;
    bf16* Y; const int* LIST; const LAS int* tab;
    __device__ __forceinline__ void operator()(const pg8::f32x4 (&acc)[2][2][4][2], const pg8::Unit& u, int wr, int wc, int fr, int fq) const {
        const int e = u.pn >> 2, pos0 = (u.pm - tab[e]) * 256 + wr * 64 + fr, cnt = tab[64 + e], col0 = (u.pn & 3) * 256 + wc * 32 + 8 * fq;
#pragma unroll
        for (int ai = 0; ai < 2; ++ai)
#pragma unroll
            for (int m = 0; m < 4; ++m) { const int pos = pos0 + ai * 128 + m * 16;
                if (pos < cnt) { const int aid = LIST[e * ML + pos]; bf16* rowp = Y + (size_t)aid * DM + col0;
#pragma unroll
                    for (int bj = 0; bj < 2; ++bj) { const pg8::f32x4 v0 = acc[ai][bj][m][0], v1 = acc[ai][bj][m][1];
                        u32x4 w; w.x = pg8::cvt_pk_bf16(v0[0], v0[1]); w.y = pg8::cvt_pk_bf16(v0[2], v0[3]); w.z = pg8::cvt_pk_bf16(v1[0], v1[1]); w.w = pg8::cvt_pk_bf16(v1[2], v1[3]);
                        *(u32x4*)(rowp + bj * 128) = w; } } }
    }
};
template <bool G_> struct MoeOrder {
    static constexpr bool GATHER = G_;
    const LAS int* tab; const int* LIST; int G, c;
    __device__ __forceinline__ bool next(int i, pg8::Unit& u) const {
        if (G == 256) { const int x = c & 7, j = i * 32 + (c >> 3), p0 = tab[4 * x], p1 = tab[4 * x + 4]; if (j >= (p1 - p0) * 4) return false;
            const int p = p0 + (j >> 2); u.pm = p; u.pn = tab[128 + p] * 4 + (j & 3); return true; }
        const int L = i * G + c; if (L >= tab[32] * 4) return false;
        const int p = L >> 2; u.pm = p; u.pn = tab[128 + p] * 4 + (L & 3); return true;
    }
    __device__ __forceinline__ int arow(const pg8::Unit& u, int r) const {
        const int e = u.pn >> 2, pos = (u.pm - tab[e]) * 256 + r;
        return pos < tab[64 + e] ? (LIST[e * ML + pos] >> 1) : 0;
    }
    __device__ __forceinline__ void a_ready(const pg8::Unit&) const {}
    __device__ __forceinline__ void done(const pg8::Unit&) const {}
};

struct Args { Ptrs p; int ph_lo, ph_hi; };

__global__ void __launch_bounds__(NTHREADS, 2) fwd_kernel(Args args) {
    extern __shared__ __attribute__((aligned(16))) unsigned char lds_raw[];
    LAS unsigned char* lds = (LAS unsigned char*)lds_raw;
    const Ptrs& P = args.p;
    const int tid = threadIdx.x, lane = tid & 63, wave = __builtin_amdgcn_readfirstlane(tid >> 6);
    const int G = gridDim.x, bid = blockIdx.x;
    const int gtid = bid * NTHREADS + tid, NT = G * NTHREADS;
    const int gw = bid * 8 + wave, NGW = G * 8;
    unsigned char* ws = P.ws;
    unsigned* ctl = (unsigned*)(ws + WS_CTL);
    float* MODP = (float*)(ws + WS_MODP);
    float* MOD = (float*)(ws + WS_MOD);
    float* ROPEC = (float*)(ws + WS_ROPE);
    float* ROPES = ROPEC + 8192 * 32;
    float* DT = (float*)(ws + WS_DT);
    float* ACS = (float*)(ws + WS_ACS);
    float* SSQP = (float*)(ws + WS_ACS);
    float* AL = (float*)(ws + WS_AL);
    float* EW = (float*)(ws + WS_EW);
    int* LIST = (int*)(ws + WS_LIST);
    float* FV = (float*)(ws + WS_FV);
    bf16* WRH = (bf16*)(ws + WS_WR);
    bf16* WRL = WRH + 48 * 1024;
    float* F1V = (float*)(ws + WS_F1);
    float* DBV = (float*)(ws + WS_DB);
    bf16* WDH = (bf16*)(ws + WS_WDT);
    bf16* WDL = WDH + 16 * 1024;
    bf16* WIN = (bf16*)(ws + WS_WIN);
    bf16* WOUT = (bf16*)(ws + WS_WOUT);
    bf16* WGU = (bf16*)(ws + WS_WGU);
    bf16* WD = (bf16*)(ws + WS_WD);
    bf16* HX = (bf16*)(ws + WS_HX);
    bf16* MIX = (bf16*)P.out;
    bf16* XST = (bf16*)(ws + WS_XST);
    bf16* BT = (bf16*)(ws + WS_BT);
    bf16* PR = (bf16*)(ws + WS_P);
    bf16* H2 = (bf16*)(ws + WS_HS);
    bf16* Y = (bf16*)(ws + WS_HS);
    bf16* U = (bf16*)(ws + WS_U);
    bf16* ACT = (bf16*)P.out;
    bf16* S = (bf16*)(ws + WS_S);
    bf16* KR = (bf16*)(ws + WS_KR);
    bf16* X1 = (bf16*)(ws + WS_X1);
    unsigned* CNT = ctl + CW_CNT;

    volatile LAS unsigned* MISC = (volatile LAS unsigned*)(lds + LDS_BYTES - 64);
    if (tid < 16) MISC[tid] = 0u;
    __syncthreads();
    XcdBarrier bar = xcd_barrier_post(ctl + CW_BAR, MISC);
    const int lo = args.ph_lo, hi = args.ph_hi;
#define IN(k) (lo <= (k) && (k) < hi)
#define SEAM(k) do { if (IN(k) && IN((k) + 1)) xcd_barrier(bar); } while (0)

    if (IN(0)) {
        LAS float* sc3 = (LAS float*)lds;
        LAS float* mred = sc3 + 3072;
        LAS float* modl = mred + 64 * 72;
        for (int i = tid; i < 3072; i += NTHREADS) sc3[i] = silu_acc(i < 2048 ? P.c[i] : P.c_ctx[i - 2048]);
        __syncthreads();
        for (int cb = bid; cb < 256; cb += G) {
            const int c8 = tid & 7, kq = tid >> 3, col = cb * 24 + c8 * 3;
            float a[3][3];
#pragma unroll
            for (int r = 0; r < 3; ++r)
#pragma unroll
                for (int c = 0; c < 3; ++c) a[r][c] = 0.f;
#pragma unroll 4
            for (int k = kq * 16; k < kq * 16 + 16; ++k) {
                const float* wp = P.w_ada + (size_t)k * 6144 + col;
                const float w0 = wp[0], w1 = wp[1], w2 = wp[2], s0 = sc3[k], s1 = sc3[1024 + k], s2 = sc3[2048 + k];
                a[0][0] += s0 * w0; a[0][1] += s0 * w1; a[0][2] += s0 * w2; a[1][0] += s1 * w0; a[1][1] += s1 * w1; a[1][2] += s1 * w2; a[2][0] += s2 * w0; a[2][1] += s2 * w1; a[2][2] += s2 * w2;
            }
#pragma unroll
            for (int r = 0; r < 3; ++r)
#pragma unroll
                for (int c = 0; c < 3; ++c) mred[kq * 72 + r * 24 + c8 * 3 + c] = a[r][c];
            __syncthreads();
            if (tid < 72) {
                const int r = tid / 24, cc = cb * 24 + tid % 24;
                float s = P.b_ada[cc];
                for (int g = 0; g < 64; ++g) s += mred[g * 72 + tid];
                MOD[r * 6144 + cc] = s; modl[tid] = s;
                if (cc >= 1024 && cc < 2048) F1V[r * 1024 + cc - 1024] = P.norm1[cc - 1024] * (1.f + s);
                if (cc >= 4096 && cc < 5120 && r < 2) FV[r * 1024 + cc - 4096] = P.norm2[cc - 4096] * (1.f + s);
            }
            __syncthreads();
        }
        for (int idx = gtid; idx < 64 * 1024; idx += NT) {
            const int k = idx & 1023, n = idx >> 10;
            const float v = n < 16 ? P.w_in[(size_t)k * INC + 1536 + n] : (n < 20 ? P.w_group[k * 4 + n - 16] : (n < 52 ? P.w_expert[k * 32 + n - 20] : 0.f));
            const unsigned h = f2bf(v); const bf16 lo = (bf16)f2bf(v - __uint_as_float(h << 16));
            if (n < 16) { WDH[idx] = (bf16)h; WDL[idx] = lo; } else { WRH[idx - 16 * 1024] = (bf16)h; WRL[idx - 16 * 1024] = lo; }
        }
        __syncthreads();
        for (int idx = gtid; idx < 8192 * 32; idx += NT) {
            const int pos = idx >> 5, f = idx & 31;
            const float inv = powf(10000.0f, -(float)(f & 15) / 16.0f);
            const float ang = (float)((f < 16) ? (pos >> 6) : (pos & 63)) * inv;
            ROPEC[idx] = cosf(ang); ROPES[idx] = sinf(ang);
        }
        LAS float* scr = (LAS float*)(lds + wave * 16640);
        for (int it = wave * G + bid; it < CONV_N0; it += NGW) conv_item(P, it, WIN, WOUT, WGU, WD, scr, lane);
    }
    SEAM(0);
    if (IN(2)) {
        typedef short s16x8 __attribute__((ext_vector_type(8)));
        const int l15 = lane & 15, c4 = lane >> 4;
        for (int task = wave * G + bid; task < MT / 16; task += NGW) {
            const int r0 = task * 16, m = r0 < ML ? r0 / SEQ : 2, rr = r0 + l15, k0 = 8 * c4;
            const float* xr = (rr < ML ? P.x + (size_t)rr * DM : P.ctx + (size_t)(rr - ML) * DM) + k0;
            float ssq = 0.f;
#pragma unroll 8
            for (int s = 0; s < 32; ++s) { const f32x4 xa = *(const f32x4*)(xr + 32 * s), xb = *(const f32x4*)(xr + 32 * s + 4);
                ssq += xa.x * xa.x + xa.y * xa.y + xa.z * xa.z + xa.w * xa.w + xb.x * xb.x + xb.y * xb.y + xb.z * xb.z + xb.w * xb.w; }
            ssq += __shfl_xor(ssq, 16); ssq += __shfl_xor(ssq, 32);
            const float rstd = rsqrtf(ssq * (1.f / DM) + EPS);
            bf16* ho = HX + (size_t)rr * DM + k0;
            const float* fv = F1V + m * 1024 + k0; const float* shv = MOD + m * 6144 + k0;
            const bf16* wh = WDH + (size_t)l15 * 1024 + k0; const bf16* wl = WDL + (size_t)l15 * 1024 + k0;
            pg8::f32x4 acc = {0.f, 0.f, 0.f, 0.f};
#pragma unroll 4
            for (int s = 0; s < 32; ++s) {
                const f32x4 xa = *(const f32x4*)(xr + 32 * s), xb = *(const f32x4*)(xr + 32 * s + 4);
                const f32x4 fa = *(const f32x4*)(fv + 32 * s), fb = *(const f32x4*)(fv + 32 * s + 4), sa = *(const f32x4*)(shv + 32 * s), sb = *(const f32x4*)(shv + 32 * s + 4);
                const float h0 = xa.x * rstd * fa.x + sa.x, h1 = xa.y * rstd * fa.y + sa.y, h2_ = xa.z * rstd * fa.z + sa.z, h3 = xa.w * rstd * fa.w + sa.w;
                const float h4 = xb.x * rstd * fb.x + sb.x, h5 = xb.y * rstd * fb.y + sb.y, h6 = xb.z * rstd * fb.z + sb.z, h7 = xb.w * rstd * fb.w + sb.w;
                const u32x4 hw = {pg8::cvt_pk_bf16(h0, h1), pg8::cvt_pk_bf16(h2_, h3), pg8::cvt_pk_bf16(h4, h5), pg8::cvt_pk_bf16(h6, h7)};
                *(u32x4*)(ho + 32 * s) = hw;
                const u32x4 lw = {pg8::cvt_pk_bf16(h0 - bflo(hw.x), h1 - bfhi(hw.x)), pg8::cvt_pk_bf16(h2_ - bflo(hw.y), h3 - bfhi(hw.y)),
                                  pg8::cvt_pk_bf16(h4 - bflo(hw.z), h5 - bfhi(hw.z)), pg8::cvt_pk_bf16(h6 - bflo(hw.w), h7 - bfhi(hw.w))};
                const s16x8 ah = __builtin_bit_cast(s16x8, hw), alo = __builtin_bit_cast(s16x8, lw);
                const s16x8 bh = *(const s16x8*)(wh + 32 * s), bl = *(const s16x8*)(wl + 32 * s);
                acc = __builtin_amdgcn_mfma_f32_16x16x32_bf16(ah, bh, acc, 0, 0, 0);
                acc = __builtin_amdgcn_mfma_f32_16x16x32_bf16(ah, bl, acc, 0, 0, 0);
                acc = __builtin_amdgcn_mfma_f32_16x16x32_bf16(alo, bh, acc, 0, 0, 0);
            }
            const float db = P.dt_bias[l15];
#pragma unroll
            for (int rg = 0; rg < 4; ++rg) DT[(r0 + 4 * c4 + rg) * 16 + l15] = softplus_f(acc[rg] + db);
        }
    }
    SEAM(2);
    if (IN(3)) {
        pg8::Gemm g{HX, WIN, MT, PC, DM}; pg8::StaticOrder S_; S_.init(MT, PC, G, bid);
        EpiStoreBf16 E{PR, PC};
        pg8::gemm_phase<EpiStoreBf16, pg8::StaticOrder, true, true>(lds, g, S_, E);
        const int nwg = (MT / 256) * (PC / 256), extra = nwg % G;
        if (extra == 0 || bid >= extra) {
            const int nfill = extra == 0 ? G : G - extra, rank = extra == 0 ? bid : bid - extra;
            LAS float* scr = (LAS float*)(lds + wave * 16640);
            for (int it = CONV_N0 + wave * nfill + rank; it < CONV_N1; it += nfill * 8) conv_item(P, it, WIN, WOUT, WGU, WD, scr, lane);
        }
    }
    SEAM(3);
    if (IN(4)) {
        {
            const int sub = tid >> 8, t8 = tid & 255, cg8 = t8 & 7, jq = t8 >> 3;
            LAS unsigned char* T = lds + sub * 17408;
            for (int ip = bid; ip < NCH * 8; ip += G) {
                const int q = ip >> 3, cg = (ip & 7) * 2 + sub, r0 = chunk_row0(q), c0 = cg * 64 + cg8 * 8;
                int s0, sl;
                if (q < 128) { s0 = (q >> 6) * SEQ; sl = SEQ; } else { s0 = ML + ((q - 128) >> 1) * CTXL; sl = CTXL; }
                u32x4 xin[8];
#pragma unroll
                for (int w = 0; w < 8; ++w) { const int rr = r0 + 4 * jq + w - 2; xin[w] = (u32x4){0u, 0u, 0u, 0u};
                    if (rr >= s0 && rr < s0 + sl) xin[w] = *(const u32x4*)(PR + (size_t)rr * PC + C_XBC + c0); }
                f32x4 wlo[5], whi[5];
#pragma unroll
                for (int w = 0; w < 5; ++w) { wlo[w] = *(const f32x4*)(P.conv_w + w * 1024 + c0); whi[w] = *(const f32x4*)(P.conv_w + w * 1024 + c0 + 4); }
                const f32x4 b0 = *(const f32x4*)(P.conv_b + c0), b1 = *(const f32x4*)(P.conv_b + c0 + 4);
                __syncthreads();
                unsigned ow[4][4];
#pragma unroll
                for (int jr = 0; jr < 4; ++jr) {
                    float a[8] = {b0.x, b0.y, b0.z, b0.w, b1.x, b1.y, b1.z, b1.w};
#pragma unroll
                    for (int w = 0; w < 5; ++w) { const u32x4 xv = xin[jr + w];
                        a[0] += wlo[w].x * bflo(xv.x); a[1] += wlo[w].y * bfhi(xv.x); a[2] += wlo[w].z * bflo(xv.y); a[3] += wlo[w].w * bfhi(xv.y);
                        a[4] += whi[w].x * bflo(xv.z); a[5] += whi[w].y * bfhi(xv.z); a[6] += whi[w].z * bflo(xv.w); a[7] += whi[w].w * bfhi(xv.w); }
#pragma unroll
                    for (int i = 0; i < 4; ++i) ow[jr][i] = pg8::cvt_pk_bf16(silu_fast(a[2 * i]), silu_fast(a[2 * i + 1]));
                    *(u32x4*)(U + (size_t)(r0 + 4 * jq + jr) * 1024 + c0) = (u32x4){ow[jr][0], ow[jr][1], ow[jr][2], ow[jr][3]};
                }
                if (cg < 12) {
#pragma unroll
                    for (int i = 0; i < 8; ++i) {
                        const unsigned e0 = (i & 1) ? (ow[0][i >> 1] >> 16) : (ow[0][i >> 1] & 0xffffu), e1 = (i & 1) ? (ow[1][i >> 1] >> 16) : (ow[1][i >> 1] & 0xffffu);
                        const unsigned e2 = (i & 1) ? (ow[2][i >> 1] >> 16) : (ow[2][i >> 1] & 0xffffu), e3 = (i & 1) ? (ow[3][i >> 1] >> 16) : (ow[3][i >> 1] & 0xffffu);
                        *(LAS u32x2*)(T + (cg8 * 8 + i) * 272 + jq * 8) = (u32x2){e0 | (e1 << 16), e2 | (e3 << 16)};
                    }
                }
                __syncthreads();
                if (cg < 12) {
                    bf16* dst = cg < 8 ? XST + ((size_t)q * 512 + cg * 64) * 128 : BT + ((size_t)q * 256 + (cg - 8) * 64) * 128;
#pragma unroll
                    for (int hh = 0; hh < 4; ++hh) { const int pc = t8 + 256 * hh, row = pc >> 4, ch = pc & 15; const u32x4 v = *(const LAS u32x4*)(T + row * 272 + ch * 16); *(u32x4*)(dst + (size_t)row * 128 + ch * 8) = v; }
                }
            }
            __syncthreads();
        }
        const int p4x = (NCH * 8) % G, p4skip = (p4x != 0 && bid < p4x), vG = p4x ? G - p4x : G, vbid = p4x ? bid - p4x : bid;
        if (!p4skip)
        for (int idx = vbid * NTHREADS + tid; idx < MT * 8; idx += vG * NTHREADS) {
            const int r = idx >> 3, kvh = (idx >> 2) & 1, d0 = (idx & 3) * 8;
            const u32x4 ka = *(const u32x4*)(PR + (size_t)r * PC + C_K + kvh * 64 + d0), kb = *(const u32x4*)(PR + (size_t)r * PC + C_K + kvh * 64 + 32 + d0);
            u32x4 oa = ka, ob = kb;
            if (r < ML) {
                const int pos = r % SEQ;
                const f32x4 c0 = *(const f32x4*)(ROPEC + pos * 32 + d0), c1 = *(const f32x4*)(ROPEC + pos * 32 + d0 + 4), s0_ = *(const f32x4*)(ROPES + pos * 32 + d0), s1_ = *(const f32x4*)(ROPES + pos * 32 + d0 + 4);
                const float cs[8] = {c0.x, c0.y, c0.z, c0.w, c1.x, c1.y, c1.z, c1.w}, sn[8] = {s0_.x, s0_.y, s0_.z, s0_.w, s1_.x, s1_.y, s1_.z, s1_.w};
                const unsigned kaw[4] = {ka.x, ka.y, ka.z, ka.w}, kbw[4] = {kb.x, kb.y, kb.z, kb.w};
                unsigned oaw[4], obw[4];
#pragma unroll
                for (int i = 0; i < 4; ++i) {
                    const float a0 = bflo(kaw[i]), a1 = bfhi(kaw[i]), b0 = bflo(kbw[i]), b1 = bfhi(kbw[i]);
                    oaw[i] = pk2(a0 * cs[2 * i] - b0 * sn[2 * i], a1 * cs[2 * i + 1] - b1 * sn[2 * i + 1]);
                    obw[i] = pk2(b0 * cs[2 * i] + a0 * sn[2 * i], b1 * cs[2 * i + 1] + a1 * sn[2 * i + 1]);
                }
                oa = (u32x4){oaw[0], oaw[1], oaw[2], oaw[3]}; ob = (u32x4){obw[0], obw[1], obw[2], obw[3]};
            }
            *(u32x4*)(KR + (size_t)r * 128 + kvh * 64 + d0) = oa; *(u32x4*)(KR + (size_t)r * 128 + kvh * 64 + 32 + d0) = ob;
        }
        if (!p4skip)
        for (int sidx = wave * vG + vbid; sidx < NCH * 16; sidx += vG * 8) {
            const int q = sidx >> 4, dh = sidx & 15, dir = dh >> 3;
            const int r0 = chunk_row0(q);
            const float A = -expf(P.a_log[dh]);
            const int i0 = dir == 0 ? 2 * lane : 127 - 2 * lane, i1 = dir == 0 ? 2 * lane + 1 : 126 - 2 * lane;
            const float v0 = DT[(r0 + i0) * 16 + dh] * A, v1 = DT[(r0 + i1) * 16 + dh] * A;
            float incl = v0 + v1;
#pragma unroll
            for (int o = 1; o < 64; o <<= 1) { const float t = __shfl_up(incl, o); if (lane >= o) incl += t; }
            const float excl = incl - (v0 + v1);
            ACS[(q * 16 + dh) * 128 + i0] = excl + v0; ACS[(q * 16 + dh) * 128 + i1] = incl;
            if (lane == 63) AL[q * 16 + dh] = incl;
        }
    }
    SEAM(4);
    if (IN(5)) {
        typedef short s16x8 __attribute__((ext_vector_type(8)));
        const int l15 = lane & 15, l4 = lane >> 4;
        LAS float* wv = (LAS float*)lds + wave * 128;
        for (int un_ = bid; un_ < 512 + 64; un_ += G) {
            const bool piece = un_ >= 512; const int nt_only = piece ? ((un_ - 512) & 3) : -1;
            const int un = piece ? 512 + ((un_ - 512) >> 2) : (G == 256) ? (((((un_ & 7) | (((un_ & 255) >> 4) << 3)) + 128 * (un_ >> 8)) << 1) | ((un_ >> 3) & 1)) : un_;
            const int q = un >> 2, g = (un >> 1) & 1, nh = un & 1, head = g * 4 + (wave & 3), dh = (wave >> 2) * 8 + head, r0 = chunk_row0(q);
            const bf16* bt = BT + ((size_t)q * 256 + g * 128 + nh * 64 + l15) * 128 + 8 * l4;
            const bf16* xt = XST + ((size_t)q * 512 + head * 64 + l15) * 128 + 8 * l4;
            {   const float al = AL[q * 16 + dh];
#pragma unroll
                for (int hh = 0; hh < 2; ++hh) { const int j = lane + 64 * hh; wv[j] = __expf(al - ACS[(q * 16 + dh) * 128 + j]) * DT[(r0 + j) * 16 + dh]; } }
            pg8::f32x4 acc[4][4];
#pragma unroll
            for (int a = 0; a < 4; ++a)
#pragma unroll
                for (int b_ = 0; b_ < 4; ++b_) acc[a][b_] = (pg8::f32x4){0.f, 0.f, 0.f, 0.f};
            __builtin_amdgcn_wave_barrier();
#pragma unroll 1
            for (int kp = 0; kp < 2; ++kp) {
                s16x8 bfr[2][4]; u32x4 xraw[2][4];
#pragma unroll
                for (int k2 = 0; k2 < 2; ++k2)
#pragma unroll
                    for (int t4 = 0; t4 < 4; ++t4) { bfr[k2][t4] = *(const s16x8*)(bt + (size_t)t4 * 16 * 128 + 32 * (2 * kp + k2)); xraw[k2][t4] = *(const u32x4*)(xt + (size_t)t4 * 16 * 128 + 32 * (2 * kp + k2)); }
#pragma unroll
                for (int k2 = 0; k2 < 2; ++k2) {
                    const int ks = 2 * kp + k2;
                    const pg8::f32x4 w0 = *(const LAS pg8::f32x4*)(wv + 32 * ks + 8 * l4), w1 = *(const LAS pg8::f32x4*)(wv + 32 * ks + 8 * l4 + 4);
#pragma unroll
                    for (int pt = 0; pt < 4; ++pt) {
                        const u32x4 raw = xraw[k2][pt];
                        u32x4 o; o.x = pg8::cvt_pk_bf16(bflo(raw.x) * w0[0], bfhi(raw.x) * w0[1]); o.y = pg8::cvt_pk_bf16(bflo(raw.y) * w0[2], bfhi(raw.y) * w0[3]);
                        o.z = pg8::cvt_pk_bf16(bflo(raw.z) * w1[0], bfhi(raw.z) * w1[1]); o.w = pg8::cvt_pk_bf16(bflo(raw.w) * w1[2], bfhi(raw.w) * w1[3]);
                        const s16x8 xf = __builtin_bit_cast(s16x8, o);
#pragma unroll
                        for (int nt = 0; nt < 4; ++nt) { if (piece && nt != nt_only) continue; acc[nt][pt] = __builtin_amdgcn_mfma_f32_16x16x32_bf16(bfr[k2][nt], xf, acc[nt][pt], 0, 0, 0); }
                    }
                }
            }
            __builtin_amdgcn_wave_barrier();
            bf16* so = S + ((size_t)q * 16 + dh) * 8192 + nh * 64;
#pragma unroll
            for (int nt = 0; nt < 4; ++nt)
#pragma unroll
                for (int pt = 0; pt < 4; ++pt) { if (piece && nt != nt_only) continue; u32x2 w; w.x = pg8::cvt_pk_bf16(acc[nt][pt][0], acc[nt][pt][1]); w.y = pg8::cvt_pk_bf16(acc[nt][pt][2], acc[nt][pt][3]);
                    *(u32x2*)(so + (size_t)(16 * pt + l15) * 128 + 16 * nt + 4 * l4) = w; }
        }
    }
    SEAM(5);
    if (IN(6)) {
        for (int idx = gtid; idx < NB * 16 * 2048; idx += NT) {
            const int pn = (idx & 2047) * 4, dh = (idx >> 11) & 15, b = idx >> 15, dir = dh >> 3;
            const int qa = dir == 0 ? 128 + 2 * b : 129 + 2 * b, qb = dir == 0 ? 129 + 2 * b : 128 + 2 * b;
            float h[4];
            {   const u32x2 sa = *(const u32x2*)(S + ((size_t)qa * 16 + dh) * 8192 + pn), sb = *(const u32x2*)(S + ((size_t)qb * 16 + dh) * 8192 + pn);
                const float e = __expf(AL[qb * 16 + dh]);
                h[0] = e * bflo(sa.x) + bflo(sb.x); h[1] = e * bfhi(sa.x) + bfhi(sb.x); h[2] = e * bflo(sa.y) + bflo(sb.y); h[3] = e * bfhi(sa.y) + bfhi(sb.y); }
            for (int c8 = 0; c8 < 64; c8 += 8) {
                u32x2 t[8]; float e[8];
#pragma unroll
                for (int k = 0; k < 8; ++k) { const int q = 64 * b + (dir == 0 ? c8 + k : 63 - c8 - k); t[k] = *(const u32x2*)(S + ((size_t)q * 16 + dh) * 8192 + pn); e[k] = __expf(AL[q * 16 + dh]); }
#pragma unroll
                for (int k = 0; k < 8; ++k) { const int q = 64 * b + (dir == 0 ? c8 + k : 63 - c8 - k);
                    u32x2 o; o.x = pk2(h[0], h[1]); o.y = pk2(h[2], h[3]);
                    *(u32x2*)(S + ((size_t)q * 16 + dh) * 8192 + pn) = o;
                    h[0] = e[k] * h[0] + bflo(t[k].x); h[1] = e[k] * h[1] + bfhi(t[k].x); h[2] = e[k] * h[2] + bflo(t[k].y); h[3] = e[k] * h[3] + bfhi(t[k].y); }
            }
        }
    }
    SEAM(6);
    if (IN(7)) {
        {
            typedef short s16x8 __attribute__((ext_vector_type(8)));
            constexpr int CBP = 132;
            LAS float* CBs = (LAS float*)lds;
            LAS float* vec = (LAS float*)(lds + 69632) + wave * 512;
            LAS float* red = (LAS float*)(lds + 86016);
            const int l15 = lane & 15, l4 = lane >> 4;
            for (int un_ = bid; un_ < 256; un_ += G) {
                const int un = (G == 256) ? ((((un_ & 7) | ((un_ >> 4) << 3)) << 1) | ((un_ >> 3) & 1)) : un_;
                const int q = un >> 1, i0 = (un & 1) * 64, r0 = q * 128;
                __syncthreads();
                {
                    const int g = wave >> 2, it = wave & 3;
                    pg8::f32x4 cacc[8];
#pragma unroll
                    for (int a = 0; a < 8; ++a) cacc[a] = (pg8::f32x4){0.f, 0.f, 0.f, 0.f};
                    const bf16* cp = U + (size_t)(r0 + i0 + 16 * it + l15) * 1024 + 768 + g * 128 + 8 * l4;
                    const bf16* bp = U + (size_t)(r0 + l15) * 1024 + 512 + g * 128 + 8 * l4;
#pragma unroll
                    for (int ks = 0; ks < 4; ++ks) {
                        const s16x8 af = *(const s16x8*)(cp + 32 * ks);
#pragma unroll
                        for (int jt = 0; jt < 8; ++jt) { const s16x8 bf = *(const s16x8*)(bp + (size_t)jt * 16 * 1024 + 32 * ks); cacc[jt] = __builtin_amdgcn_mfma_f32_16x16x32_bf16(af, bf, cacc[jt], 0, 0, 0); }
                    }
#pragma unroll
                    for (int jt = 0; jt < 8; ++jt)
#pragma unroll
                        for (int rg = 0; rg < 4; ++rg) CBs[(g * 64 + 16 * it + 4 * l4 + rg) * CBP + 16 * jt + l15] = cacc[jt][rg];
                }
                const int head = wave, g = head >> 2;
                {
#pragma unroll
                    for (int hh = 0; hh < 2; ++hh) { const int j = lane + 64 * hh;
                        vec[j] = ACS[(q * 16 + head) * 128 + j]; vec[128 + j] = ACS[(q * 16 + 8 + head) * 128 + j];
                        vec[256 + j] = DT[(r0 + j) * 16 + head]; vec[384 + j] = DT[(r0 + j) * 16 + 8 + head]; }
                }
                __builtin_amdgcn_wave_barrier();
                pg8::f32x4 acc[4][4];
#pragma unroll
                for (int a = 0; a < 4; ++a)
#pragma unroll
                    for (int b_ = 0; b_ < 4; ++b_) acc[a][b_] = (pg8::f32x4){0.f, 0.f, 0.f, 0.f};
                const bf16* xt = XST + ((size_t)q * 512 + head * 64 + l15) * 128 + 8 * l4;
#pragma unroll 1
                for (int dir = 0; dir < 2; ++dir) {
                    const int dh = dir * 8 + head;
                    const bf16* hp = S + ((size_t)q * 16 + dh) * 8192 + (size_t)l15 * 128 + 8 * l4;
                    float sc_[4];
#pragma unroll
                    for (int it = 0; it < 4; ++it) sc_[it] = __expf(vec[dir * 128 + i0 + 16 * it + l15]);
#pragma unroll 1
                    for (int kp = 0; kp < 2; ++kp) {
                        s16x8 hf[2][4]; u32x4 craw[2][4];
#pragma unroll
                        for (int k2 = 0; k2 < 2; ++k2)
#pragma unroll
                            for (int t4 = 0; t4 < 4; ++t4) { hf[k2][t4] = *(const s16x8*)(hp + (size_t)t4 * 16 * 128 + 32 * (2 * kp + k2));
                                craw[k2][t4] = *(const u32x4*)(U + (size_t)(r0 + i0 + 16 * t4 + l15) * 1024 + 768 + g * 128 + 32 * (2 * kp + k2) + 8 * l4); }
#pragma unroll
                        for (int k2 = 0; k2 < 2; ++k2)
#pragma unroll
                            for (int it = 0; it < 4; ++it) {
                                const u32x4 raw = craw[k2][it]; const float s_ = sc_[it];
                                const s16x8 cf = __builtin_bit_cast(s16x8, (u32x4){pg8::cvt_pk_bf16(bflo(raw.x) * s_, bfhi(raw.x) * s_), pg8::cvt_pk_bf16(bflo(raw.y) * s_, bfhi(raw.y) * s_),
                                                                                  pg8::cvt_pk_bf16(bflo(raw.z) * s_, bfhi(raw.z) * s_), pg8::cvt_pk_bf16(bflo(raw.w) * s_, bfhi(raw.w) * s_)});
#pragma unroll
                                for (int pt = 0; pt < 4; ++pt) acc[it][pt] = __builtin_amdgcn_mfma_f32_16x16x32_bf16(hf[k2][pt], cf, acc[it][pt], 0, 0, 0);
                            }
                    }
                }
                __syncthreads();
                const float dsk = P.d_skip[head];
                u32x2 exv[4][4], ezv[4][4];
#pragma unroll
                for (int it = 0; it < 4; ++it)
#pragma unroll
                    for (int pt = 0; pt < 4; ++pt) { const int row = r0 + i0 + 16 * it + l15, ch0 = head * 64 + 16 * pt + 4 * l4;
                        exv[it][pt] = *(const u32x2*)(U + (size_t)row * 1024 + ch0); ezv[it][pt] = *(const u32x2*)(PR + (size_t)row * PC + C_Z + ch0); }
#pragma unroll 2
                for (int ks = 0; ks < 4; ++ks) {
                    s16x8 xf[4];
#pragma unroll
                    for (int pt = 0; pt < 4; ++pt) xf[pt] = *(const s16x8*)(xt + (size_t)pt * 16 * 128 + 32 * ks);
                    const int j0 = 32 * ks + 8 * l4;
                    float afj[8], abj[8], dfj[8], dbj[8];
#pragma unroll
                    for (int i = 0; i < 8; ++i) { afj[i] = vec[j0 + i]; abj[i] = vec[128 + j0 + i]; dfj[i] = vec[256 + j0 + i]; dbj[i] = vec[384 + j0 + i]; }
#pragma unroll
                    for (int it = 0; it < 4; ++it) {
                        const int i = i0 + 16 * it + l15;
                        const float afi = vec[i], abi = vec[128 + i];
                        const LAS float* cbp = CBs + (g * 64 + 16 * it + l15) * CBP + j0;
                        const pg8::f32x4 c0 = *(const LAS pg8::f32x4*)cbp, c1 = *(const LAS pg8::f32x4*)(cbp + 4);
                        const float cv[8] = {c0[0], c0[1], c0[2], c0[3], c1[0], c1[1], c1[2], c1[3]};
                        float lv[8];
#pragma unroll
                        for (int jj = 0; jj < 8; ++jj) { const int j = j0 + jj;
                            const float tf = j <= i ? __expf(afi - afj[jj]) * dfj[jj] : 0.f;
                            const float tb = j >= i ? __expf(abi - abj[jj]) * dbj[jj] : 0.f;
                            lv[jj] = cv[jj] * (tf + tb); }
                        const s16x8 lf = __builtin_bit_cast(s16x8, (u32x4){pg8::cvt_pk_bf16(lv[0], lv[1]), pg8::cvt_pk_bf16(lv[2], lv[3]), pg8::cvt_pk_bf16(lv[4], lv[5]), pg8::cvt_pk_bf16(lv[6], lv[7])});
#pragma unroll
                        for (int pt = 0; pt < 4; ++pt) acc[it][pt] = __builtin_amdgcn_mfma_f32_16x16x32_bf16(xf[pt], lf, acc[it][pt], 0, 0, 0);
                    }
                }
                float ssq[4];
#pragma unroll
                for (int it = 0; it < 4; ++it) {
                    const int row = r0 + i0 + 16 * it + l15;
                    float s_ = 0.f;
#pragma unroll
                    for (int pt = 0; pt < 4; ++pt) {
                        const int ch0 = head * 64 + 16 * pt + 4 * l4;
                        const u32x2 xv = exv[it][pt], zv = ezv[it][pt];
                        const float xs[4] = {bflo(xv.x), bfhi(xv.x), bflo(xv.y), bfhi(xv.y)}, zs[4] = {bflo(zv.x), bfhi(zv.x), bflo(zv.y), bfhi(zv.y)};
#pragma unroll
                        for (int rg = 0; rg < 4; ++rg) { float y = acc[it][pt][rg] + dsk * xs[rg]; y *= silu_fast(zs[rg]); acc[it][pt][rg] = y; s_ += y * y; }
                    }
                    s_ += __shfl_xor(s_, 16); s_ += __shfl_xor(s_, 32);
                    ssq[it] = s_;
                }
                if (l4 == 0) {
#pragma unroll
                    for (int it = 0; it < 4; ++it) red[wave * 64 + 16 * it + l15] = ssq[it];
                }
                __syncthreads();
#pragma unroll
                for (int it = 0; it < 4; ++it) {
                    const int il = 16 * it + l15, row = r0 + i0 + il;
                    float tot = 0.f;
#pragma unroll
                    for (int w = 0; w < 8; ++w) tot += red[w * 64 + il];
                    const float rstd = rsqrtf(tot * (1.f / 512.f) + EPS);
#pragma unroll
                    for (int pt = 0; pt < 4; ++pt) { const int ch0 = head * 64 + 16 * pt + 4 * l4; const f32x4 gn = *(const f32x4*)(P.ssd_norm + ch0);
                        u32x2 o; o.x = pg8::cvt_pk_bf16(acc[it][pt][0] * rstd * gn.x, acc[it][pt][1] * rstd * gn.y); o.y = pg8::cvt_pk_bf16(acc[it][pt][2] * rstd * gn.z, acc[it][pt][3] * rstd * gn.w);
                        *(u32x2*)(MIX + (size_t)row * 1024 + ch0) = o; }
                }
            }
            __syncthreads();
        }
        {
            typedef float f32x16 __attribute__((ext_vector_type(16)));
            typedef short s16x8 __attribute__((ext_vector_type(8)));
            typedef short s16x4 __attribute__((ext_vector_type(4)));
            const int r32 = lane & 31, hi_ = lane >> 5;
            LAS unsigned char* KV = lds;
            LAS float* wsf = (LAS float*)(lds + 32768) + wave * 64;
            const float C2 = 0.125f * 1.4426950408889634f;
            const int vboff = ((lane >> 4) & 1) * 32 + (lane & 3) * 8 + (4 * hi_ + ((lane & 15) >> 2)) * 64;
            for (int L_ = bid; L_ < 512; L_ += G) {
                int pair = L_ & 1, kvh = (L_ >> 1) & 1, nb = (L_ >> 2) & 63, b = L_ >> 8;
                if (G == 256) { const int r_ = (L_ & 255) >> 3, pg_ = (((L_ >> 8) * 8 + (L_ & 7)) * 16) + (r_ >> 1); pair = r_ & 1; nb = pg_ & 63; kvh = (pg_ >> 6) & 1; b = pg_ >> 7; }
                const int hq = kvh * 4 + pair * 2 + (wave >> 2), qq = (wave & 3) * 32 + r32;
                const int qrow = b * SEQ + nb * 128 + qq, pos = nb * 128 + qq;
                s16x8 qr[4];
                {
                    const bf16* qp = PR + (size_t)qrow * PC + C_Q + hq * 64 + 8 * hi_;
                    u32x4 raw[4];
#pragma unroll
                    for (int d0 = 0; d0 < 4; ++d0) raw[d0] = *(const u32x4*)(qp + 16 * d0);
#pragma unroll
                    for (int dd = 0; dd < 2; ++dd) {
                        const float* cp = ROPEC + pos * 32 + 16 * dd + 8 * hi_; const float* sp = ROPES + pos * 32 + 16 * dd + 8 * hi_;
                        const f32x4 c0 = *(const f32x4*)cp, c1 = *(const f32x4*)(cp + 4), s0_ = *(const f32x4*)sp, s1_ = *(const f32x4*)(sp + 4);
                        const float cs[8] = {c0.x, c0.y, c0.z, c0.w, c1.x, c1.y, c1.z, c1.w}, sn[8] = {s0_.x, s0_.y, s0_.z, s0_.w, s1_.x, s1_.y, s1_.z, s1_.w};
                        const unsigned aw[4] = {raw[dd].x, raw[dd].y, raw[dd].z, raw[dd].w}, bw[4] = {raw[dd + 2].x, raw[dd + 2].y, raw[dd + 2].z, raw[dd + 2].w};
                        unsigned oa[4], ob[4];
#pragma unroll
                        for (int i = 0; i < 4; ++i) {
                            const float a0 = bflo(aw[i]), a1 = bfhi(aw[i]), b0 = bflo(bw[i]), b1 = bfhi(bw[i]);
                            oa[i] = pk2((a0 * cs[2 * i] - b0 * sn[2 * i]) * C2, (a1 * cs[2 * i + 1] - b1 * sn[2 * i + 1]) * C2);
                            ob[i] = pk2((b0 * cs[2 * i] + a0 * sn[2 * i]) * C2, (b1 * cs[2 * i + 1] + a1 * sn[2 * i + 1]) * C2);
                        }
                        qr[dd] = __builtin_bit_cast(s16x8, (u32x4){oa[0], oa[1], oa[2], oa[3]});
                        qr[dd + 2] = __builtin_bit_cast(s16x8, (u32x4){ob[0], ob[1], ob[2], ob[3]});
                    }
                }
                f32x16 o0 = {0.f}, o1 = {0.f};
#pragma unroll
                for (int r = 0; r < 16; ++r) { o0[r] = 0.f; o1[r] = 0.f; }
                float m_run = 0.f, l_run = 0.f; bool first = true;
                f32x16 negm;
#pragma unroll
                for (int r = 0; r < 16; ++r) negm[r] = 0.f;
                const int tfirst = 0;
                auto tile_row0 = [&](int t) -> int { return t < 4 ? ML + b * CTXL + 64 * t : b * SEQ + (nb - 1) * 128 + 64 * (t - 4); };
                auto tile_ok = [&](int t) -> bool { return !((nb == 0 && (t == 4 || t == 5)) || (nb == 63 && (t == 8 || t == 9))); };
                u32x4 kreg, vreg;
                {
                    const int row0 = tile_row0(tfirst);
                    kreg = *(const u32x4*)(KR + (size_t)(row0 + lane) * 128 + kvh * 64 + wave * 8);
                    vreg = *(const u32x4*)(PR + (size_t)(row0 + 16 * (wave & 3) + (lane >> 2)) * PC + C_V + kvh * 64 + (wave >> 2) * 32 + (lane & 3) * 8);
                }
                auto tile_next = [&](int t) -> int { int tn = t + 1; while (tn < 10 && !tile_ok(tn)) ++tn; return tn; };
                auto tile_load = [&](int t) { const int row0 = tile_row0(t);
                    kreg = *(const u32x4*)(KR + (size_t)(row0 + lane) * 128 + kvh * 64 + wave * 8);
                    vreg = *(const u32x4*)(PR + (size_t)(row0 + 16 * (wave & 3) + (lane >> 2)) * PC + C_V + kvh * 64 + (wave >> 2) * 32 + (lane & 3) * 8); };
                int cur = 0;
                __syncthreads();
                *(LAS u32x4*)(KV + wave * 1024 + lane * 16) = kreg; *(LAS u32x4*)(KV + 8192 + wave * 1024 + lane * 16) = vreg;
                { const int t1 = tile_next(0); if (t1 < 10) tile_load(t1); }
                __syncthreads();
                for (int t = 0; t < 10; t = tile_next(t)) {
                    LAS unsigned char* Kb = KV + cur * 16384; LAS unsigned char* Vb = Kb + 8192;
                    const int tn = tile_next(t);
                    if (tn < 10) {
                        LAS unsigned char* Kn = KV + (cur ^ 1) * 16384;
                        *(LAS u32x4*)(Kn + wave * 1024 + lane * 16) = kreg; *(LAS u32x4*)(Kn + 8192 + wave * 1024 + lane * 16) = vreg;
                        const int t2 = tile_next(tn); if (t2 < 10) tile_load(t2);
                    }
                    f32x16 p0, p1;
                    {   const s16x8 b0 = *(const LAS s16x8*)(Kb + hi_ * 1024 + r32 * 16), b1 = *(const LAS s16x8*)(Kb + hi_ * 1024 + r32 * 16 + 512);
                        p0 = __builtin_amdgcn_mfma_f32_32x32x16_bf16(b0, qr[0], negm, 0, 0, 0);
                        p1 = __builtin_amdgcn_mfma_f32_32x32x16_bf16(b1, qr[0], negm, 0, 0, 0); }
#pragma unroll
                    for (int d0 = 1; d0 < 4; ++d0) {
                        const s16x8 b0 = *(const LAS s16x8*)(Kb + d0 * 2048 + hi_ * 1024 + r32 * 16);
                        const s16x8 b1 = *(const LAS s16x8*)(Kb + d0 * 2048 + hi_ * 1024 + r32 * 16 + 512);
                        p0 = __builtin_amdgcn_mfma_f32_32x32x16_bf16(b0, qr[d0], p0, 0, 0, 0);
                        p1 = __builtin_amdgcn_mfma_f32_32x32x16_bf16(b1, qr[d0], p1, 0, 0, 0);
                    }
                    if (__builtin_amdgcn_readfirstlane(t) == 4 || __builtin_amdgcn_readfirstlane(t) == 5) {
                        asm volatile("" ::: "memory");
                        const int kb0 = 64 * (t - 4) + 4 * hi_;
#pragma unroll
                        for (int r = 0; r < 16; ++r) { const int kk = kb0 + (r & 3) + 8 * (r >> 2); if (kk < qq) p0[r] = -INFINITY; if (kk + 32 < qq) p1[r] = -INFINITY; }
                    } else if (__builtin_amdgcn_readfirstlane(t) >= 8) {
                        asm volatile("" ::: "memory");
                        const int kb0 = 64 * (t - 8) + 4 * hi_;
#pragma unroll
                        for (int r = 0; r < 16; ++r) { const int kk = kb0 + (r & 3) + 8 * (r >> 2); if (kk > qq) p0[r] = -INFINITY; if (kk + 32 > qq) p1[r] = -INFINITY; }
                    }
                    float mx = fmaxf(p0[0], p1[0]);
#pragma unroll
                    for (int r = 1; r < 16; ++r) mx = fmaxf(mx, fmaxf(p0[r], p1[r]));
                    mx = fmaxf(mx, __shfl_xor(mx, 32));
                    if (__any(mx > (first ? -INFINITY : 8.0f))) {
                        asm volatile("" ::: "memory");
                        const float dl = first ? mx : fmaxf(mx, 0.f);
                        m_run += dl;
#pragma unroll
                        for (int r = 0; r < 16; ++r) { p0[r] -= dl; p1[r] -= dl; negm[r] = -m_run; }
                        const float f = __builtin_amdgcn_exp2f(-dl);
                        l_run *= f;
                        if (!first) {
                            if (hi_ == 0) wsf[r32] = f;
                            __builtin_amdgcn_wave_barrier();
#pragma unroll
                            for (int r = 0; r < 16; ++r) { const float a = wsf[(r & 3) + 8 * (r >> 2) + 4 * hi_]; o0[r] *= a; o1[r] *= a; }
                            __builtin_amdgcn_wave_barrier();
                        }
                        first = false;
                    }
                    float rs = 0.f;
#pragma unroll
                    for (int r = 0; r < 16; ++r) { p0[r] = __builtin_amdgcn_exp2f(p0[r]); p1[r] = __builtin_amdgcn_exp2f(p1[r]); rs += p0[r] + p1[r]; }
                    l_run += rs;
                    s16x8 pa[4];
                    pa[0] = __builtin_bit_cast(s16x8, (u32x4){pg8::cvt_pk_bf16(p0[0], p0[1]), pg8::cvt_pk_bf16(p0[2], p0[3]), pg8::cvt_pk_bf16(p0[4], p0[5]), pg8::cvt_pk_bf16(p0[6], p0[7])});
                    pa[1] = __builtin_bit_cast(s16x8, (u32x4){pg8::cvt_pk_bf16(p0[8], p0[9]), pg8::cvt_pk_bf16(p0[10], p0[11]), pg8::cvt_pk_bf16(p0[12], p0[13]), pg8::cvt_pk_bf16(p0[14], p0[15])});
                    pa[2] = __builtin_bit_cast(s16x8, (u32x4){pg8::cvt_pk_bf16(p1[0], p1[1]), pg8::cvt_pk_bf16(p1[2], p1[3]), pg8::cvt_pk_bf16(p1[4], p1[5]), pg8::cvt_pk_bf16(p1[6], p1[7])});
                    pa[3] = __builtin_bit_cast(s16x8, (u32x4){pg8::cvt_pk_bf16(p1[8], p1[9]), pg8::cvt_pk_bf16(p1[10], p1[11]), pg8::cvt_pk_bf16(p1[12], p1[13]), pg8::cvt_pk_bf16(p1[14], p1[15])});
#pragma unroll
                    for (int ks = 0; ks < 4; ++ks) {
                        typedef short v4i16_t __attribute__((ext_vector_type(4)));
                        const s16x4 l0 = __builtin_bit_cast(s16x4, __builtin_amdgcn_ds_read_tr16_b64_v4i16((LAS v4i16_t*)(Vb + vboff + ks * 1024)));
                        const s16x4 h0 = __builtin_bit_cast(s16x4, __builtin_amdgcn_ds_read_tr16_b64_v4i16((LAS v4i16_t*)(Vb + vboff + ks * 1024 + 512)));
                        const s16x4 l1 = __builtin_bit_cast(s16x4, __builtin_amdgcn_ds_read_tr16_b64_v4i16((LAS v4i16_t*)(Vb + vboff + 4096 + ks * 1024)));
                        const s16x4 h1 = __builtin_bit_cast(s16x4, __builtin_amdgcn_ds_read_tr16_b64_v4i16((LAS v4i16_t*)(Vb + vboff + 4096 + ks * 1024 + 512)));
                        const s16x8 v0 = (s16x8){l0[0], l0[1], l0[2], l0[3], h0[0], h0[1], h0[2], h0[3]}, v1 = (s16x8){l1[0], l1[1], l1[2], l1[3], h1[0], h1[1], h1[2], h1[3]};
                        o0 = __builtin_amdgcn_mfma_f32_32x32x16_bf16(pa[ks], v0, o0, 0, 0, 0);
                        o1 = __builtin_amdgcn_mfma_f32_32x32x16_bf16(pa[ks], v1, o1, 0, 0, 0);
                    }
                    __syncthreads();
                    cur ^= 1;
                }
                float l_tot = l_run + __shfl_xor(l_run, 32);
                l_tot += __builtin_amdgcn_exp2f(P.sinks[hq] * 1.4426950408889634f - m_run);
                if (hi_ == 0) wsf[r32] = 1.0f / l_tot;
                __builtin_amdgcn_wave_barrier();
                bf16* orow = MIX + (size_t)(b * SEQ + nb * 128 + (wave & 3) * 32) * 1024 + 512 + hq * 64 + r32;
#pragma unroll
                for (int r = 0; r < 16; ++r) { const int qi = (r & 3) + 8 * (r >> 2) + 4 * hi_; const float inv = wsf[qi];
                    orow[(size_t)qi * 1024] = (bf16)f2bf(o0[r] * inv); orow[(size_t)qi * 1024 + 32] = (bf16)f2bf(o1[r] * inv); }
                __builtin_amdgcn_wave_barrier();
            }
        }
    }
    SEAM(7);
    if (IN(8)) {
        pg8::Gemm g{MIX, WOUT, ML, DM, DM}; pg8::StaticOrder S_; S_.init(ML, DM, G, bid);
        EpiOutProj E{P.x, MOD, X1, SSQP};
        pg8::gemm_phase<EpiOutProj, pg8::StaticOrder, false, true>(lds, g, S_, E);
    }
    SEAM(8);
    if (IN(9)) {
        typedef short s16x8 __attribute__((ext_vector_type(8)));
        const int l15 = lane & 15, c4 = lane >> 4, sl = wave & 3, kh = wave >> 2;
        LAS float* lgs = (LAS float*)lds + (sl * 2 + kh) * 832;
        for (int tb = bid; tb * 4 < ML / 16; tb += G) {
            const int task = tb * 4 + sl, r0 = task * 16, b = r0 / SEQ;
            float rstd;
            {   const float* sp = SSQP + (size_t)(r0 + l15) * 16; const f32x4 a0 = *(const f32x4*)sp, a1 = *(const f32x4*)(sp + 4), a2 = *(const f32x4*)(sp + 8), a3 = *(const f32x4*)(sp + 12);
                const float t = (((a0.x + a0.y) + (a0.z + a0.w)) + ((a1.x + a1.y) + (a1.z + a1.w))) + (((a2.x + a2.y) + (a2.z + a2.w)) + ((a3.x + a3.y) + (a3.z + a3.w)));
                rstd = rsqrtf(t * (1.f / DM) + EPS); }
            const int k0 = kh * 512 + 8 * c4;
            const bf16* xr = X1 + (size_t)(r0 + l15) * DM + k0;
            bf16* ho = H2 + (size_t)(r0 + l15) * DM + k0;
            const float* fv = FV + b * 1024 + k0; const float* shv = MOD + b * 6144 + 3072 + k0;
            const bf16* wh = WRH + (size_t)l15 * 1024 + k0; const bf16* wl = WRL + (size_t)l15 * 1024 + k0;
            pg8::f32x4 acc[3];
#pragma unroll
            for (int a = 0; a < 3; ++a) acc[a] = (pg8::f32x4){0.f, 0.f, 0.f, 0.f};
#pragma unroll 4
            for (int s = 0; s < 16; ++s) {
                const u32x4 xw = *(const u32x4*)(xr + 32 * s);
                const f32x4 xa = {bflo(xw.x), bfhi(xw.x), bflo(xw.y), bfhi(xw.y)}, xb = {bflo(xw.z), bfhi(xw.z), bflo(xw.w), bfhi(xw.w)};
                const f32x4 fa = *(const f32x4*)(fv + 32 * s), fb = *(const f32x4*)(fv + 32 * s + 4), sa = *(const f32x4*)(shv + 32 * s), sb = *(const f32x4*)(shv + 32 * s + 4);
                const float h0 = xa.x * rstd * fa.x + sa.x, h1 = xa.y * rstd * fa.y + sa.y, h2_ = xa.z * rstd * fa.z + sa.z, h3 = xa.w * rstd * fa.w + sa.w;
                const float h4 = xb.x * rstd * fb.x + sb.x, h5 = xb.y * rstd * fb.y + sb.y, h6 = xb.z * rstd * fb.z + sb.z, h7 = xb.w * rstd * fb.w + sb.w;
                const u32x4 hw = {pg8::cvt_pk_bf16(h0, h1), pg8::cvt_pk_bf16(h2_, h3), pg8::cvt_pk_bf16(h4, h5), pg8::cvt_pk_bf16(h6, h7)};
                *(u32x4*)(ho + 32 * s) = hw;
                const u32x4 lw = {pg8::cvt_pk_bf16(h0 - bflo(hw.x), h1 - bfhi(hw.x)), pg8::cvt_pk_bf16(h2_ - bflo(hw.y), h3 - bfhi(hw.y)),
                                  pg8::cvt_pk_bf16(h4 - bflo(hw.z), h5 - bfhi(hw.z)), pg8::cvt_pk_bf16(h6 - bflo(hw.w), h7 - bfhi(hw.w))};
                const s16x8 ah = __builtin_bit_cast(s16x8, hw), alo = __builtin_bit_cast(s16x8, lw);
#pragma unroll
                for (int nt = 0; nt < 3; ++nt) {
                    const s16x8 bh = *(const s16x8*)(wh + (size_t)nt * 16 * 1024 + 32 * s), bl = *(const s16x8*)(wl + (size_t)nt * 16 * 1024 + 32 * s);
                    acc[nt] = __builtin_amdgcn_mfma_f32_16x16x32_bf16(ah, bh, acc[nt], 0, 0, 0);
                    acc[nt] = __builtin_amdgcn_mfma_f32_16x16x32_bf16(ah, bl, acc[nt], 0, 0, 0);
                    acc[nt] = __builtin_amdgcn_mfma_f32_16x16x32_bf16(alo, bh, acc[nt], 0, 0, 0);
                }
            }
            __syncthreads();
#pragma unroll
            for (int nt = 0; nt < 3; ++nt)
#pragma unroll
                for (int rg = 0; rg < 4; ++rg) lgs[(4 * c4 + rg) * 52 + 16 * nt + l15] = acc[nt][rg];
            __syncthreads();
            if (kh == 0 && lane < 16) {
                const int r = r0 + lane;
                const LAS float* lp = lgs + lane * 52; const LAS float* lq = lp + 832;
                float gl[4]; float gm = -INFINITY; int gi = 0;
#pragma unroll
                for (int e = 0; e < 4; ++e) { gl[e] = (lp[e] + lq[e]) + P.b_group[e]; if (gl[e] > gm) { gm = gl[e]; gi = e; } }
                float gs = 0.f;
#pragma unroll
                for (int e = 0; e < 4; ++e) gs += expf(gl[e] - gm);
                const float gwt = 1.f / gs;
                float el[8]; float em = -INFINITY; int e1 = 0;
#pragma unroll
                for (int e = 0; e < 8; ++e) { el[e] = (lp[4 + gi * 8 + e] + lq[4 + gi * 8 + e]) + P.b_expert[gi * 8 + e]; if (el[e] > em) { em = el[e]; e1 = e; } }
                float em2 = -INFINITY; int e2 = 0;
#pragma unroll
                for (int e = 0; e < 8; ++e) if (e != e1 && el[e] > em2) { em2 = el[e]; e2 = e; }
                const float p2 = expf(em2 - em);
                const float w1 = gwt / (1.f + p2), w2 = gwt * p2 / (1.f + p2);
                const int ex1 = gi * 8 + e1, ex2 = gi * 8 + e2;
                const unsigned pos1 = atomicAdd(&CNT[ex1 * 64], 1u), pos2 = atomicAdd(&CNT[ex2 * 64], 1u);
                LIST[ex1 * ML + pos1] = r * 2; EW[r * 2] = w1;
                LIST[ex2 * ML + pos2] = r * 2 + 1; EW[r * 2 + 1] = w2;
            }
        }
    }
    SEAM(9);
    LAS int* tab = (LAS int*)(lds + LDS_TAB);
    if (hi > 10 && lo <= 11) {
        __syncthreads();
        if (wave == 0) {
            const int cnt = lane < NE ? (int)CNT[lane * 64] : 0, np = (cnt + 255) >> 8;
            int incl = np;
#pragma unroll
            for (int o_ = 1; o_ < 32; o_ <<= 1) { const int t_ = __shfl_up(incl, o_); if (lane >= o_) incl += t_; }
            const int first = incl - np;
            if (lane < NE) { tab[lane] = first; tab[64 + lane] = cnt; for (int k = 0; k < np; ++k) tab[128 + first + k] = lane; }
            if (lane == NE - 1) tab[32] = incl;
            if (lane == 0) { tab[33] = 0; tab[34] = 0; tab[36] = 0; tab[37] = 0; tab[38] = 0; tab[39] = 0; }
        }
        __syncthreads();
        {
            const int c_ = tid;
            const int nu = c_ < G ? ((G == 256) ? (((tab[4 * (c_ & 7) + 4] - tab[4 * (c_ & 7)]) * 4 - (c_ >> 3) + 31) >> 5) : ((tab[32] * 4 - c_ + G - 1) / G)) : 0;
            { int m_ = nu;
#pragma unroll
              for (int o_ = 1; o_ < 64; o_ <<= 1) { const int t_ = __shfl_xor(m_, o_); m_ = t_ > m_ ? t_ : m_; }
              if (lane == 0) tab[40 + wave] = m_; }
            __syncthreads();
            int numax_ = tab[40];
#pragma unroll
            for (int w_ = 1; w_ < 8; ++w_) numax_ = tab[40 + w_] > numax_ ? tab[40 + w_] : numax_;
            const bool isf = c_ < G && nu < numax_;
            const unsigned long long bal = __ballot(isf);
            if (lane == 0 && wave < 4) tab[36 + wave] = __popcll(bal);
            __syncthreads();
            int base_ = 0; for (int w_ = 0; w_ < wave && w_ < 4; ++w_) base_ += tab[36 + w_];
            const int tot_ = tab[36] + tab[37] + tab[38] + tab[39];
            if (c_ < G && c_ < 256) tab[320 + c_] = tot_ == 0 ? c_ : (isf ? base_ + __popcll(bal & ((1ull << lane) - 1ull)) : -1);
            if (tid == 0) tab[33] = tot_ == 0 ? G : tot_;
        }
        __syncthreads();
    }
    if (IN(10)) {
        pg8::Gemm g{H2, WGU, ML, NE * 1024, DM}; MoeOrder<true> S_{tab, LIST, G, bid};
        EpiGateUp E{ACT};
        pg8::gemm_phase<EpiGateUp, MoeOrder<true>, true, true>(lds, g, S_, E);
        const int nfill = tab[33], rank = tab[320 + bid];
        if (rank >= 0) {
            LAS float* scr = (LAS float*)(lds + wave * 16640);
            for (int it = CONV_N1 + wave * nfill + rank; it < CONV_ITEMS; it += nfill * 8) conv_item(P, it, WIN, WOUT, WGU, WD, scr, lane);
        }
    }
    SEAM(10);
    if (IN(11)) {
        pg8::Gemm g{ACT, WD, MAXSLOT, NE * 1024, EDIM}; MoeOrder<false> S_{tab, LIST, G, bid};
        EpiDown E{Y, LIST, tab};
        pg8::gemm_phase<EpiDown, MoeOrder<false>, true, true>(lds, g, S_, E);
    }
    SEAM(11);
    if (IN(12)) {
        const int half = lane >> 5, l32 = lane & 31;
        for (int rp = gw; rp < ML / 2; rp += NGW) {
            const int r = rp * 2 + half;
            const float* g2 = MOD + (r / SEQ) * 6144 + 5120;
            const float w0 = EW[r * 2], w1 = EW[r * 2 + 1];
            f32x4 v[8]; float s = 0.f;
#pragma unroll
            for (int j = 0; j < 8; ++j) {
                const int c0 = j * 128 + l32 * 4;
                const u32x2 xw = *(const u32x2*)(X1 + (size_t)r * DM + c0); const f32x4 xv = {bflo(xw.x), bfhi(xw.x), bflo(xw.y), bfhi(xw.y)};
                const u32x2 y0 = *(const u32x2*)(Y + (size_t)(r * 2) * DM + c0), y1 = *(const u32x2*)(Y + (size_t)(r * 2 + 1) * DM + c0);
                const f32x4 gg = *(const f32x4*)(g2 + c0);
                v[j].x = xv.x + gg.x * (w0 * bflo(y0.x) + w1 * bflo(y1.x)); v[j].y = xv.y + gg.y * (w0 * bfhi(y0.x) + w1 * bfhi(y1.x));
                v[j].z = xv.z + gg.z * (w0 * bflo(y0.y) + w1 * bflo(y1.y)); v[j].w = xv.w + gg.w * (w0 * bfhi(y0.y) + w1 * bfhi(y1.y));
                s += v[j].x * v[j].x + v[j].y * v[j].y + v[j].z * v[j].z + v[j].w * v[j].w;
            }
            s += __shfl_xor(s, 1); s += __shfl_xor(s, 2); s += __shfl_xor(s, 4); s += __shfl_xor(s, 8); s += __shfl_xor(s, 16);
            const float rstd = rsqrtf(s * (1.f / DM) + EPS);
#pragma unroll
            for (int j = 0; j < 8; ++j) {
                const int c0 = j * 128 + l32 * 4;
                const f32x4 nf = *(const f32x4*)(P.norm_final + c0);
                f32x4 o; o.x = v[j].x * rstd * nf.x; o.y = v[j].y * rstd * nf.y; o.z = v[j].z * rstd * nf.z; o.w = v[j].w * rstd * nf.w;
                *(f32x4*)(P.out + (size_t)r * DM + c0) = o;
            }
        }
    }
#undef IN
#undef SEAM
}

#ifndef N_LAUNCHES
#define N_LAUNCHES 1
#endif
constexpr int N_PHASES = 13;

extern "C" void kernel_launch(void* const* d_in, const int* in_sizes, int n_in, void* d_out, int out_size, void* d_ws, size_t ws_size, hipStream_t stream) {
    static int grid = 0;
    if (grid == 0) {
        if (n_in != 25 || out_size != ML * DM || ws_size < WS_NEED) { fprintf(stderr, "kernel_launch: unexpected problem (n_in %d out %d ws %zu need %zu)\n", n_in, out_size, ws_size, (size_t)WS_NEED); grid = -1; return; }
        int dev = 0, cus = 0, per_cu = 0;
        (void)hipGetDevice(&dev);
        (void)hipDeviceGetAttribute(&cus, hipDeviceAttributeMultiprocessorCount, dev);
        (void)hipFuncSetAttribute((const void*)fwd_kernel, hipFuncAttributeMaxDynamicSharedMemorySize, LDS_BYTES);
        (void)hipOccupancyMaxActiveBlocksPerMultiprocessor(&per_cu, (const void*)fwd_kernel, NTHREADS, LDS_BYTES);
        (void)hipGetLastError();
        if (per_cu < 1) { fprintf(stderr, "kernel_launch: occupancy query says %d\n", per_cu); }
        grid = cus;
    }
    if (grid < 0) return;
    (void)hipMemsetAsync((char*)d_ws + WS_CTL, 0, CTL_ZERO_BYTES, stream);
    Args a{};
    const float** pp = (const float**)&a.p;
    for (int i = 0; i < 25; ++i) pp[i] = (const float*)d_in[i];
    a.p.out = (float*)d_out; a.p.ws = (unsigned char*)d_ws;
    if (N_LAUNCHES == 1) {
        a.ph_lo = 0; a.ph_hi = N_PHASES;
        hipLaunchKernelGGL(fwd_kernel, dim3(grid), dim3(NTHREADS), LDS_BYTES, stream, a);
    } else {
        for (int ph = 0; ph < N_PHASES; ++ph) { a.ph_lo = ph; a.ph_hi = ph + 1; hipLaunchKernelGGL(fwd_kernel, dim3(grid), dim3(NTHREADS), LDS_BYTES, stream, a); }
    }
}
```
